# Optimizing an MI355X kernel written in HIP

```python
import math
import jax, jax.numpy as jnp
from jax import lax
import numpy as np

D_MODEL = 2048
BATCH = 4
SEQ = 2048
DEPTH = 2
DEC_BATCH = 128
DEC_SEQ = 4
PAST_LEN = 16384
PAGE_SIZE = 128

D_PLE = 256
D_A = D_MODEL // 2
CONV_A = 3
H_B = 8
DK = 128
DV = 128
D_B = H_B * DV
CONV_B = 4
DELTA_CHUNK = 64
D_C = D_MODEL // 2
CHUNK_C = 128
G_C = 8
C_GROUP_DIM = D_C // G_C
D_FF = ((8 * D_MODEL // 3 + 127) // 128) * 128
CONV_F = 3
N_BRANCH = 3
DEEPNORM_ALPHA = (2 * DEPTH) ** 0.25
DEEPNORM_BETA = (8 * DEPTH) ** -0.25
LN_EPS = 1e-5
RMS_EPS = 1e-6
SPLIT_SIZES = (D_A, D_A, D_A, 3 * D_B, D_B, H_B, H_B, D_C, D_C, N_BRANCH * D_MODEL)
N_IN = sum(SPLIT_SIZES)

kernel_name = 'hybrid_conv_delta_gmlp_deepnorm_step'


def layer_norm(x, g, b):
    xf = x.astype(jnp.float32)
    mu = jnp.mean(xf, -1, keepdims=True)
    xc = xf - mu
    var = jnp.mean(xc * xc, -1, keepdims=True)
    y = xc * lax.rsqrt(var + LN_EPS) * g.astype(jnp.float32) + b.astype(jnp.float32)
    return y.astype(x.dtype)


def rms_norm_f32(x, g):
    xf = x.astype(jnp.float32)
    return xf * lax.rsqrt(jnp.mean(xf * xf, -1, keepdims=True) + RMS_EPS) * g.astype(jnp.float32)


def l2_normalize(t):
    return t * lax.rsqrt(jnp.sum(t * t, -1, keepdims=True) + RMS_EPS)


def split_cols(t, sizes):
    offs = np.cumsum(np.array(sizes))[:-1].tolist()
    return jnp.split(t, offs, axis=-1)


def causal_dwconv(x, hist, w):
    width = w.shape[0]
    L = x.shape[1]
    xf = jnp.concatenate([hist, x], axis=1)
    out = xf[:, 0:L] * w[0]
    for j in range(1, width):
        out = out + xf[:, j:j + L] * w[j]
    return out, xf[:, xf.shape[1] - (width - 1):]


def gated_delta_rule(q, k, v, g, beta, s0):
    Bn, L, H, _ = q.shape
    C = min(DELTA_CHUNK, L)
    pad = (-L) % C
    n_chunks = (L + pad) // C

    def prep(t):
        t = jnp.pad(t, [(0, 0), (0, pad)] + [(0, 0)] * (t.ndim - 2))
        t = t.reshape((Bn, n_chunks, C) + t.shape[2:])
        return jnp.transpose(t, (1, 0, 3, 2) + tuple(range(4, t.ndim)))

    qc, kc, vc, gc, bc = prep(q), prep(k), prep(v), prep(g), prep(beta)
    gcum = jnp.cumsum(gc, axis=-1)
    idx = jnp.arange(C)
    causal = idx[:, None] >= idx[None, :]
    strict = idx[:, None] > idx[None, :]
    decay = jnp.exp(jnp.where(causal, gcum[..., :, None] - gcum[..., None, :], -jnp.inf))
    kb = kc * bc[..., None]
    vb = vc * bc[..., None]
    lmat = jnp.where(strict, jnp.einsum('nbhcd,nbhed->nbhce', kb, kc) * decay, 0.0)
    eye = jnp.eye(C, dtype=jnp.float32)
    tmat = lax.linalg.triangular_solve(eye + lmat, jnp.broadcast_to(eye, lmat.shape),
                                       left_side=True, lower=True, unit_diagonal=True)
    u = jnp.einsum('nbhce,nbhef->nbhcf', tmat, vb)
    w = jnp.einsum('nbhce,nbhed->nbhcd', tmat, kb * jnp.exp(gcum)[..., None])
    qk = jnp.einsum('nbhcd,nbhed->nbhce', qc, kc) * decay
    q_dec = qc * jnp.exp(gcum)[..., None]
    k_dec = kc * jnp.exp(gcum[..., -1:] - gcum)[..., None]
    g_last = jnp.exp(gcum[..., -1])

    def step(s, xs):
        u_n, w_n, qk_n, qd_n, kd_n, gl_n = xs
        v_new = u_n - jnp.einsum('bhcd,bhde->bhce', w_n, s)
        o_n = jnp.einsum('bhcd,bhde->bhce', qd_n, s) + jnp.einsum('bhce,bhef->bhcf', qk_n, v_new)
        s = s * gl_n[..., None, None] + jnp.einsum('bhcd,bhce->bhde', kd_n, v_new)
        return s, o_n

    s_fin, o = lax.scan(step, s0, (u, w, qk, q_dec, k_dec, g_last))
    o = jnp.transpose(o, (1, 0, 3, 2, 4)).reshape(Bn, n_chunks * C, H, DV)[:, :L]
    return o, s_fin


def chunk_spatial_mix(v, w_s, b_s):
    Bn, L, _ = v.shape
    pad = (-L) % CHUNK_C
    vp = jnp.pad(v, ((0, 0), (0, pad), (0, 0))).reshape(Bn, -1, CHUNK_C, G_C, C_GROUP_DIM)
    tri = jnp.tril(jnp.ones((CHUNK_C, CHUNK_C), dtype=bool))
    wm = jnp.where(tri, w_s, 0.0)
    mixed = jnp.einsum('gts,bnsgc->bntgc', wm, vp) + jnp.transpose(b_s)[None, None, :, :, None]
    return mixed.reshape(Bn, -1, D_C)[:, :L]


def layer_step(x, p, hist_a, hist_qkv, s_delta, hist_f,
               w_in, conv_a_w, w_a_out, conv_b_w, a_log, dt_bias, norm_b_g, w_b_out,
               ln_c_g, ln_c_b, w_s, b_s, w_c_out, w_o, ln1_g, ln1_b,
               w_up, conv_f_w, w_down, w_pe, w_pg, ln2_g, ln2_b):
    Bn, L, _ = x.shape
    proj = x @ w_in
    a_h, a_bg, a_cg, qkv, z, beta_raw, dec_raw, c_u, c_v, gates = split_cols(proj, SPLIT_SIZES)

    conv_a, new_hist_a = causal_dwconv(a_cg * a_h, hist_a, conv_a_w)
    out_a = (a_bg * conv_a) @ w_a_out

    qkv_c, new_hist_qkv = causal_dwconv(qkv, hist_qkv, conv_b_w)
    qkv_c = jax.nn.silu(qkv_c).astype(jnp.float32)
    q, k, v = jnp.split(qkv_c, 3, axis=-1)
    q = l2_normalize(q.reshape(Bn, L, H_B, DK)) * (DK ** -0.5)
    k = l2_normalize(k.reshape(Bn, L, H_B, DK))
    v = v.reshape(Bn, L, H_B, DV)
    beta = jax.nn.sigmoid(beta_raw.astype(jnp.float32))
    g = -jnp.exp(a_log.astype(jnp.float32)) * jax.nn.softplus(dec_raw.astype(jnp.float32) + dt_bias.astype(jnp.float32))
    o, new_s = gated_delta_rule(q, k, v, g, beta, s_delta.astype(jnp.float32))
    zf = z.astype(jnp.float32).reshape(Bn, L, H_B, DV)
    o = (rms_norm_f32(o, norm_b_g) * jax.nn.silu(zf)).astype(x.dtype)
    out_b = o.reshape(Bn, L, D_B) @ w_b_out

    u_c = jax.nn.gelu(c_u)
    v_c = layer_norm(jax.nn.gelu(c_v), ln_c_g, ln_c_b)
    out_c = (u_c * chunk_spatial_mix(v_c, w_s, b_s)) @ w_c_out

    gts = jax.nn.sigmoid(gates).reshape(Bn, L, N_BRANCH, D_MODEL)
    merged = gts[:, :, 0] * out_a + gts[:, :, 1] * out_b + gts[:, :, 2] * out_c
    x = layer_norm(DEEPNORM_ALPHA * x + merged @ w_o, ln1_g, ln1_b)

    hg, hu = jnp.split(x @ w_up, 2, axis=-1)
    hg_c, new_hist_f = causal_dwconv(hg, hist_f, conv_f_w)
    ffn = (jax.nn.silu(hg_c) * hu) @ w_down
    ple = jax.nn.sigmoid(x @ w_pg) * (p @ w_pe)
    x = layer_norm(DEEPNORM_ALPHA * x + ffn + ple, ln2_g, ln2_b)
    return x, new_hist_a, new_hist_qkv, new_s.astype(s_delta.dtype), new_hist_f, v_c


def setup_inputs(seed: int = 0) -> dict:
    key = jax.random.key(seed)
    ks = iter(jax.random.split(key, 48))
    f32 = jnp.float32

    def nrm(shape, scale):
        return jax.random.normal(next(ks), shape, f32) * scale

    x_prompt = nrm((BATCH, SEQ, D_MODEL), 1.0)
    x_sample = nrm((DEC_BATCH, DEC_SEQ, D_MODEL), 1.0)
    state_conv_a = nrm((DEPTH, DEC_BATCH, CONV_A - 1, D_A), 1.0)
    state_conv_qkv = nrm((DEPTH, DEC_BATCH, CONV_B - 1, 3 * D_B), 1.0)
    state_delta = nrm((DEPTH, DEC_BATCH, H_B, DK, DV), 0.5)
    state_conv_ffn = nrm((DEPTH, DEC_BATCH, CONV_F - 1, D_FF), 1.0)
    p_prompt = nrm((DEPTH, BATCH, SEQ, D_PLE), 1.0)
    p_sample = nrm((DEPTH, DEC_BATCH, DEC_SEQ, D_PLE), 1.0)
    ln_in_g = 1.0 + nrm((D_MODEL,), 0.02)
    ln_in_b = nrm((D_MODEL,), 0.02)
    w_in = nrm((DEPTH, D_MODEL, N_IN), D_MODEL ** -0.5)
    conv_a_w = nrm((DEPTH, CONV_A, D_A), CONV_A ** -0.5)
    w_a_out = nrm((DEPTH, D_A, D_MODEL), D_A ** -0.5)
    conv_b_w = nrm((DEPTH, CONV_B, 3 * D_B), CONV_B ** -0.5)
    a_log = jnp.log(jax.random.uniform(next(ks), (DEPTH, H_B), f32, 1.0, 16.0))
    dt = jnp.exp(jax.random.uniform(next(ks), (DEPTH, H_B), f32, math.log(1e-3), math.log(1e-1)))
    dt_bias = dt + jnp.log(-jnp.expm1(-dt))
    norm_b_g = 1.0 + nrm((DEPTH, DV), 0.02)
    w_b_out = nrm((DEPTH, D_B, D_MODEL), D_B ** -0.5)
    ln_c_g = 1.0 + nrm((DEPTH, D_C), 0.02)
    ln_c_b = nrm((DEPTH, D_C), 0.02)
    w_s = nrm((DEPTH, G_C, CHUNK_C, CHUNK_C), CHUNK_C ** -0.5)
    b_s = 1.0 + nrm((DEPTH, G_C, CHUNK_C), 0.1)
    w_c_out = nrm((DEPTH, D_C, D_MODEL), D_C ** -0.5)
    w_o = nrm((DEPTH, D_MODEL, D_MODEL), D_MODEL ** -0.5 * DEEPNORM_BETA)
    ln1_g = 1.0 + nrm((DEPTH, D_MODEL), 0.02)
    ln1_b = nrm((DEPTH, D_MODEL), 0.02)
    w_up = nrm((DEPTH, D_MODEL, 2 * D_FF), D_MODEL ** -0.5)
    conv_f_w = nrm((DEPTH, CONV_F, D_FF), CONV_F ** -0.5)
    w_down = nrm((DEPTH, D_FF, D_MODEL), D_FF ** -0.5 * DEEPNORM_BETA)
    w_pe = nrm((DEPTH, D_PLE, D_MODEL), D_PLE ** -0.5 * DEEPNORM_BETA)
    w_pg = nrm((DEPTH, D_MODEL, D_MODEL), D_MODEL ** -0.5)
    ln2_g = 1.0 + nrm((DEPTH, D_MODEL), 0.02)
    ln2_b = nrm((DEPTH, D_MODEL), 0.02)
    return {
        'x_prompt': x_prompt, 'x_sample': x_sample,
        'state_conv_a': state_conv_a, 'state_conv_qkv': state_conv_qkv,
        'state_delta': state_delta, 'state_conv_ffn': state_conv_ffn,
        'p_prompt': p_prompt, 'p_sample': p_sample,
        'ln_in_g': ln_in_g, 'ln_in_b': ln_in_b,
        'w_in': w_in, 'conv_a_w': conv_a_w, 'w_a_out': w_a_out,
        'conv_b_w': conv_b_w, 'a_log': a_log, 'dt_bias': dt_bias, 'norm_b_g': norm_b_g, 'w_b_out': w_b_out,
        'ln_c_g': ln_c_g, 'ln_c_b': ln_c_b, 'w_s': w_s, 'b_s': b_s, 'w_c_out': w_c_out,
        'w_o': w_o, 'ln1_g': ln1_g, 'ln1_b': ln1_b,
        'w_up': w_up, 'conv_f_w': conv_f_w, 'w_down': w_down,
        'w_pe': w_pe, 'w_pg': w_pg, 'ln2_g': ln2_g, 'ln2_b': ln2_b,
    }


def reference(x_prompt, x_sample, state_conv_a, state_conv_qkv, state_delta, state_conv_ffn,
              p_prompt, p_sample, ln_in_g, ln_in_b,
              w_in, conv_a_w, w_a_out, conv_b_w, a_log, dt_bias, norm_b_g, w_b_out,
              ln_c_g, ln_c_b, w_s, b_s, w_c_out, w_o, ln1_g, ln1_b,
              w_up, conv_f_w, w_down, w_pe, w_pg, ln2_g, ln2_b):
    xp = layer_norm(x_prompt, ln_in_g, ln_in_b)
    xs = layer_norm(x_sample, ln_in_g, ln_in_b)
    bp = x_prompt.shape[0]
    dt_p = x_prompt.dtype
    pa, pq, pd, pf = [], [], [], []
    sa, sq, sd, sf, sv = [], [], [], [], []
    for i in range(DEPTH):
        wts = (w_in[i], conv_a_w[i], w_a_out[i], conv_b_w[i], a_log[i], dt_bias[i], norm_b_g[i], w_b_out[i],
               ln_c_g[i], ln_c_b[i], w_s[i], b_s[i], w_c_out[i], w_o[i], ln1_g[i], ln1_b[i],
               w_up[i], conv_f_w[i], w_down[i], w_pe[i], w_pg[i], ln2_g[i], ln2_b[i])
        xp, ha, hq, hs, hf, _ = layer_step(
            xp, p_prompt[i],
            jnp.zeros((bp, CONV_A - 1, D_A), dt_p),
            jnp.zeros((bp, CONV_B - 1, 3 * D_B), dt_p),
            jnp.zeros((bp, H_B, DK, DV), dt_p),
            jnp.zeros((bp, CONV_F - 1, D_FF), dt_p),
            *wts)
        pa.append(ha); pq.append(hq); pd.append(hs); pf.append(hf)
        xs, ha, hq, hs, hf, vrows = layer_step(
            xs, p_sample[i], state_conv_a[i], state_conv_qkv[i], state_delta[i], state_conv_ffn[i], *wts)
        sa.append(ha); sq.append(hq); sd.append(hs); sf.append(hf); sv.append(vrows)
    new_conv_a_p = jnp.stack(pa)
    new_conv_qkv_p = jnp.stack(pq)
    new_delta_p = jnp.stack(pd)
    new_conv_ffn_p = jnp.stack(pf)
    new_conv_a_s = jnp.stack(sa)
    new_conv_qkv_s = jnp.stack(sq)
    new_delta_s = jnp.stack(sd)
    new_conv_ffn_s = jnp.stack(sf)
    new_vchunk_s = jnp.stack(sv)
    return (xp, xs, new_conv_a_p, new_conv_qkv_p, new_delta_p, new_conv_ffn_p,
            new_conv_a_s, new_conv_qkv_s, new_delta_s, new_conv_ffn_s, new_vchunk_s)
```

```cpp
#include <hip/hip_runtime.h>
#include <hip/hip_cooperative_groups.h>
#include <cstdio>
#include <cstdint>
namespace cg = cooperative_groups;

#define LAS __attribute__((address_space(3)))
typedef unsigned short bf16_t;
typedef short bf16x8 __attribute__((ext_vector_type(8)));
typedef float f32x4 __attribute__((ext_vector_type(4)));
typedef unsigned u32x4 __attribute__((ext_vector_type(4)));
typedef unsigned u32x2 __attribute__((ext_vector_type(2)));

constexpr int DM = 2048, NBP = 4, SEQ = 2048, NBS = 128, DSQ = 4;
constexpr int MP = NBP * SEQ, MS = NBS * DSQ, MT = MP + MS;
constexpr int DPLE = 256, DA = 1024, HB = 8, DB = 1024, DC = 1024, DFF = 5504, NIN = 15376;
constexpr int NV1 = 61 * 256, NV4 = 2 * DFF + DM;
constexpr float ALPHA = 1.41421356237f, LN_EPS = 1e-5f, RMS_EPS = 1e-6f;

constexpr size_t OUT_YP = 0, OUT_YS = OUT_YP + (size_t)MP * DM, OUT_CAP = OUT_YS + (size_t)MS * DM, OUT_CQP = OUT_CAP + 2 * 4 * 2 * 1024,
                 OUT_DP = OUT_CQP + 2 * 4 * 3 * 3072, OUT_CFP = OUT_DP + 2 * 4 * 8 * 16384, OUT_CAS = OUT_CFP + 2 * 4 * 2 * 5504,
                 OUT_CQS = OUT_CAS + 2 * 128 * 2 * 1024, OUT_DS = OUT_CQS + 2 * 128 * 3 * 3072, OUT_CFS = OUT_DS + (size_t)2 * 128 * 8 * 16384,
                 OUT_VS = OUT_CFS + 2 * 128 * 2 * 5504, OUT_END = OUT_VS + 2 * 128 * 4 * 1024;

constexpr size_t al256(size_t x) { return (x + 255) & ~(size_t)255; }
constexpr size_t W_WIN = 0, W_WA = W_WIN + (size_t)NV1 * 2048 * 2, W_WB = W_WA + (size_t)2048 * 1024 * 2, W_WC = W_WB + (size_t)2048 * 1024 * 2,
                 W_WO = W_WC + (size_t)2048 * 1024 * 2, W_WUP = W_WO + (size_t)2048 * 2048 * 2, W_WDN = W_WUP + (size_t)NV4 * 2048 * 2,
                 W_WPE = W_WDN + (size_t)2048 * DFF * 2, W_XRES = W_WPE + (size_t)2048 * 256 * 2, W_XB = W_XRES + (size_t)MT * DM * 4,
                 W_PRE = W_XB + (size_t)MT * DM * 2, W_PB = W_PRE + (size_t)MT * DM * 4, W_R = W_PB + (size_t)MT * DPLE * 2;
constexpr size_t W_CH = W_R, W_BG = W_CH + (size_t)MT * 1024 * 2, W_QKV = W_BG + (size_t)MT * 1024 * 2, W_Z = W_QKV + (size_t)MT * 3072 * 2,
                 W_GU = W_Z + (size_t)MT * 1024 * 2, W_GV = W_GU + (size_t)MT * 1024 * 2, W_GTS = W_GV + (size_t)MT * 1024 * 2,
                 W_BETA = W_GTS + (size_t)MT * 6144 * 2, W_GG = W_BETA + al256((size_t)MT * 8 * 4), W_YA = W_GG + al256((size_t)MT * 8 * 4),
                 W_YB = W_YA + (size_t)MT * 1024 * 2, W_YC = W_YB + (size_t)MT * 1024 * 2, W_QKVN = W_YC + (size_t)MT * 1024 * 2,
                 W_QKVNS = W_QKVN + (size_t)MT * 3072 * 2, W_VCN = W_QKVNS + (size_t)MS * 3072 * 4, W_DU = W_VCN + (size_t)MT * 1024 * 2,
                 W_DNW = W_DU + (size_t)1024 * 8192 * 4, W_DQD = W_DNW + (size_t)1024 * 8192 * 2, W_DKDT = W_DQD + (size_t)1024 * 8192 * 2,
                 W_DQK = W_DKDT + (size_t)1024 * 8192 * 2, W_DNW2 = W_DQK + (size_t)1024 * 4096 * 2, W_OB = W_DNW2 + (size_t)1024 * 8192 * 2,
                 W_DGL = W_OB + (size_t)MP * 1024 * 4, W_MG32 = W_DGL + 4096,
                 W_MGB = W_MG32 + (size_t)MT * DM * 4, W_REND = W_MGB + (size_t)MT * DM * 2;
constexpr size_t W_PE = W_R, W_HG = W_PE + (size_t)MT * DM * 4, W_HU = W_HG + (size_t)MT * DFF * 2, W_H = W_HU + (size_t)MT * DFF * 2,
                 W_FEND = W_H + (size_t)MT * DFF * 2;
constexpr size_t W_MG32C = W_VCN;
static_assert(W_MG32C + (size_t)MT * DM * 4 <= W_DKDT, "MG32C overlay");
constexpr size_t W_PART = W_VCN;
static_assert(W_PART >= W_FEND && W_PART + (size_t)16 * MS * DM * 4 <= W_OB, "partial buffer overlay");
constexpr size_t WS_NEED = W_REND > W_FEND ? W_REND : W_FEND;
constexpr size_t W_BAR = WS_NEED;
constexpr size_t WS_TOTAL = W_BAR + 16384;
static_assert(WS_TOTAL <= (size_t)1007681536, "workspace too large");

struct KP { const float* in[33]; float* out; unsigned char* ws; };
enum { I_XP = 0, I_XS, I_SCA, I_SCQ, I_SD, I_SCF, I_PP, I_PS, I_LNG, I_LNB, I_WIN, I_CAW, I_WAO, I_CBW, I_ALOG, I_DTB, I_NBG, I_WBO, I_LCG, I_LCB, I_WS, I_BS,
       I_WCO, I_WO, I_L1G, I_L1B, I_WUP, I_CFW, I_WDN, I_WPE, I_WPG, I_L2G, I_L2B };

__device__ __forceinline__ float bf2f(bf16_t h) { return __uint_as_float(((unsigned)h) << 16); }
__device__ __forceinline__ bf16_t f2bf(float f) { unsigned u = __float_as_uint(f); u += 0x7FFFu + ((u >> 16) & 1u); return (bf16_t)(u >> 16); }
typedef __bf16 bf16x2_t __attribute__((ext_vector_type(2)));
typedef float f32x2_t __attribute__((ext_vector_type(2)));
__device__ __forceinline__ unsigned pk2(float lo, float hi) { const bf16x2_t r = __builtin_convertvector((f32x2_t){lo, hi}, bf16x2_t); return __builtin_bit_cast(unsigned, r); }
__device__ __forceinline__ void split_bf(float x, bf16_t& hi, bf16_t& lo) { hi = f2bf(x); lo = f2bf(x - bf2f(hi)); }
__device__ __forceinline__ float lo16(unsigned w) { return __uint_as_float(w << 16); }
__device__ __forceinline__ float hi16(unsigned w) { return __uint_as_float(w & 0xffff0000u); }
__device__ __forceinline__ void unpack8(u32x4 w, float (&f)[8]) { f[0] = lo16(w.x); f[1] = hi16(w.x); f[2] = lo16(w.y); f[3] = hi16(w.y); f[4] = lo16(w.z); f[5] = hi16(w.z); f[6] = lo16(w.w); f[7] = hi16(w.w); }
__device__ __forceinline__ u32x4 pack8(const float (&f)[8]) { u32x4 w; w.x = pk2(f[0], f[1]); w.y = pk2(f[2], f[3]); w.z = pk2(f[4], f[5]); w.w = pk2(f[6], f[7]); return w; }
__device__ __forceinline__ float sigmoid_(float x) { return __builtin_amdgcn_rcpf(1.f + __expf(-x)); }
__device__ __forceinline__ float silu_(float x) { return x * __builtin_amdgcn_rcpf(1.f + __expf(-x)); }
__device__ __forceinline__ float gelu_(float x) { const float y = 1.5957691216f * (x + 0.044715f * x * x * x); return x * __builtin_amdgcn_rcpf(1.f + __expf(-y)); }
__device__ __forceinline__ float softplus_(float x) { return x > 20.f ? x : log1pf(__expf(x)); }
__device__ __forceinline__ float wave_sum(float v) {
#pragma unroll
    for (int o = 1; o < 64; o <<= 1) v += __shfl_xor(v, o);
    return v;
}

__device__ __forceinline__ int otid() { int t = (int)threadIdx.x; asm volatile("" : "+v"(t)); return t; }
__device__ __forceinline__ int obid() { int t = (int)blockIdx.x; asm volatile("" : "+s"(t)); return t; }
__device__ __forceinline__ unsigned char* ows(const unsigned char* p) { unsigned long long v = (unsigned long long)p; asm volatile("" : "+s"(v)); return (unsigned char*)(__attribute__((address_space(1))) unsigned char*)v; }
constexpr int BM = 256, BK = 64, HALF = 128, HTB = HALF * BK * 2, STAGE_BYTES = 8 * HTB, NXCD = 8, WGM = 8;
__device__ __forceinline__ int lds_byte(int r, int c) { const int st = (r >> 4) * 2 + (c >> 5), rr = r & 15, cc = c & 31, ob = rr * 64 + cc * 2; return st * 1024 + (ob ^ (((ob >> 9) & 1) << 5)); }
__device__ __forceinline__ void stage_rc(int b, int& R, int& C) { const int st = b / 1024, sb = b % 1024, swz = sb ^ (((sb >> 9) & 1) << 5); R = (st >> 1) * 16 + swz / 64; C = (st & 1) * 32 + (swz % 64) / 2; }
__device__ __forceinline__ int perm32(int rho) { const int n = rho >> 4, i = rho & 15; return 8 * (i >> 2) + 4 * n + (i & 3); }
struct Unit { int pm, pn, k0, nt, part; };
struct Gemm { const bf16_t* A; const bf16_t* Bt; int M, N, K; };
struct StaticOrder {
    int nM, nN, nwg, G, c, ntf, split;
    __device__ __forceinline__ void init(int M, int N, int K, int G_, int c_, int split_) { nM = M / BM; nN = N / BM; nwg = nM * nN; G = G_; c = c_; ntf = K / BK; split = split_; }
    __device__ __forceinline__ bool next(int i, Unit& u) const {
        u.k0 = 0; u.nt = ntf; u.part = -1;
        if (split) {
            if (i >= 2) return false;
            if (i == 0) { const int su = c >> 4, ks = c & 15, np = ntf >> 1, p0 = (np * ks) >> 4, p1 = (np * (ks + 1)) >> 4;
                u.pm = 32 + (su >> 3); u.pn = su & 7; u.k0 = 2 * p0; u.nt = 2 * (p1 - p0); u.part = ks; return true; }
        }
        const long L = split ? (long)c : (long)i * G + c; if (L >= nwg) return false;
        int wgid = (int)L; { const int q = nwg / NXCD, r = nwg % NXCD, xcd = wgid % NXCD, off = wgid / NXCD; wgid = (xcd < r ? xcd * (q + 1) : r * (q + 1) + (xcd - r) * q) + off; }
        const int nig = WGM * nN, gid = wgid / nig, fm = gid * WGM, gsz = (nM - fm) < WGM ? (nM - fm) : WGM;
        u.pm = fm + ((wgid % nig) % gsz); u.pn = (wgid % nig) / gsz; return true;
    }
};

enum { M_G1 = 0, M_G2A, M_G2B, M_G2C, M_G3, M_PE, M_G4, M_G5 };

__device__ __forceinline__ void st8bf(bf16_t* p, f32x4 a, f32x4 b) { u32x4 w; w.x = pk2(a[0], a[1]); w.y = pk2(a[2], a[3]); w.z = pk2(b[0], b[1]); w.w = pk2(b[2], b[3]); *(u32x4*)p = w; }
__device__ __forceinline__ void st8f(float* p, f32x4 a, f32x4 b) { *(f32x4*)p = a; *(f32x4*)(p + 4) = b; }
__device__ __forceinline__ bool tail_row(int r, int nk, int& seq, int& i, bool& smp) {
    if (r < MP) { seq = r >> 11; smp = false; i = (r & 2047) - (2048 - nk); return i >= 0; }
    const int rs = r - MP; seq = rs >> 2; smp = true; i = (rs & 3) - (4 - nk); return i >= 0;
}

__device__ __forceinline__ void epilogue(const KP& P, const int mode, const int l, const f32x4 (&acc)[2][2][4][2], const int pm, const int pn, const int part, const int wr, const int wc, const int fr_, const int fq_) {
    unsigned char* const ws = ows(P.ws); float* const out = (float*)ows((const unsigned char*)P.out);
    int fr = fr_, fq = fq_; asm volatile("" : "+v"(fr), "+v"(fq));
    const int rbase = pm * 256 + wr * 64 + fr, cl = wc * 32 + 8 * fq;
    if (mode == M_G1) {
        if (pn < 8) {
            bf16_t* ch = (bf16_t*)(ws + W_CH);
#pragma unroll
            for (int ai = 0; ai < 2; ++ai)
#pragma unroll
                for (int m = 0; m < 4; ++m) {
                    __builtin_amdgcn_sched_barrier(0); const int row = rbase + ai * 128 + m * 16, col = pn * 128 + cl;
                    const f32x4 a = acc[ai][0][m][0] * acc[ai][1][m][0], b = acc[ai][0][m][1] * acc[ai][1][m][1];
                    st8bf(ch + (unsigned)(row * 1024 + col), a, b);
                    int seq, i; bool smp;
                    if (tail_row(row, 2, seq, i, smp)) {
                        float* d = out + (smp ? OUT_CAS + ((size_t)(l * 128 + seq) * 2 + i) * 1024 : OUT_CAP + ((size_t)(l * 4 + seq) * 2 + i) * 1024) + col;
                        st8f(d, a, b);
                    }
                }
        } else if (pn == 60) {
            if (wc == 0 && fq < 2) {
                float* dst = (float*)(ws + (fq == 0 ? W_BETA : W_GG));
#pragma unroll
                for (int ai = 0; ai < 2; ++ai)
#pragma unroll
                    for (int m = 0; m < 4; ++m) {
                        __builtin_amdgcn_sched_barrier(0); const int row = rbase + ai * 128 + m * 16;
                        float v[8];
#pragma unroll
                        for (int j = 0; j < 4; ++j) { v[j] = acc[ai][0][m][0][j]; v[4 + j] = acc[ai][0][m][1][j]; }
#pragma unroll
                        for (int h = 0; h < 8; ++h) {
                            if (fq == 0) v[h] = sigmoid_(v[h]);
                            else v[h] = -__expf(P.in[I_ALOG][l * 8 + h]) * softplus_(v[h] + P.in[I_DTB][l * 8 + h]);
                        }
                        st8f(dst + (unsigned)(row * 8), (f32x4){v[0], v[1], v[2], v[3]}, (f32x4){v[4], v[5], v[6], v[7]});
                    }
            }
        } else {
            bf16_t* dstb; int ld, c0, act = 0; bool isq = false;
            if (pn < 12) { dstb = (bf16_t*)(ws + W_BG); ld = 1024; c0 = (pn - 8) * 256; }
            else if (pn < 24) { dstb = (bf16_t*)(ws + W_QKV); ld = 3072; c0 = (pn - 12) * 256; isq = true; }
            else if (pn < 28) { dstb = (bf16_t*)(ws + W_Z); ld = 1024; c0 = (pn - 24) * 256; }
            else if (pn < 32) { dstb = (bf16_t*)(ws + W_GU); ld = 1024; c0 = (pn - 28) * 256; act = 1; }
            else if (pn < 36) { dstb = (bf16_t*)(ws + W_GV); ld = 1024; c0 = (pn - 32) * 256; act = 1; }
            else { dstb = (bf16_t*)(ws + W_GTS); ld = 6144; c0 = (pn - 36) * 256; act = 2; }
#pragma unroll
            for (int ai = 0; ai < 2; ++ai)
#pragma unroll
                for (int m = 0; m < 4; ++m) {
                    __builtin_amdgcn_sched_barrier(0); const int row = rbase + ai * 128 + m * 16;
#pragma unroll
                    for (int bj = 0; bj < 2; ++bj) {
                        const int col = c0 + bj * 128 + cl;
                        f32x4 a = acc[ai][bj][m][0], b = acc[ai][bj][m][1];
                        if (act == 1) {
#pragma unroll
                            for (int j = 0; j < 4; ++j) { a[j] = gelu_(a[j]); b[j] = gelu_(b[j]); }
                        } else if (act == 2) {
#pragma unroll
                            for (int j = 0; j < 4; ++j) { a[j] = sigmoid_(a[j]); b[j] = sigmoid_(b[j]); }
                        }
                        st8bf(dstb + (unsigned)(row * ld + col), a, b);
                        if (isq) {
                            int seq, i; bool smp;
                            if (tail_row(row, 3, seq, i, smp)) {
                                float* d = out + (smp ? OUT_CQS + ((size_t)(l * 128 + seq) * 3 + i) * 3072 : OUT_CQP + ((size_t)(l * 4 + seq) * 3 + i) * 3072) + col;
                                st8f(d, a, b);
                            }
                        }
                    }
                }
        }
    } else if (mode == M_G2A || mode == M_G2B || mode == M_G2C) {
        const int which = mode - M_G2A;
        float* mg = (float*)(ws + W_MG32); const bf16_t* gts = (const bf16_t*)(ws + W_GTS); bf16_t* mgb = (bf16_t*)(ws + W_MGB);
#pragma unroll
        for (int ai = 0; ai < 2; ++ai)
#pragma unroll
            for (int m = 0; m < 4; ++m) {
                __builtin_amdgcn_sched_barrier(0); const int row = rbase + ai * 128 + m * 16;
#pragma unroll
                for (int bj = 0; bj < 2; ++bj) {
                    const int col = pn * 256 + bj * 128 + cl;
                    float g[8]; unpack8(*(const u32x4*)(gts + (unsigned)(row * 6144 + which * 2048 + col)), g);
                    f32x4 a = acc[ai][bj][m][0], b = acc[ai][bj][m][1];
#pragma unroll
                    for (int j = 0; j < 4; ++j) { a[j] *= g[j]; b[j] *= g[4 + j]; }
                    const unsigned mo = (unsigned)(row * DM + col);
                    if (which == 0) st8f(mg + mo, a, b);
                    else if (which == 2) st8f((float*)(ws + W_MG32C) + mo, a, b);
                    else { const float* mc = (const float*)(ws + W_MG32C) + mo;
                        a += *(const f32x4*)(mg + mo) + *(const f32x4*)mc; b += *(const f32x4*)(mg + mo + 4) + *(const f32x4*)(mc + 4);
                        st8bf(mgb + mo, a, b); }
                }
            }
    } else if (mode == M_G3 || mode == M_G5 || mode == M_PE) {
        const float* xr = (const float*)(ws + W_XRES); const float* pe = (const float*)(ws + W_PE);
        float* dst = (float*)(ws + (mode == M_PE ? W_PE : W_PRE));
#pragma unroll
        for (int ai = 0; ai < 2; ++ai)
#pragma unroll
            for (int m = 0; m < 4; ++m) {
                __builtin_amdgcn_sched_barrier(0); const int row = rbase + ai * 128 + m * 16;
#pragma unroll
                for (int bj = 0; bj < 2; ++bj) {
                    const unsigned o = (unsigned)(row * DM + pn * 256 + bj * 128 + cl);
                    f32x4 a = acc[ai][bj][m][0], b = acc[ai][bj][m][1];
                    if (part <= 0) {
                        if (mode == M_G3) { a += ALPHA * *(const f32x4*)(xr + o); b += ALPHA * *(const f32x4*)(xr + o + 4); }
                        if (mode == M_G5) { a += *(const f32x4*)(pe + o); b += *(const f32x4*)(pe + o + 4); }
                    }
                    if (part < 0) st8f(dst + o, a, b);
                    else st8f((float*)(ws + W_PART) + (unsigned)(part * (MS * DM)) + (o - (unsigned)(MP * DM)), a, b);
                }
            }
    } else {
        if (pn < 43) {
            bf16_t* hg = (bf16_t*)(ws + W_HG); bf16_t* hu = (bf16_t*)(ws + W_HU);
#pragma unroll
            for (int ai = 0; ai < 2; ++ai)
#pragma unroll
                for (int m = 0; m < 4; ++m) {
                    __builtin_amdgcn_sched_barrier(0); const int row = rbase + ai * 128 + m * 16;
#pragma unroll
                    for (int bj = 0; bj < 2; ++bj) {
                        const int c = pn * 256 + bj * 128 + cl;
                        const f32x4 a = acc[ai][bj][m][0], b = acc[ai][bj][m][1];
                        if (c < DFF) {
                            st8bf(hg + (unsigned)(row * DFF + c), a, b);
                            int seq, i; bool smp;
                            if (tail_row(row, 2, seq, i, smp)) {
                                float* d = out + (smp ? OUT_CFS + ((size_t)(l * 128 + seq) * 2 + i) * DFF : OUT_CFP + ((size_t)(l * 4 + seq) * 2 + i) * DFF) + c;
                                st8f(d, a, b);
                            }
                        } else st8bf(hu + (unsigned)(row * DFF + (c - DFF)), a, b);
                    }
                }
        } else {
            float* pe = (float*)(ws + W_PE);
#pragma unroll
            for (int ai = 0; ai < 2; ++ai)
#pragma unroll
                for (int m = 0; m < 4; ++m) {
                    __builtin_amdgcn_sched_barrier(0); const int row = rbase + ai * 128 + m * 16;
#pragma unroll
                    for (int bj = 0; bj < 2; ++bj) {
                        float* p = pe + (unsigned)(row * DM + (pn - 43) * 256 + bj * 128 + cl);
                        f32x4 a = acc[ai][bj][m][0], b = acc[ai][bj][m][1];
                        const f32x4 pa = *(const f32x4*)p, pb = *(const f32x4*)(p + 4);
                        const float* xq = (const float*)(ws + W_XRES) + (unsigned)(row * DM + (pn - 43) * 256 + bj * 128 + cl);
                        const f32x4 xa = *(const f32x4*)xq, xb4 = *(const f32x4*)(xq + 4);
#pragma unroll
                        for (int j = 0; j < 4; ++j) { a[j] = sigmoid_(a[j]) * pa[j] + ALPHA * xa[j]; b[j] = sigmoid_(b[j]) * pb[j] + ALPHA * xb4[j]; }
                        st8f(p, a, b);
                    }
                }
        }
    }
}

__device__ __forceinline__ void gemm_phase(LAS unsigned char* lds, const Gemm g, const StaticOrder& S, const KP& P, const int mode, const int layer) {
    const int tidx_ = otid(), bidx_ = obid(); (void)tidx_; (void)bidx_;
    const int tid = tidx_, wid = __builtin_amdgcn_readfirstlane(tid >> 6), lane = tid & 63, wr = wid >> 2, wc = wid & 3, fr = lane & 15, fq = lane >> 4;
    const int K = g.K;
    unsigned voffA[2], voffB[2];
#pragma unroll
    for (int i = 0; i < 2; ++i) { int R, C; stage_rc(tid * 16 + i * 8192, R, C); const int Rb = (R & ~31) + perm32(R & 31);
        voffA[i] = (unsigned)(R * K + C) * 2u; voffB[i] = (unsigned)(Rb * K + C) * 2u; }
    const size_t kstep = (size_t)(BK * 2);
    const size_t hstep = (size_t)HALF * K * 2;
    const size_t tstep = 2 * hstep;
    const unsigned ldsw = (unsigned)wid * 1024u;
    const int aoff = lds_byte(wr * 64 + fr, fq * 8), boff = lds_byte(wc * 32 + fr, fq * 8);
#define PG8_SA(b, h) (((b) * 2 + (h)) * HTB)
#define PG8_SB(b, h) ((4 + (b) * 2 + (h)) * HTB)
#define PG8_STAGE(bufoff, gbase, voff) do { _Pragma("unroll") for (int _i = 0; _i < 2; ++_i) \
        __builtin_amdgcn_global_load_lds((const unsigned*)((const char*)(gbase) + (voff)[_i]), (LAS unsigned*)(lds + (bufoff) + ldsw + _i * 8192), 16, 0, 0); } while (0)
#define PG8_LDA(dst, b, h) do { _Pragma("unroll") for (int m = 0; m < 4; ++m) _Pragma("unroll") for (int k = 0; k < 2; ++k) dst[m][k] = *(const LAS bf16x8*)(lds + PG8_SA(b, h) + aoff + m * 2048 + k * 1024); } while (0)
#define PG8_LDB(dst, b, h) do { _Pragma("unroll") for (int n = 0; n < 2; ++n) _Pragma("unroll") for (int k = 0; k < 2; ++k) dst[n][k] = *(const LAS bf16x8*)(lds + PG8_SB(b, h) + boff + n * 2048 + k * 1024); } while (0)
#define PG8_MMA(ai, bj, At, Bt) do { __builtin_amdgcn_s_setprio(1); _Pragma("unroll") for (int m = 0; m < 4; ++m) _Pragma("unroll") for (int n = 0; n < 2; ++n) _Pragma("unroll") for (int k = 0; k < 2; ++k) \
        acc[ai][bj][m][n] = __builtin_amdgcn_mfma_f32_16x16x32_bf16(Bt[n][k], At[m][k], acc[ai][bj][m][n], 0, 0, 0); __builtin_amdgcn_s_setprio(0); } while (0)
#define PG8_WAIT_V(n) asm volatile("s_waitcnt vmcnt(" #n ")" ::: "memory")
#define PG8_WAIT_L(n) asm volatile("s_waitcnt lgkmcnt(" #n ")" ::: "memory")
#define PG8_BAR __builtin_amdgcn_s_barrier()
#define PG8_SCHED __builtin_amdgcn_sched_barrier(0)
    Unit cur, nxt; int ui = 0;
    if (!S.next(0, cur)) return;
    f32x4 acc[2][2][4][2];
#pragma unroll
    for (int a = 0; a < 2; ++a)
#pragma unroll
        for (int b = 0; b < 2; ++b)
#pragma unroll
            for (int m = 0; m < 4; ++m)
#pragma unroll
                for (int n = 0; n < 2; ++n) acc[a][b][m][n] = (f32x4){0.f, 0.f, 0.f, 0.f};
    bf16x8 At[4][2], B0[2][2], B1[2][2];
    const char* cA = (const char*)g.A + (size_t)cur.pm * tstep + (size_t)cur.k0 * kstep; const char* cB = (const char*)g.Bt + (size_t)cur.pn * tstep + (size_t)cur.k0 * kstep;
    PG8_STAGE(PG8_SB(0, 0), cB, voffB); PG8_STAGE(PG8_SB(0, 1), cB + hstep, voffB); PG8_STAGE(PG8_SA(0, 0), cA, voffA); PG8_STAGE(PG8_SA(0, 1), cA + hstep, voffA);
    if (wr == 1) PG8_BAR;
    PG8_WAIT_V(2); PG8_BAR;
    PG8_STAGE(PG8_SB(1, 0), cB + kstep, voffB); PG8_STAGE(PG8_SA(1, 0), cA + kstep, voffA); PG8_STAGE(PG8_SB(1, 1), cB + hstep + kstep, voffB);
    PG8_WAIT_V(6); PG8_BAR;
    for (;;) {
        const bool has_next = S.next(ui + 1, nxt);
        const char* nA = has_next ? (const char*)g.A + (size_t)nxt.pm * tstep + (size_t)nxt.k0 * kstep : cA; const char* nB = has_next ? (const char*)g.Bt + (size_t)nxt.pn * tstep + (size_t)nxt.k0 * kstep : cB;
        const int nt = cur.nt;
        for (int t = 0; t < nt; t += 2) {
            const bool last = (t == nt - 2);
            const char* a1 = cA + (size_t)(t + 1) * kstep;
            const char* a2 = last ? nA : cA + (size_t)(t + 2) * kstep; const char* b2 = last ? nB : cB + (size_t)(t + 2) * kstep;
            const char* a3 = a2 + kstep; const char* b3 = b2 + kstep;
            PG8_LDB(B0, 0, 0); PG8_LDB(B1, 0, 1); PG8_SCHED; PG8_LDA(At, 0, 0); PG8_STAGE(PG8_SA(1, 1), a1 + hstep, voffA);
            PG8_WAIT_V(8); PG8_WAIT_L(0); PG8_BAR; PG8_MMA(0, 0, At, B0); PG8_MMA(0, 1, At, B1); PG8_BAR; PG8_SCHED;
            PG8_LDA(At, 0, 1); PG8_STAGE(PG8_SB(0, 0), b2, voffB); PG8_STAGE(PG8_SB(0, 1), b2 + hstep, voffB); PG8_STAGE(PG8_SA(0, 0), a2, voffA);
            PG8_WAIT_V(8); PG8_WAIT_L(0); PG8_BAR; PG8_MMA(1, 0, At, B0); PG8_MMA(1, 1, At, B1); PG8_BAR; PG8_SCHED;
            PG8_LDB(B0, 1, 0); PG8_LDB(B1, 1, 1); PG8_SCHED; PG8_LDA(At, 1, 0); PG8_STAGE(PG8_SA(0, 1), a2 + hstep, voffA);
            PG8_WAIT_V(8); PG8_WAIT_L(0); PG8_BAR; PG8_MMA(0, 0, At, B0); PG8_MMA(0, 1, At, B1); PG8_BAR; PG8_SCHED;
            PG8_LDA(At, 1, 1); PG8_STAGE(PG8_SB(1, 0), b3, voffB); PG8_STAGE(PG8_SB(1, 1), b3 + hstep, voffB); PG8_STAGE(PG8_SA(1, 0), a3, voffA);
            PG8_WAIT_V(8); PG8_WAIT_L(0); PG8_BAR; PG8_MMA(1, 0, At, B0); PG8_MMA(1, 1, At, B1); PG8_BAR; PG8_SCHED;
        }
        if (wr == 0) PG8_BAR;
        epilogue(P, mode, layer, acc, cur.pm, cur.pn, cur.part, wr, wc, fr, fq);
        if (!has_next) break;
#pragma unroll
        for (int a = 0; a < 2; ++a)
#pragma unroll
            for (int b = 0; b < 2; ++b)
#pragma unroll
                for (int m = 0; m < 4; ++m)
#pragma unroll
                    for (int n = 0; n < 2; ++n) acc[a][b][m][n] = (f32x4){0.f, 0.f, 0.f, 0.f};
        cur = nxt; cA = nA; cB = nB; ++ui;
        if (wr == 1) PG8_BAR;
    }
    PG8_WAIT_V(0);
    PG8_BAR;
#undef PG8_SA
#undef PG8_SB
#undef PG8_STAGE
#undef PG8_LDA
#undef PG8_LDB
#undef PG8_MMA
#undef PG8_WAIT_V
#undef PG8_WAIT_L
#undef PG8_BAR
#undef PG8_SCHED
}

__device__ __forceinline__ void tr_tile_w(const float* src, const int ldsrc, const int scol0, const int nvalid, const int k0, bf16_t* dst, const int K, const int drow0, float* scr, const int lane) {
    const int kk = lane >> 3, c4 = (lane & 7) * 4;
    f32x4 v[8];
#pragma unroll
    for (int p = 0; p < 8; ++p) { v[p] = (f32x4){0.f, 0.f, 0.f, 0.f}; if (c4 < nvalid) v[p] = __builtin_nontemporal_load((const f32x4*)(src + (size_t)(k0 + kk + 8 * p) * ldsrc + scol0 + c4)); }
#pragma unroll
    for (int p = 0; p < 8; ++p) {
        scr[(c4 + 0) * 65 + kk + 8 * p] = v[p][0]; scr[(c4 + 1) * 65 + kk + 8 * p] = v[p][1]; scr[(c4 + 2) * 65 + kk + 8 * p] = v[p][2]; scr[(c4 + 3) * 65 + kk + 8 * p] = v[p][3];
    }
    __builtin_amdgcn_wave_barrier();
#pragma unroll
    for (int q = 0; q < 4; ++q) {
        const int id = lane + 64 * q, n = id >> 3, c = id & 7; const float* sp = scr + n * 65 + 8 * c;
        u32x4 o; o.x = pk2(sp[0], sp[1]); o.y = pk2(sp[2], sp[3]); o.z = pk2(sp[4], sp[5]); o.w = pk2(sp[6], sp[7]);
        *(u32x4*)(dst + (size_t)(drow0 + n) * K + k0 + 8 * c) = o;
    }
    __builtin_amdgcn_wave_barrier();
}
__device__ __forceinline__ void convert_weights(const KP& P, const int l, float* scr0, const int part, const int wblk, const int nwb) {
    const int tidx_ = otid(), bidx_ = obid(); (void)tidx_; (void)bidx_;
    unsigned char* ws = ows(P.ws);
    const int lane = tidx_ & 63, wv = tidx_ >> 6, gw = wblk * 8 + wv, ngw = nwb * 8;
    float* scr = scr0 + wv * (32 * 65);
    constexpr int T_WIN = (NV1 / 32) * 32, T_W1 = 64 * 16, T_WO = 64 * 32, T_WUP = (2 * DFF / 32) * 32, T_WPG = 64 * 32, T_WDN = 64 * (DFF / 64), T_WPE = 64 * 4;
    constexpr int T_ALL = T_WIN + 3 * T_W1 + T_WO + T_WUP + T_WPG + T_WDN + T_WPE;
    constexpr int T_A = T_WIN + 3 * T_W1 + T_WO, T_LATE = T_WUP + T_WPG;
    const int njobs = part == 1 ? T_LATE : (part == 2 ? T_WDN : (part == 3 ? T_ALL - T_LATE : T_ALL - T_LATE - T_WDN));
    for (int jt = gw; jt < njobs; jt += ngw) {
        const int it = part == 1 ? T_A + jt : (part == 2 ? T_A + T_LATE + jt : (jt < T_A ? jt : jt + T_LATE + (part == 3 ? 0 : T_WDN)));
        int r = it;
        if (r < T_WIN) {
            const int nj = r >> 5, kj = r & 31, nv0 = nj * 32; int sc, nv = 32;
            if (nv0 < 2048) { const int t = nv0 >> 8, hf = (nv0 >> 7) & 1, i = nv0 & 127; sc = (hf ? 2048 : 0) + 128 * t + i; }
            else if (nv0 < 3072) sc = nv0 - 1024;
            else if (nv0 < 7168) sc = nv0;
            else if (nv0 < 15360) sc = nv0 + 16;
            else if (nv0 == 15360) { sc = 7168; nv = 16; }
            else { sc = 0; nv = 0; }
            tr_tile_w(P.in[I_WIN] + (size_t)l * 2048 * NIN, NIN, sc, nv, kj * 64, (bf16_t*)(ws + W_WIN), 2048, nv0, scr, lane); continue;
        }
        r -= T_WIN;
        if (r < 3 * T_W1) {
            const int w = r / T_W1, rr = r % T_W1, nj = rr >> 4, kj = rr & 15;
            const float* src = (w == 0 ? P.in[I_WAO] : (w == 1 ? P.in[I_WBO] : P.in[I_WCO])) + (size_t)l * 1024 * 2048;
            bf16_t* dst = (bf16_t*)(ws + (w == 0 ? W_WA : (w == 1 ? W_WB : W_WC)));
            tr_tile_w(src, 2048, nj * 32, 32, kj * 64, dst, 1024, nj * 32, scr, lane); continue;
        }
        r -= 3 * T_W1;
        if (r < T_WO) { const int nj = r >> 5, kj = r & 31; tr_tile_w(P.in[I_WO] + (size_t)l * 2048 * 2048, 2048, nj * 32, 32, kj * 64, (bf16_t*)(ws + W_WO), 2048, nj * 32, scr, lane); continue; }
        r -= T_WO;
        if (r < T_WUP) { const int nj = r >> 5, kj = r & 31; tr_tile_w(P.in[I_WUP] + (size_t)l * 2048 * 2 * DFF, 2 * DFF, nj * 32, 32, kj * 64, (bf16_t*)(ws + W_WUP), 2048, nj * 32, scr, lane); continue; }
        r -= T_WUP;
        if (r < T_WPG) { const int nj = r >> 5, kj = r & 31; tr_tile_w(P.in[I_WPG] + (size_t)l * 2048 * 2048, 2048, nj * 32, 32, kj * 64, (bf16_t*)(ws + W_WUP), 2048, 2 * DFF + nj * 32, scr, lane); continue; }
        r -= T_WPG;
        if (r < T_WDN) { const int nj = r / (DFF / 64), kj = r % (DFF / 64); tr_tile_w(P.in[I_WDN] + (size_t)l * DFF * 2048, 2048, nj * 32, 32, kj * 64, (bf16_t*)(ws + W_WDN), DFF, nj * 32, scr, lane); continue; }
        r -= T_WDN;
        { const int nj = r >> 2, kj = r & 3; tr_tile_w(P.in[I_WPE] + (size_t)l * 256 * 2048, 2048, nj * 32, 32, kj * 64, (bf16_t*)(ws + W_WPE), 256, nj * 32, scr, lane); }
    }
    bf16_t* pb = (bf16_t*)(ws + W_PB);
    if (part == 0 || part == 3) for (int i = bidx_ * 512 + tidx_; i < MT * 32; i += gridDim.x * 512) {
        const int r = i >> 5, c8 = (i & 31) * 8;
        const float* s = (r < MP ? P.in[I_PP] + ((size_t)l * MP + r) * 256 : P.in[I_PS] + ((size_t)l * MS + (r - MP)) * 256) + c8;
        const f32x4 a = *(const f32x4*)s, b = *(const f32x4*)(s + 4);
        st8bf(pb + (size_t)r * 256 + c8, a, b);
    }
}

__device__ __forceinline__ void ln_rows(const KP& P, const int srcsel  , const float* g, const float* b, const bool to_out) {
    const int tidx_ = otid(), bidx_ = obid(); (void)tidx_; (void)bidx_;
    unsigned char* ws = ows(P.ws);
    const int lane = tidx_ & 63, gw = bidx_ * 8 + (tidx_ >> 6), ngw = gridDim.x * 8;
    f32x4 gv[8], bv[8];
#pragma unroll
    for (int j = 0; j < 8; ++j) { gv[j] = *(const f32x4*)(g + j * 256 + lane * 4); bv[j] = *(const f32x4*)(b + j * 256 + lane * 4); }
    for (int r = gw; r < MT; r += ngw) {
        const float* src = srcsel ? (const float*)(ws + W_PRE) + (size_t)r * DM : (r < MP ? P.in[I_XP] + (size_t)r * DM : P.in[I_XS] + (size_t)(r - MP) * DM);
        f32x4 v[8]; float s = 0.f;
        if (srcsel && r >= MP && gridDim.x == 256) {
            const float* pp = (const float*)(ws + W_PART) + (size_t)(r - MP) * DM + lane * 4;
#pragma unroll
            for (int j = 0; j < 8; ++j) v[j] = __builtin_nontemporal_load((const f32x4*)(pp + j * 256));
#pragma unroll 3
            for (int ks = 1; ks < 16; ++ks)
#pragma unroll
                for (int j = 0; j < 8; ++j) v[j] += __builtin_nontemporal_load((const f32x4*)(pp + (size_t)ks * (MS * DM) + j * 256));
#pragma unroll
            for (int j = 0; j < 8; ++j) s += (v[j][0] + v[j][1]) + (v[j][2] + v[j][3]);
        } else {
#pragma unroll
            for (int j = 0; j < 8; ++j) { v[j] = __builtin_nontemporal_load((const f32x4*)(src + j * 256 + lane * 4)); s += (v[j][0] + v[j][1]) + (v[j][2] + v[j][3]); }
        }
        const float mean = wave_sum(s) * (1.f / DM); float s2 = 0.f;
#pragma unroll
        for (int j = 0; j < 8; ++j) { v[j] = v[j] - mean; s2 += (v[j][0] * v[j][0] + v[j][1] * v[j][1]) + (v[j][2] * v[j][2] + v[j][3] * v[j][3]); }
        const float rstd = rsqrtf(wave_sum(s2) * (1.f / DM) + LN_EPS);
        float* d32 = to_out ? P.out + (size_t)r * DM : (float*)(ws + W_XRES) + (size_t)r * DM;
        bf16_t* db = (bf16_t*)(ws + W_XB) + (size_t)r * DM;
#pragma unroll
        for (int j = 0; j < 8; ++j) {
            const f32x4 y = v[j] * rstd * gv[j] + bv[j];
            if (to_out) __builtin_nontemporal_store(y, (f32x4*)(d32 + j * 256 + lane * 4)); else *(f32x4*)(d32 + j * 256 + lane * 4) = y;
            if (!to_out) { u32x2 w; w.x = pk2(y[0], y[1]); w.y = pk2(y[2], y[3]); *(u32x2*)(db + j * 256 + lane * 4) = w; }
        }
    }
}

__device__ __forceinline__ void phase_e(const KP& P, const int l) {
    const int tidx_ = otid(), bidx_ = obid(); (void)tidx_; (void)bidx_;
    unsigned char* ws = ows(P.ws);
    {
        const bf16_t* ch = (const bf16_t*)(ws + W_CH); const bf16_t* bg = (const bf16_t*)(ws + W_BG); bf16_t* ya = (bf16_t*)(ws + W_YA);
        const float* cw = P.in[I_CAW] + (size_t)l * 3 * 1024; const float* hist = P.in[I_SCA] + (size_t)l * 128 * 2 * 1024;
        for (int i = bidx_ * 512 + tidx_; i < (MT / 4) * 128; i += gridDim.x * 512) {
            const int q = i >> 7, c8 = (i & 127) * 8, r0 = 4 * q;
            const bool smp = r0 >= MP; const int t0 = smp ? 0 : (r0 & 2047), sb = (r0 - MP) >> 2;
            float x[6][8];
#pragma unroll
            for (int d = 0; d < 2; ++d) {
                if (t0 > 0) unpack8(*(const u32x4*)(ch + (size_t)(r0 - 2 + d) * 1024 + c8), x[d]);
                else if (smp) { const float* h = hist + ((size_t)sb * 2 + d) * 1024 + c8; const f32x4 h0 = *(const f32x4*)h, h1 = *(const f32x4*)(h + 4);
#pragma unroll
                    for (int j = 0; j < 4; ++j) { x[d][j] = h0[j]; x[d][4 + j] = h1[j]; } }
                else {
#pragma unroll
                    for (int j = 0; j < 8; ++j) x[d][j] = 0.f; }
            }
#pragma unroll
            for (int d = 0; d < 4; ++d) unpack8(*(const u32x4*)(ch + (size_t)(r0 + d) * 1024 + c8), x[2 + d]);
            float w[3][8];
#pragma unroll
            for (int d = 0; d < 3; ++d) { const f32x4 w0 = *(const f32x4*)(cw + d * 1024 + c8), w1 = *(const f32x4*)(cw + d * 1024 + c8 + 4);
#pragma unroll
                for (int j = 0; j < 4; ++j) { w[d][j] = w0[j]; w[d][4 + j] = w1[j]; } }
#pragma unroll
            for (int d = 0; d < 4; ++d) {
                float g[8], a[8]; unpack8(*(const u32x4*)(bg + (size_t)(r0 + d) * 1024 + c8), g);
#pragma unroll
                for (int j = 0; j < 8; ++j) a[j] = g[j] * (w[0][j] * x[d][j] + w[1][j] * x[d + 1][j] + w[2][j] * x[d + 2][j]);
                *(u32x4*)(ya + (size_t)(r0 + d) * 1024 + c8) = pack8(a);
            }
        }
    }
    const int lane = tidx_ & 63, gw = bidx_ * 8 + (tidx_ >> 6), ngw = gridDim.x * 8;
    {
        const bf16_t* qkv = (const bf16_t*)(ws + W_QKV); bf16_t* qn = (bf16_t*)(ws + W_QKVN); float* qns = (float*)(ws + W_QKVNS);
        const float* cw = P.in[I_CBW] + (size_t)l * 4 * 3072; const float* hist = P.in[I_SCQ] + (size_t)l * 128 * 3 * 3072;
        for (int it = gw; it < (MT / 4) * 6; it += ngw) {
            const int q = it / 6, s4 = it % 6, c = s4 * 512 + lane * 8, r0 = 4 * q;
            const bool smp = r0 >= MP; const int t0 = smp ? 0 : (r0 & 2047), sb = (r0 - MP) >> 2;
            float x[7][8];
#pragma unroll
            for (int d = 0; d < 3; ++d) {
                if (t0 > 0) unpack8(*(const u32x4*)(qkv + (size_t)(r0 - 3 + d) * 3072 + c), x[d]);
                else if (smp) { const float* hp = hist + ((size_t)sb * 3 + d) * 3072 + c; const f32x4 h0 = *(const f32x4*)hp, h1 = *(const f32x4*)(hp + 4);
#pragma unroll
                    for (int j = 0; j < 4; ++j) { x[d][j] = h0[j]; x[d][4 + j] = h1[j]; } }
                else {
#pragma unroll
                    for (int j = 0; j < 8; ++j) x[d][j] = 0.f; }
            }
#pragma unroll
            for (int d = 0; d < 4; ++d) unpack8(*(const u32x4*)(qkv + (size_t)(r0 + d) * 3072 + c), x[3 + d]);
            float w[4][8];
#pragma unroll
            for (int d = 0; d < 4; ++d) { const f32x4 w0 = *(const f32x4*)(cw + d * 3072 + c), w1 = *(const f32x4*)(cw + d * 3072 + c + 4);
#pragma unroll
                for (int j = 0; j < 4; ++j) { w[d][j] = w0[j]; w[d][4 + j] = w1[j]; } }
#pragma unroll
            for (int d = 0; d < 4; ++d) {
                float a[8]; float ss = 0.f;
#pragma unroll
                for (int j = 0; j < 8; ++j) { a[j] = silu_(w[0][j] * x[d][j] + w[1][j] * x[d + 1][j] + w[2][j] * x[d + 2][j] + w[3][j] * x[d + 3][j]); ss += a[j] * a[j]; }
                if (s4 < 4) {
                    ss += __shfl_xor(ss, 1); ss += __shfl_xor(ss, 2); ss += __shfl_xor(ss, 4); ss += __shfl_xor(ss, 8);
                    const float sc = rsqrtf(ss + RMS_EPS) * (s4 < 2 ? 0.08838834764831845f : 1.f);
#pragma unroll
                    for (int j = 0; j < 8; ++j) a[j] *= sc;
                }
                *(u32x4*)(qn + (size_t)(r0 + d) * 3072 + c) = pack8(a);
                if (smp) st8f(qns + (size_t)(r0 + d - MP) * 3072 + c, (f32x4){a[0], a[1], a[2], a[3]}, (f32x4){a[4], a[5], a[6], a[7]});
            }
        }
    }
    {
        const bf16_t* gv = (const bf16_t*)(ws + W_GV); bf16_t* vcn = (bf16_t*)(ws + W_VCN);
        const float* lg = P.in[I_LCG] + (size_t)l * 1024; const float* lb = P.in[I_LCB] + (size_t)l * 1024;
        for (int r = gw; r < MT; r += ngw) {
            float x[2][8]; float s = 0.f;
#pragma unroll
            for (int j = 0; j < 2; ++j) { unpack8(*(const u32x4*)(gv + (size_t)r * 1024 + j * 512 + lane * 8), x[j]);
#pragma unroll
                for (int e = 0; e < 8; ++e) s += x[j][e]; }
            const float mean = wave_sum(s) * (1.f / 1024.f); float s2 = 0.f;
#pragma unroll
            for (int j = 0; j < 2; ++j)
#pragma unroll
                for (int e = 0; e < 8; ++e) { x[j][e] -= mean; s2 += x[j][e] * x[j][e]; }
            const float rstd = rsqrtf(wave_sum(s2) * (1.f / 1024.f) + LN_EPS);
#pragma unroll
            for (int j = 0; j < 2; ++j) {
                const int c = j * 512 + lane * 8;
#pragma unroll
                for (int e = 0; e < 8; ++e) x[j][e] = x[j][e] * rstd * lg[c + e] + lb[c + e];
                *(u32x4*)(vcn + (size_t)r * 1024 + c) = pack8(x[j]);
                if (r >= MP) { float* d = P.out + OUT_VS + ((size_t)l * MS + (r - MP)) * 1024 + c;
                    st8f(d, (f32x4){x[j][0], x[j][1], x[j][2], x[j][3]}, (f32x4){x[j][4], x[j][5], x[j][6], x[j][7]}); }
            }
        }
    }
}

__device__ __forceinline__ void beta_gate(const KP& P, const int l) {
    const int tidx_ = otid(), bidx_ = obid(); (void)tidx_; (void)bidx_;
    unsigned char* ws = ows(P.ws);
    const int lane = tidx_ & 63, lr = lane & 15, lq = lane >> 4, gw = bidx_ * 8 + (tidx_ >> 6), ngw = gridDim.x * 8;
    const bf16_t* xb = (const bf16_t*)(ws + W_XB); const bf16_t* wt = (const bf16_t*)(ws + W_WIN) + (size_t)15360 * 2048;
    float* betab = (float*)(ws + W_BETA); float* ggb = (float*)(ws + W_GG);
    for (int it = gw; it < MT / 16; it += ngw) {
        const bf16_t* ap = xb + (size_t)(16 * it + lr) * 2048 + lq * 8; const bf16_t* bp = wt + (size_t)lr * 2048 + lq * 8;
        f32x4 acc0 = {0.f, 0.f, 0.f, 0.f}, acc1 = {0.f, 0.f, 0.f, 0.f};
#pragma unroll 8
        for (int ks = 0; ks < 64; ks += 2) {
            acc0 = __builtin_amdgcn_mfma_f32_16x16x32_bf16(*(const bf16x8*)(ap + ks * 32), *(const bf16x8*)(bp + ks * 32), acc0, 0, 0, 0);
            acc1 = __builtin_amdgcn_mfma_f32_16x16x32_bf16(*(const bf16x8*)(ap + ks * 32 + 32), *(const bf16x8*)(bp + ks * 32 + 32), acc1, 0, 0, 0);
        }
        const int h = lr & 7; const float al = -__expf(P.in[I_ALOG][l * 8 + h]), dtb = P.in[I_DTB][l * 8 + h];
#pragma unroll
        for (int j = 0; j < 4; ++j) {
            const float v = acc0[j] + acc1[j]; const int row = 16 * it + 4 * lq + j;
            if (lr < 8) betab[row * 8 + h] = sigmoid_(v); else ggb[row * 8 + h] = al * softplus_(v + dtb);
        }
    }
}
__device__ __forceinline__ void d1_prep(const KP& P, const int l, float* shm) {
    const int tidx_ = otid(), bidx_ = obid(); (void)tidx_; (void)bidx_;
    unsigned char* ws = ows(P.ws);
    const int tid = tidx_, w = tid >> 6, lane = tid & 63, lr = lane & 15, lq = lane >> 4;
    float* Am = shm;
    float* gc = Am + 64 * 68;
    float* bt = gc + 64;
    float* X = shm + 8192;
    const bf16_t* qn = (const bf16_t*)(ws + W_QKVN);
    const float* betab = (const float*)(ws + W_BETA); const float* ggb = (const float*)(ws + W_GG);
    float* DU = (float*)(ws + W_DU); bf16_t* DNW = (bf16_t*)(ws + W_DNW); bf16_t* DQD = (bf16_t*)(ws + W_DQD); bf16_t* DKDT = (bf16_t*)(ws + W_DKDT);
    bf16_t* DQK = (bf16_t*)(ws + W_DQK); float* DGL = (float*)(ws + W_DGL);
    bf16_t* DNW2 = (bf16_t*)(ws + W_DNW2);
    for (int T = bidx_; T < 1024; T += gridDim.x) {
        const int chain = T >> 5, n = T & 31, b = chain >> 3, h = chain & 7, r0 = b * 2048 + n * 64;
        const bf16_t* qp = qn + (size_t)r0 * 3072 + h * 128; const bf16_t* kp = qp + 1024; const bf16_t* vp = qp + 2048;
        if (w == 0) {
            float v = ggb[(size_t)(r0 + lane) * 8 + h];
#pragma unroll
            for (int o = 1; o < 64; o <<= 1) { const float t = __shfl_up(v, o); if (lane >= o) v += t; }
            gc[lane] = v; bt[lane] = betab[(size_t)(r0 + lane) * 8 + h];
        }
        __syncthreads();
        {
            const int rt = w & 3;
            bf16x8 ak[4], aq[4];
#pragma unroll
            for (int ks = 0; ks < 4; ++ks) { ak[ks] = *(const bf16x8*)(kp + (size_t)(16 * rt + lr) * 3072 + ks * 32 + lq * 8); aq[ks] = *(const bf16x8*)(qp + (size_t)(16 * rt + lr) * 3072 + ks * 32 + lq * 8); }
#pragma unroll
            for (int c2 = 0; c2 < 2; ++c2) {
                const int nt = 2 * (w >> 2) + c2;
                f32x4 ckk = {0.f, 0.f, 0.f, 0.f}, cqk = {0.f, 0.f, 0.f, 0.f};
#pragma unroll
                for (int ks = 0; ks < 4; ++ks) {
                    const bf16x8 bb = *(const bf16x8*)(kp + (size_t)(16 * nt + lr) * 3072 + ks * 32 + lq * 8);
                    ckk = __builtin_amdgcn_mfma_f32_16x16x32_bf16(ak[ks], bb, ckk, 0, 0, 0);
                    cqk = __builtin_amdgcn_mfma_f32_16x16x32_bf16(aq[ks], bb, cqk, 0, 0, 0);
                }
                const int jj = 16 * nt + lr; const float gj = gc[jj];
#pragma unroll
                for (int j = 0; j < 4; ++j) {
                    const int i = 16 * rt + 4 * lq + j; const float dec = __expf(fminf(gc[i] - gj, 0.f));
                    Am[i * 68 + jj] = (i > jj) ? bt[i] * ckk[j] * dec : 0.f;
                    DQK[(size_t)T * 4096 + i * 64 + jj] = f2bf((i >= jj) ? cqk[j] * dec : 0.f);
                }
            }
        }
        __syncthreads();
        {
            const int c = tid & 255, hf = tid >> 8; const bool isv = c < 128; const bf16_t* colp = isv ? vp + c : kp + (c - 128);
#pragma unroll 16
            for (int i2 = 0; i2 < 32; ++i2) { const int i = hf * 32 + i2; float rhs = bf2f(colp[(size_t)i * 3072]) * bt[i]; if (!isv) rhs *= __expf(gc[i]); X[i * 256 + c] = rhs; }
            const float glast = gc[63];
#pragma unroll 8
            for (int e = tid; e < 8192; e += 512) { const int i = e >> 7, d = e & 127; DQD[(size_t)T * 8192 + e] = f2bf(bf2f(qp[(size_t)i * 3072 + d]) * __expf(gc[i])); }
#pragma unroll 8
            for (int e = tid; e < 8192; e += 512) { const int d = e >> 6, i = e & 63; DKDT[(size_t)T * 8192 + e] = f2bf(bf2f(kp[(size_t)i * 3072 + d]) * __expf(glast - gc[i])); }
            if (tid == 0) DGL[T] = __expf(glast);
        }
        __syncthreads();
#pragma unroll
        for (int I = 0; I < 4; ++I) {
            if (I > 0) {
#pragma unroll
                for (int c2 = 0; c2 < 2; ++c2) {
                    const int ct = 2 * w + c2;
                    f32x4 acc = {0.f, 0.f, 0.f, 0.f};
#pragma unroll
                    for (int kk = 0; kk < 4 * I; ++kk)
                        acc = __builtin_amdgcn_mfma_f32_16x16x4f32(Am[(16 * I + lr) * 68 + 4 * kk + lq], X[(4 * kk + lq) * 256 + 16 * ct + lr], acc, 0, 0, 0);
#pragma unroll
                    for (int j = 0; j < 4; ++j) X[(16 * I + 4 * lq + j) * 256 + 16 * ct + lr] -= acc[j];
                }
                __syncthreads();
            }
            if (tid < 256) {
                float x[16];
#pragma unroll
                for (int r = 0; r < 16; ++r) x[r] = X[(16 * I + r) * 256 + tid];
#pragma unroll
                for (int r = 1; r < 16; ++r) {
                    float sacc = 0.f;
#pragma unroll
                    for (int j = 0; j < r; ++j) sacc += Am[(16 * I + r) * 68 + 16 * I + j] * x[j];
                    x[r] -= sacc;
                }
#pragma unroll
                for (int r = 1; r < 16; ++r) X[(16 * I + r) * 256 + tid] = x[r];
            }
            __syncthreads();
        }
        {
            const int c = tid & 255, hf = tid >> 8;
            if (c < 128) {
#pragma unroll 8
                for (int i2 = 0; i2 < 32; ++i2) { const int i = hf * 32 + i2; DU[(size_t)T * 8192 + i * 128 + c] = X[i * 256 + c]; }
            } else {
#pragma unroll 8
                for (int i2 = 0; i2 < 32; ++i2) { const int i = hf * 32 + i2; bf16_t hi_, lo_; split_bf(-X[i * 256 + c], hi_, lo_); DNW[(size_t)T * 8192 + i * 128 + (c - 128)] = hi_; DNW2[(size_t)T * 8192 + i * 128 + (c - 128)] = lo_; }
            }
        }
        __syncthreads();
    }
}
__device__ __forceinline__ void d1_mix(const KP& P, const int l) {
    const int tidx_ = otid(), bidx_ = obid(); (void)tidx_; (void)bidx_;
    unsigned char* ws = ows(P.ws);
    const int tid = tidx_, w = tid >> 6, lane = tid & 63, lr = lane & 15, lq = lane >> 4;
    const bf16_t* vcn = (const bf16_t*)(ws + W_VCN); const bf16_t* gu = (const bf16_t*)(ws + W_GU); bf16_t* yc = (bf16_t*)(ws + W_YC);
    for (int it = bidx_; it < 512; it += gridDim.x) {
        const int g = it & 7, cn = (it >> 3) & 15, b = it >> 7, r0 = b * 2048 + cn * 128;
        const float* wsg = P.in[I_WS] + ((size_t)l * 8 + g) * 128 * 128; const float* bsg = P.in[I_BS] + ((size_t)l * 8 + g) * 128;
        bf16x8 xv[4];
#pragma unroll
        for (int ks = 0; ks < 4; ++ks)
#pragma unroll
            for (int e = 0; e < 8; ++e) xv[ks][e] = (short)vcn[(size_t)(r0 + 32 * ks + 8 * lq + e) * 1024 + g * 128 + 16 * w + lr];
#pragma unroll
        for (int mt = 0; mt < 8; ++mt) {
            const int t = 16 * mt + lr;
            f32x4 acc = {0.f, 0.f, 0.f, 0.f};
#pragma unroll
            for (int ks = 0; ks < 4; ++ks) {
                if (32 * ks <= 16 * mt + 15) {
                    const float* wp = wsg + (size_t)t * 128 + 32 * ks + 8 * lq; const f32x4 w0 = *(const f32x4*)wp, w1 = *(const f32x4*)(wp + 4);
                    float wv[8] = {w0[0], w0[1], w0[2], w0[3], w1[0], w1[1], w1[2], w1[3]};
                    bf16x8 yw;
#pragma unroll
                    for (int e = 0; e < 8; ++e) yw[e] = (short)f2bf((32 * ks + 8 * lq + e <= t) ? wv[e] : 0.f);
                    acc = __builtin_amdgcn_mfma_f32_16x16x32_bf16(xv[ks], yw, acc, 0, 0, 0);
                }
            }
            const float bias = bsg[t]; const size_t o = (size_t)(r0 + t) * 1024 + g * 128 + 16 * w + 4 * lq;
            const u32x2 gw2 = *(const u32x2*)(gu + o);
            u32x2 r; r.x = pk2(lo16(gw2.x) * (acc[0] + bias), hi16(gw2.x) * (acc[1] + bias)); r.y = pk2(lo16(gw2.y) * (acc[2] + bias), hi16(gw2.y) * (acc[3] + bias));
            *(u32x2*)(yc + o) = r;
        }
    }
    for (int i = bidx_ * 512 + tidx_; i < MS * 128; i += gridDim.x * 512) {
        const int rs = i >> 7, c8 = (i & 127) * 8, t = rs & 3, g = c8 >> 7, r = MP + rs;
        const float* wsg = P.in[I_WS] + (((size_t)l * 8 + g) * 128 + t) * 128; const float bias = P.in[I_BS][((size_t)l * 8 + g) * 128 + t];
        float a[8];
#pragma unroll
        for (int e = 0; e < 8; ++e) a[e] = bias;
#pragma unroll
        for (int s = 0; s < 4; ++s) if (s <= t) { float x[8]; unpack8(*(const u32x4*)(vcn + (size_t)(r - t + s) * 1024 + c8), x); const float wv = wsg[s];
#pragma unroll
            for (int e = 0; e < 8; ++e) a[e] += wv * x[e]; }
        float gq[8]; unpack8(*(const u32x4*)(gu + (size_t)r * 1024 + c8), gq);
#pragma unroll
        for (int e = 0; e < 8; ++e) a[e] *= gq[e];
        *(u32x4*)(yc + (size_t)r * 1024 + c8) = pack8(a);
    }
}
__device__ __forceinline__ void d1_sample_delta(const KP& P, const int l, float* shm) {
    const int tidx_ = otid(), bidx_ = obid(); (void)tidx_; (void)bidx_;
    unsigned char* ws = ows(P.ws);
    const int tid = tidx_, dvq = tid & 31, dkg = tid >> 5, lane = tid & 63;
    float* part = shm;
    float* part2 = shm + 2048;
    float* qs = shm + 4096;
    float* ks = qs + 512; float* vs = ks + 512;
    const float* qns = (const float*)(ws + W_QKVNS); const float* betab = (const float*)(ws + W_BETA); const float* ggb = (const float*)(ws + W_GG);
    const bf16_t* zb = (const bf16_t*)(ws + W_Z); bf16_t* yb = (bf16_t*)(ws + W_YB);
    for (int it = bidx_ - 128; it < 1024; it += gridDim.x - 128) {
        const int b = it >> 3, h = it & 7;
        const size_t so = ((size_t)(l * 128 + b) * 8 + h) * 16384;
        const float* s0 = P.in[I_SD] + so; float* sout = P.out + OUT_DS + so;
        f32x4 S[8];
#pragma unroll
        for (int i = 0; i < 8; ++i) S[i] = __builtin_nontemporal_load((const f32x4*)(s0 + (size_t)(8 * dkg + i) * 128 + 4 * dvq));
        __syncthreads();
        for (int e = tid; e < 1536; e += 512) { const int t = (e >> 7) & 3, d = e & 127, wh = e >> 9; qs[e] = qns[(size_t)(b * 4 + t) * 3072 + wh * 1024 + h * 128 + d]; }
        __syncthreads();
#pragma unroll 1
        for (int t = 0; t < 4; ++t) {
            const int row = MP + b * 4 + t;
            const float a = __expf(ggb[(size_t)row * 8 + h]), be = betab[(size_t)row * 8 + h];
            f32x4 p = {0.f, 0.f, 0.f, 0.f};
#pragma unroll
            for (int i = 0; i < 8; ++i) p += ks[t * 128 + 8 * dkg + i] * S[i];
            *(f32x4*)(part + dkg * 128 + 4 * dvq) = p;
            __syncthreads();
            f32x4 kS = {0.f, 0.f, 0.f, 0.f};
#pragma unroll
            for (int j = 0; j < 16; ++j) kS += *(const f32x4*)(part + j * 128 + 4 * dvq);
            const f32x4 vv = *(const f32x4*)(vs + t * 128 + 4 * dvq);
            const f32x4 vn = be * (vv - a * kS);
            f32x4 po = {0.f, 0.f, 0.f, 0.f};
#pragma unroll
            for (int i = 0; i < 8; ++i) { S[i] = a * S[i] + ks[t * 128 + 8 * dkg + i] * vn; po += qs[t * 128 + 8 * dkg + i] * S[i]; }
            *(f32x4*)(part2 + dkg * 128 + 4 * dvq) = po;
            __syncthreads();
            if (tid < 64) {
                float o0 = 0.f, o1 = 0.f;
#pragma unroll
                for (int j = 0; j < 16; ++j) { o0 += part2[j * 128 + lane]; o1 += part2[j * 128 + 64 + lane]; }
                const float rstd = rsqrtf(wave_sum(o0 * o0 + o1 * o1) * (1.f / 128.f) + RMS_EPS);
                const float* ng = P.in[I_NBG] + (size_t)l * 128;
                const size_t o = (size_t)row * 1024 + h * 128;
                yb[o + lane] = f2bf(o0 * rstd * ng[lane] * silu_(bf2f(zb[o + lane])));
                yb[o + 64 + lane] = f2bf(o1 * rstd * ng[64 + lane] * silu_(bf2f(zb[o + 64 + lane])));
            }
        }
#pragma unroll
        for (int i = 0; i < 8; ++i) __builtin_nontemporal_store(S[i], (f32x4*)(sout + (size_t)(8 * dkg + i) * 128 + 4 * dvq));
    }
}

struct D2Frags { bf16x8 nwh[4], nwl[4], qd[4], qk[2], kd[2][2]; float u[4]; float gl; };
__device__ __forceinline__ void d2_load(D2Frags& f, const unsigned char* ws, const int T, const int rg, const int lr, const int lq, const int dvc) {
    const bf16_t* DNW = (const bf16_t*)(ws + W_DNW); const bf16_t* DNW2 = (const bf16_t*)(ws + W_DNW2); const bf16_t* DQD = (const bf16_t*)(ws + W_DQD);
    const bf16_t* DKDT = (const bf16_t*)(ws + W_DKDT); const bf16_t* DQK = (const bf16_t*)(ws + W_DQK);
    const unsigned o8 = (unsigned)T * 8192u + (unsigned)(16 * rg + lr) * 128u + lq * 8;
#pragma unroll
    for (int ks = 0; ks < 4; ++ks) { f.nwh[ks] = *(const bf16x8*)(DNW + o8 + ks * 32); f.nwl[ks] = *(const bf16x8*)(DNW2 + o8 + ks * 32); f.qd[ks] = *(const bf16x8*)(DQD + o8 + ks * 32); }
#pragma unroll
    for (int k2 = 0; k2 < 2; ++k2) {
        f.qk[k2] = *(const bf16x8*)(DQK + (unsigned)T * 4096u + (unsigned)(16 * rg + lr) * 64u + k2 * 32 + lq * 8);
#pragma unroll
        for (int t2 = 0; t2 < 2; ++t2) f.kd[t2][k2] = *(const bf16x8*)(DKDT + (unsigned)T * 8192u + (unsigned)(32 * rg + 16 * t2 + lr) * 64u + k2 * 32 + lq * 8);
    }
#pragma unroll
    for (int j = 0; j < 4; ++j) f.u[j] = ((const float*)(ws + W_DU))[(unsigned)T * 8192u + (unsigned)(16 * rg + 4 * lq + j) * 128u + dvc];
    f.gl = ((const float*)(ws + W_DGL))[T];
}
#define MF(a_, b_, c_) c_ = __builtin_amdgcn_mfma_f32_16x16x32_bf16(a_, b_, c_, 0, 0, 0)
__device__ __forceinline__ void d2_step(const D2Frags& cur, D2Frags& nxt, const unsigned char* ws, const int Tn, const int r0, const int h, const int rg, const int lr, const int lq, const int dvc,
                                        bf16_t* StH, bf16_t* StL, bf16_t* vnT, float* ob, f32x4 (&S)[2]) {
    d2_load(nxt, ws, Tn, rg, lr, lq, dvc);
    asm volatile("" ::: "memory");
    bf16x8 bSh[4], bSl[4];
#pragma unroll
    for (int ks = 0; ks < 4; ++ks) { bSh[ks] = *(const bf16x8*)(StH + lr * 136 + ks * 32 + lq * 8); bSl[ks] = *(const bf16x8*)(StL + lr * 136 + ks * 32 + lq * 8); }
    f32x4 av = {cur.u[0], cur.u[1], cur.u[2], cur.u[3]};
#pragma unroll
    for (int ks = 0; ks < 4; ++ks) { MF(cur.nwh[ks], bSh[ks], av); MF(cur.nwh[ks], bSl[ks], av); MF(cur.nwl[ks], bSh[ks], av); }
    { u32x2 q; q.x = pk2(av[0], av[1]); q.y = pk2(av[2], av[3]); *(u32x2*)(vnT + lr * 72 + 16 * rg + 4 * lq) = q; }
    f32x4 ao = {0.f, 0.f, 0.f, 0.f};
#pragma unroll
    for (int ks = 0; ks < 4; ++ks) { MF(cur.qd[ks], bSh[ks], ao); MF(cur.qd[ks], bSl[ks], ao); }
    __syncthreads();
    bf16x8 bV[2];
#pragma unroll
    for (int k2 = 0; k2 < 2; ++k2) bV[k2] = *(const bf16x8*)(vnT + lr * 72 + k2 * 32 + lq * 8);
#pragma unroll
    for (int k2 = 0; k2 < 2; ++k2) MF(cur.qk[k2], bV[k2], ao);
#pragma unroll
    for (int t2 = 0; t2 < 2; ++t2) {
        S[t2] *= cur.gl;
#pragma unroll
        for (int k2 = 0; k2 < 2; ++k2) MF(cur.kd[t2][k2], bV[k2], S[t2]);
        float hf[4], lf[4];
#pragma unroll
        for (int j = 0; j < 4; ++j) { hf[j] = bf2f(f2bf(S[t2][j])); lf[j] = S[t2][j] - hf[j]; }
        u32x2 q; q.x = pk2(hf[0], hf[1]); q.y = pk2(hf[2], hf[3]); *(u32x2*)(StH + lr * 136 + 32 * rg + 16 * t2 + 4 * lq) = q;
        q.x = pk2(lf[0], lf[1]); q.y = pk2(lf[2], lf[3]); *(u32x2*)(StL + lr * 136 + 32 * rg + 16 * t2 + 4 * lq) = q;
    }
#pragma unroll
    for (int j = 0; j < 4; ++j) ob[(unsigned)(r0 + 16 * rg + 4 * lq + j) * 1024u + h * 128 + dvc] = ao[j];
    __syncthreads();
}
__device__ __forceinline__ void d2_scan(const KP& P, const int l, unsigned char* shmb) {
    const int tidx_ = otid(), bidx_ = obid(); (void)tidx_; (void)bidx_;
    unsigned char* ws = ows(P.ws);
    const int tid = tidx_, w = tid >> 6, lane = tid & 63, lr = lane & 15, lq = lane >> 4, sl = w >> 2, rg = w & 3;
    bf16_t* StH = (bf16_t*)(shmb + sl * 11008); bf16_t* StL = StH + 16 * 136; bf16_t* vnT = StL + 16 * 136;
    float* ob = (float*)(ws + W_OB);
    for (int item = bidx_; item < 128; item += gridDim.x) {
        const int chain = item >> 2, dq = item & 3, b = chain >> 3, h = chain & 7, dv0 = 32 * dq + 16 * sl, dvc = dv0 + lr;
        f32x4 S[2];
        S[0] = (f32x4){0.f, 0.f, 0.f, 0.f}; S[1] = (f32x4){0.f, 0.f, 0.f, 0.f};
        __syncthreads();
        for (int e = tid; e < 2 * 11008 / 4; e += 512) ((unsigned*)shmb)[e] = 0u;
        __syncthreads();
        D2Frags fa, fb; d2_load(fa, ws, chain * 32, rg, lr, lq, dvc);
#pragma unroll 1
        for (int n = 0; n < 32; n += 2) {
            const int T = chain * 32 + n, r0 = b * 2048 + n * 64;
            d2_step(fa, fb, ws, T + 1, r0, h, rg, lr, lq, dvc, StH, StL, vnT, ob, S);
            d2_step(fb, fa, ws, (n < 30) ? T + 2 : T + 1, r0 + 64, h, rg, lr, lq, dvc, StH, StL, vnT, ob, S);
        }
        float* sout = P.out + OUT_DP + ((size_t)(l * 4 + b) * 8 + h) * 16384;
#pragma unroll
        for (int t2 = 0; t2 < 2; ++t2)
#pragma unroll
            for (int j = 0; j < 4; ++j) sout[(unsigned)(32 * rg + 16 * t2 + 4 * lq + j) * 128u + dvc] = S[t2][j];
    }
}
#undef MF
__device__ __forceinline__ void onorm(const KP& P, const int l) {
    const int tidx_ = otid(), bidx_ = obid(); (void)tidx_; (void)bidx_;
    unsigned char* ws = ows(P.ws);
    const int lane = tidx_ & 63, gw = bidx_ * 8 + (tidx_ >> 6), ngw = gridDim.x * 8;
    const float* ob = (const float*)(ws + W_OB); const bf16_t* zb = (const bf16_t*)(ws + W_Z); bf16_t* yb = (bf16_t*)(ws + W_YB);
    const float* ng = P.in[I_NBG] + (size_t)l * 128 + (lane & 7) * 16;
    for (int r = gw; r < MP; r += ngw) {
        const unsigned o = (unsigned)r * 1024u + lane * 16;
        float x[16]; float ss = 0.f;
#pragma unroll
        for (int q = 0; q < 4; ++q) { const f32x4 v = *(const f32x4*)(ob + o + 4 * q); x[4 * q] = v[0]; x[4 * q + 1] = v[1]; x[4 * q + 2] = v[2]; x[4 * q + 3] = v[3]; ss += (v[0] * v[0] + v[1] * v[1]) + (v[2] * v[2] + v[3] * v[3]); }
        ss += __shfl_xor(ss, 1); ss += __shfl_xor(ss, 2); ss += __shfl_xor(ss, 4);
        const float rstd = rsqrtf(ss * (1.f / 128.f) + RMS_EPS);
        float z0[8], z1[8]; unpack8(*(const u32x4*)(zb + o), z0); unpack8(*(const u32x4*)(zb + o + 8), z1);
        float y0[8], y1[8];
#pragma unroll
        for (int e = 0; e < 8; ++e) { y0[e] = x[e] * rstd * ng[e] * silu_(z0[e]); y1[e] = x[8 + e] * rstd * ng[8 + e] * silu_(z1[e]); }
        *(u32x4*)(yb + o) = pack8(y0); *(u32x4*)(yb + o + 8) = pack8(y1);
    }
}

__device__ __forceinline__ void phase_f(const KP& P, const int l) {
    const int tidx_ = otid(), bidx_ = obid(); (void)tidx_; (void)bidx_;
    unsigned char* ws = ows(P.ws);
    const bf16_t* hg = (const bf16_t*)(ws + W_HG); const bf16_t* hu = (const bf16_t*)(ws + W_HU); bf16_t* hh = (bf16_t*)(ws + W_H);
    const float* cw = P.in[I_CFW] + (size_t)l * 3 * DFF; const float* hist = P.in[I_SCF] + (size_t)l * 128 * 2 * DFF;
    constexpr int C8 = DFF / 8;
    for (int i = bidx_ * 512 + tidx_; i < (MT / 4) * C8; i += gridDim.x * 512) {
        const int q = i / C8, c8 = (i % C8) * 8, r0 = 4 * q;
        const bool smp = r0 >= MP; const int t0 = smp ? 0 : (r0 & 2047), sb = (r0 - MP) >> 2;
        float x[6][8];
#pragma unroll
        for (int d = 0; d < 2; ++d) {
            if (t0 > 0) unpack8(*(const u32x4*)(hg + (size_t)(r0 - 2 + d) * DFF + c8), x[d]);
            else if (smp) { const float* hp = hist + ((size_t)sb * 2 + d) * DFF + c8; const f32x4 h0 = *(const f32x4*)hp, h1 = *(const f32x4*)(hp + 4);
#pragma unroll
                for (int j = 0; j < 4; ++j) { x[d][j] = h0[j]; x[d][4 + j] = h1[j]; } }
            else {
#pragma unroll
                for (int j = 0; j < 8; ++j) x[d][j] = 0.f; }
        }
#pragma unroll
        for (int d = 0; d < 4; ++d) unpack8(*(const u32x4*)(hg + (size_t)(r0 + d) * DFF + c8), x[2 + d]);
        float w[3][8];
#pragma unroll
        for (int d = 0; d < 3; ++d) { const f32x4 w0 = *(const f32x4*)(cw + d * DFF + c8), w1 = *(const f32x4*)(cw + d * DFF + c8 + 4);
#pragma unroll
            for (int j = 0; j < 4; ++j) { w[d][j] = w0[j]; w[d][4 + j] = w1[j]; } }
#pragma unroll
        for (int d = 0; d < 4; ++d) {
            float u[8], a[8]; unpack8(*(const u32x4*)(hu + (size_t)(r0 + d) * DFF + c8), u);
#pragma unroll
            for (int j = 0; j < 8; ++j) a[j] = silu_(w[0][j] * x[d][j] + w[1][j] * x[d + 1][j] + w[2][j] * x[d + 2][j]) * u[j];
            *(u32x4*)(hh + (size_t)(r0 + d) * DFF + c8) = pack8(a);
        }
    }
}

#define XB_TMO      128
#define XB_XCNT(j)  (256  + 64 * (j))
#define XB_XSUB(j)  (1280 + 64 * (j))
#define XB_XGEN(j)  (2304 + 64 * (j))
#define XB_TOP      3328
#define XB_TOPGEN   3392
#define XCD_BAR_WORDS 3456
#define XB_SPIN_CAP (1u << 18)

__device__ __forceinline__ unsigned xb_ld(unsigned* p)              { return __hip_atomic_load(p, __ATOMIC_RELAXED, __HIP_MEMORY_SCOPE_AGENT); }
__device__ __forceinline__ unsigned xb_add(unsigned* p, unsigned v) { return __hip_atomic_fetch_add(p, v, __ATOMIC_RELAXED, __HIP_MEMORY_SCOPE_AGENT); }
__device__ __forceinline__ unsigned xb_xcc_id() { return (unsigned)__builtin_amdgcn_s_getreg((3 << 11) | 20) & 0xFu; }
#define XB_SPIN(cond, bar) do { unsigned _sp = 0; while (cond) { __builtin_amdgcn_s_sleep(1); \
    if ((++_sp & 255u) == 0u) { if (xb_ld(&(bar)[XB_TMO])) break; if (_sp > XB_SPIN_CAP) { atomicAdd(&(bar)[XB_TMO], 1u); break; } } } } while (0)

struct XcdBarrier {
    unsigned* bar; unsigned x;
    volatile LAS unsigned* st;
};

__device__ __forceinline__ XcdBarrier xcd_barrier_post(unsigned* bar, volatile LAS unsigned* st) {
    XcdBarrier b; b.bar = bar; b.x = xb_xcc_id(); b.st = st;
    if (threadIdx.x == 0) (void)xb_add(&bar[XB_XCNT(b.x)], 1u);
    return b;
}
__device__ __forceinline__ void xcd_barrier_complete(unsigned* bar, unsigned x, unsigned& nloc, unsigned& nx) {
    const unsigned G = gridDim.x * gridDim.y * gridDim.z;
    unsigned sum, cnt, mine, sp = 0u;
    for (;;) {
        sum = 0u; cnt = 0u; mine = 0u;
#pragma unroll
        for (unsigned j = 0; j < 16; ++j) { const unsigned c = xb_ld(&bar[XB_XCNT(j)]); sum += c; cnt += (c > 0u) ? 1u : 0u; mine = (j == x) ? c : mine; }
        if (sum == G) break;
        __builtin_amdgcn_s_sleep(1);
        if ((++sp & 255u) == 0u) { if (xb_ld(&bar[XB_TMO])) break; if (sp > XB_SPIN_CAP) { atomicAdd(&bar[XB_TMO], 1u); break; } }
    }
    nloc = mine > 0u ? mine : 1u; nx = cnt > 0u ? cnt : 1u;
}

__device__ __forceinline__ void xcd_barrier(const XcdBarrier& b) {
    asm volatile("s_waitcnt vmcnt(0)" ::: "memory");
    __syncthreads();
    if (threadIdx.x == 0) {
        unsigned* bar = b.bar;
        __builtin_amdgcn_s_waitcnt(0);
        unsigned nloc = b.st[0], nx = b.st[1];
        if (nloc == 0u) { xcd_barrier_complete(bar, b.x, nloc, nx); b.st[0] = nloc; b.st[1] = nx; }
        const unsigned old = xb_add(&bar[XB_XSUB(b.x)], 1u);
        const unsigned gen = old / nloc;
        if (old + 1u == (gen + 1u) * nloc) {
            __builtin_amdgcn_fence(__ATOMIC_RELEASE, "agent");
            asm volatile("s_waitcnt vmcnt(0)" ::: "memory");
            const unsigned og = xb_add(&bar[XB_TOP], 1u);
            const unsigned tg = og / nx;
            if (og + 1u == (tg + 1u) * nx) xb_add(&bar[XB_TOPGEN], 1u);
            else XB_SPIN(xb_ld(&bar[XB_TOPGEN]) == tg, bar);
            __builtin_amdgcn_fence(__ATOMIC_ACQUIRE, "agent");
            xb_add(&bar[XB_XGEN(b.x)], 1u);
            asm volatile("s_waitcnt vmcnt(0)" ::: "memory");
        } else {
            XB_SPIN(xb_ld(&bar[XB_XGEN(b.x)]) == gen, bar);
            __builtin_amdgcn_fence(__ATOMIC_ACQUIRE, "agent");
            asm volatile("s_waitcnt vmcnt(0)" ::: "memory");
        }
    }
    __syncthreads();
}

enum { K_G1 = 0, K_E, K_D1, K_D2, K_G2A, K_G2B, K_G3, K_LN1, K_G4, K_F, K_G5, K_LN2, K_PER_LAYER };
constexpr int N_PHASES = 1 + 2 * K_PER_LAYER;

__global__ void __launch_bounds__(512, 2) mega(const KP P, const int ph_lo, const int ph_hi) {
    extern __shared__ __attribute__((aligned(16))) unsigned char shm[];
    cg::grid_group grid = cg::this_grid();
    unsigned char* const ws = P.ws;
    volatile LAS unsigned* xst = (volatile LAS unsigned*)((LAS unsigned char*)shm + STAGE_BYTES);
    if (threadIdx.x == 0) { xst[0] = 0u; xst[1] = 0u; xst[2] = 0u; xst[3] = 0u; }
    __syncthreads();
    (void)xcd_barrier_post((unsigned*)(ws + W_BAR), xst);
    int again = 0;
#pragma unroll 1
    for (int ph = ph_lo; ph < ph_hi;) {
        if (ph == 0) {
#if !defined(PHSEL) || PHSEL == 0
            ln_rows(P, 0, P.in[I_LNG], P.in[I_LNB], false);
#endif
#if !defined(PHSEL) || PHSEL == 1
#endif
        } else {
            const int l = (ph - 1) / K_PER_LAYER, k = (ph - 1) % K_PER_LAYER;
            Gemm g; g.A = nullptr; g.Bt = nullptr; g.M = MT; g.N = 0; g.K = 0; int mode = -1;
            switch (k) {
                case K_G1: g.A = (const bf16_t*)(ws + W_XB); g.Bt = (const bf16_t*)(ws + W_WIN); g.N = NV1 - 256; g.K = 2048; mode = M_G1; break;
                case K_G2A: g.A = (const bf16_t*)(ws + W_YA); g.Bt = (const bf16_t*)(ws + W_WA); g.N = 2048; g.K = 1024; mode = M_G2A; break;
                case K_G2B: g.A = (const bf16_t*)(ws + W_YB); g.Bt = (const bf16_t*)(ws + W_WB); g.N = 2048; g.K = 1024; mode = M_G2B; break;
                case K_G3: g.A = (const bf16_t*)(ws + W_MGB); g.Bt = (const bf16_t*)(ws + W_WO); g.N = 2048; g.K = 2048; mode = M_G3; break;
                case K_G4: g.A = (const bf16_t*)(ws + W_XB); g.Bt = (const bf16_t*)(ws + W_WUP); g.N = NV4; g.K = 2048; mode = M_G4; break;
                case K_G5: g.A = (const bf16_t*)(ws + W_H); g.Bt = (const bf16_t*)(ws + W_WDN); g.N = 2048; g.K = DFF; mode = M_G5; break;
                default: break;
            }
            if (mode >= 0) {
#if !defined(PHSEL) || PHSEL == 2
                const int npass = (k == K_G2A) ? 3 : 1;
#pragma unroll 1
                for (int pass = 0; pass < npass; ++pass) {
                    int cblk = (int)blockIdx.x, G = (int)gridDim.x; bool skip = false;
                    if (pass == 1) {
                        g.A = (const bf16_t*)(ws + W_YC); g.Bt = (const bf16_t*)(ws + W_WC); mode = M_G2C; cblk = (cblk + G / 2) % G;
                    } else if (pass == 2) {
                        g.A = (const bf16_t*)(ws + W_PB); g.Bt = (const bf16_t*)(ws + W_WPE); g.K = 256; mode = M_PE;
                        skip = (cblk < 16) || (cblk >= 128 && cblk < 144); cblk -= (cblk < 128) ? 16 : 32; G -= 32;
                    }
                    if (!skip) {
                        const int split = ((mode == M_G3 || mode == M_G5) && gridDim.x == 256) ? 1 : 0;
                        StaticOrder S; S.init(split ? MP : g.M, g.N, g.K, G, cblk, split);
                        gemm_phase((LAS unsigned char*)shm, g, S, P, mode, l);
                    }
                }
#endif
                if (k == K_G2A) onorm(P, l);
            } else if (k == K_E) {
#if !defined(PHSEL) || PHSEL == 3
                beta_gate(P, l);
                phase_e(P, l);
#endif
            } else if (k == K_D1) {
#if !defined(PHSEL) || PHSEL == 4
                d1_prep(P, l, (float*)shm);
#endif
#if !defined(PHSEL) || PHSEL == 5
                d1_mix(P, l);
#endif

            } else if (k == K_D2) {
#if !defined(PHSEL) || PHSEL == 7
                if (blockIdx.x < 128) d2_scan(P, l, shm);
                else d1_sample_delta(P, l, (float*)shm);
#endif
            } else if (k == K_LN1) {
                ln_rows(P, 1, P.in[I_L1G] + (size_t)l * DM, P.in[I_L1B] + (size_t)l * DM, false);
            } else if (k == K_F) {
#if !defined(PHSEL) || PHSEL == 8
                phase_f(P, l);
#endif
            } else if (k == K_LN2) {
                ln_rows(P, 1, P.in[I_L2G] + (size_t)l * DM, P.in[I_L2B] + (size_t)l * DM, l == 1);
            }
        }
        {
            int cl = -1, cpart = (gridDim.x == 256) ? 0 : 3, cb0 = 0, cnb = (int)gridDim.x; const int cb = (int)blockIdx.x;
            if (ph == 0) cl = 0;
            else { const int l2 = (ph - 1) / K_PER_LAYER, k2 = (ph - 1) % K_PER_LAYER;
                if (k2 == K_LN2 && l2 == 0) cl = 1;
                else if (k2 == K_G2B && blockIdx.x >= 16) { cl = l2; cpart = 1; cb0 = 16; cnb -= 16; }
                else if (k2 == K_G2A && gridDim.x == 256 && !(cb < 16 || (cb >= 128 && cb < 144))) { cl = l2; cpart = 2; cb0 = (cb < 128) ? 16 : 32; cnb = 224; } }
            if (cl >= 0) convert_weights(P, cl, (float*)shm, cpart, cb - cb0, cnb);
        }
#ifdef REPMASK
        {
            const int k = ph == 0 ? -1 : (ph - 1) % K_PER_LAYER; int bit = -1;
            if (ph == 0 || k == K_LN2) bit = 0; else if (k == K_E || k == K_F) bit = 1; else if (k == K_D1) bit = 2; else if (k == K_D2) bit = 3;
            else if (k == K_G1 || k == K_G5) bit = 4; else if (k == K_G3) bit = 5; else if (k == K_LN1) bit = 6;
            if (!again && bit >= 0 && ((REPMASK >> bit) & 1)) again = 1; else { again = 0; ++ph; }
        }
#else
        ++ph; (void)again;
#endif
        if (ph < ph_hi) { if (ph_hi < 0) grid.sync();   { XcdBarrier xb; xb.bar = (unsigned*)(ows(P.ws) + W_BAR); xb.x = xb_xcc_id(); xb.st = (volatile LAS unsigned*)((LAS unsigned char*)shm + STAGE_BYTES); xcd_barrier(xb); } }
    }
}

extern "C" void kernel_launch(void* const* d_in, const int* in_sizes, int n_in, void* d_out, int out_size, void* d_ws, size_t ws_size, hipStream_t stream) {
    static int grid_blocks = 0;
    constexpr int LDS_BYTES = STAGE_BYTES + 256;
    if (grid_blocks == 0) {
        if (n_in != 33 || (size_t)out_size != OUT_END || ws_size < WS_TOTAL) {
            fprintf(stderr, "kernel_launch: unexpected problem (n_in %d, out %d vs %zu, ws %zu vs %zu)\n", n_in, out_size, (size_t)OUT_END, ws_size, (size_t)WS_TOTAL);
            grid_blocks = -1; return;
        }
        int dev = 0, cus = 0, per_cu = 0;
        hipGetDevice(&dev);
        hipDeviceGetAttribute(&cus, hipDeviceAttributeMultiprocessorCount, dev);
        hipFuncSetAttribute((const void*)mega, hipFuncAttributeMaxDynamicSharedMemorySize, LDS_BYTES);
        hipOccupancyMaxActiveBlocksPerMultiprocessor(&per_cu, (const void*)mega, 512, LDS_BYTES);
        if (per_cu < 1) per_cu = 1;
        grid_blocks = cus * 1;
        (void)hipGetLastError();
    }
    if (grid_blocks < 0) return;
    if (hipMemsetAsync((unsigned char*)d_ws + W_BAR, 0, XCD_BAR_WORDS * sizeof(unsigned), stream) != hipSuccess) { fprintf(stderr, "kernel_launch: memset of the barrier words failed\n"); return; }
    KP p{};
    for (int i = 0; i < 33; ++i) p.in[i] = (const float*)d_in[i];
    p.out = (float*)d_out; p.ws = (unsigned char*)d_ws;
    int lo = 0, hi = N_PHASES;
    void* args[] = {&p, &lo, &hi};
    hipError_t e = hipLaunchCooperativeKernel((const void*)mega, dim3(grid_blocks), dim3(512), args, LDS_BYTES, stream);
    if (e != hipSuccess) fprintf(stderr, "cooperative launch failed: %s (grid %d)\n", hipGetErrorString(e), grid_blocks);
}
```

```cpp
#include <hip/hip_runtime.h>
#include <hip/hip_cooperative_groups.h>
#include <cstdio>
#include <cstdint>
namespace cg = cooperative_groups;

#define LAS __attribute__((address_space(3)))
typedef unsigned short bf16_t;
typedef short bf16x8 __attribute__((ext_vector_type(8)));
typedef float f32x4 __attribute__((ext_vector_type(4)));
typedef unsigned u32x4 __attribute__((ext_vector_type(4)));
typedef unsigned u32x2 __attribute__((ext_vector_type(2)));

constexpr int DM = 2048, NBP = 4, SEQ = 2048, NBS = 128, DSQ = 4;
constexpr int MP = NBP * SEQ, MS = NBS * DSQ, MT = MP + MS;
constexpr int DPLE = 256, DA = 1024, HB = 8, DB = 1024, DC = 1024, DFF = 5504, NIN = 15376;
constexpr int NV1 = 61 * 256, NV4 = 2 * DFF + DM;
constexpr float ALPHA = 1.41421356237f, LN_EPS = 1e-5f, RMS_EPS = 1e-6f;

constexpr size_t OUT_YP = 0, OUT_YS = OUT_YP + (size_t)MP * DM, OUT_CAP = OUT_YS + (size_t)MS * DM, OUT_CQP = OUT_CAP + 2 * 4 * 2 * 1024,
                 OUT_DP = OUT_CQP + 2 * 4 * 3 * 3072, OUT_CFP = OUT_DP + 2 * 4 * 8 * 16384, OUT_CAS = OUT_CFP + 2 * 4 * 2 * 5504,
                 OUT_CQS = OUT_CAS + 2 * 128 * 2 * 1024, OUT_DS = OUT_CQS + 2 * 128 * 3 * 3072, OUT_CFS = OUT_DS + (size_t)2 * 128 * 8 * 16384,
                 OUT_VS = OUT_CFS + 2 * 128 * 2 * 5504, OUT_END = OUT_VS + 2 * 128 * 4 * 1024;

constexpr size_t al256(size_t x) { return (x + 255) & ~(size_t)255; }
constexpr size_t W_WIN = 0, W_WA = W_WIN + (size_t)NV1 * 2048 * 2, W_WB = W_WA + (size_t)2048 * 1024 * 2, W_WC = W_WB + (size_t)2048 * 1024 * 2,
                 W_WO = W_WC + (size_t)2048 * 1024 * 2, W_WUP = W_WO + (size_t)2048 * 2048 * 2, W_WDN = W_WUP + (size_t)NV4 * 2048 * 2,
                 W_WPE = W_WDN + (size_t)2048 * DFF * 2, W_XRES = W_WPE + (size_t)2048 * 256 * 2, W_XB = W_XRES + (size_t)MT * DM * 4,
                 W_PRE = W_XB + (size_t)MT * DM * 2, W_PB = W_PRE + (size_t)MT * DM * 4, W_R = W_PB + (size_t)MT * DPLE * 2;
constexpr size_t W_CH = W_R, W_BG = W_CH + (size_t)MT * 1024 * 2, W_QKV = W_BG + (size_t)MT * 1024 * 2, W_Z = W_QKV + (size_t)MT * 3072 * 2,
                 W_GU = W_Z + (size_t)MT * 1024 * 2, W_GV = W_GU + (size_t)MT * 1024 * 2, W_GTS = W_GV + (size_t)MT * 1024 * 2,
                 W_BETA = W_GTS + (size_t)MT * 6144 * 2, W_GG = W_BETA + al256((size_t)MT * 8 * 4), W_YA = W_GG + al256((size_t)MT * 8 * 4),
                 W_YB = W_YA + (size_t)MT * 1024 * 2, W_YC = W_YB + (size_t)MT * 1024 * 2, W_QKVN = W_YC + (size_t)MT * 1024 * 2,
                 W_QKVNS = W_QKVN + (size_t)MT * 3072 * 2, W_VCN = W_QKVNS + (size_t)MS * 3072 * 4, W_DU = W_VCN + (size_t)MT * 1024 * 2,
                 W_DNW = W_DU + (size_t)1024 * 8192 * 4, W_DQD = W_DNW + (size_t)1024 * 8192 * 2, W_DKDT = W_DQD + (size_t)1024 * 8192 * 2,
                 W_DQK = W_DKDT + (size_t)1024 * 8192 * 2, W_DNW2 = W_DQK + (size_t)1024 * 4096 * 2, W_OB = W_DNW2 + (size_t)1024 * 8192 * 2,
                 W_DGL = W_OB + (size_t)MP * 1024 * 4, W_MG32 = W_DGL + 4096,
                 W_MGB = W_MG32 + (size_t)MT * DM * 4, W_REND = W_MGB + (size_t)MT * DM * 2;
constexpr size_t W_PE = W_R, W_HG = W_PE + (size_t)MT * DM * 4, W_HU = W_HG + (size_t)MT * DFF * 2, W_H = W_HU + (size_t)MT * DFF * 2,
                 W_FEND = W_H + (size_t)MT * DFF * 2;
constexpr size_t W_MG32C = W_VCN;
static_assert(W_MG32C + (size_t)MT * DM * 4 <= W_DKDT, "MG32C overlay");
constexpr size_t W_PART = W_VCN;
static_assert(W_PART >= W_FEND && W_PART + (size_t)16 * MS * DM * 4 <= W_OB, "partial buffer overlay");
constexpr size_t WS_NEED = W_REND > W_FEND ? W_REND : W_FEND;
constexpr size_t W_BAR = WS_NEED;
constexpr size_t WS_TOTAL = W_BAR + 16384;
static_assert(WS_TOTAL <= (size_t)1007681536, "workspace too large");

struct KP { const float* in[33]; float* out; unsigned char* ws; };
enum { I_XP = 0, I_XS, I_SCA, I_SCQ, I_SD, I_SCF, I_PP, I_PS, I_LNG, I_LNB, I_WIN, I_CAW, I_WAO, I_CBW, I_ALOG, I_DTB, I_NBG, I_WBO, I_LCG, I_LCB, I_WS, I_BS,
       I_WCO, I_WO, I_L1G, I_L1B, I_WUP, I_CFW, I_WDN, I_WPE, I_WPG, I_L2G, I_L2B };

__device__ __forceinline__ float bf2f(bf16_t h) { return __uint_as_float(((unsigned)h) << 16); }
__device__ __forceinline__ bf16_t f2bf(float f) { unsigned u = __float_as_uint(f); u += 0x7FFFu + ((u >> 16) & 1u); return (bf16_t)(u >> 16); }
typedef __bf16 bf16x2_t __attribute__((ext_vector_type(2)));
typedef float f32x2_t __attribute__((ext_vector_type(2)));
__device__ __forceinline__ unsigned pk2(float lo, float hi) { const bf16x2_t r = __builtin_convertvector((f32x2_t){lo, hi}, bf16x2_t); return __builtin_bit_cast(unsigned, r); }
__device__ __forceinline__ void split_bf(float x, bf16_t& hi, bf16_t& lo) { hi = f2bf(x); lo = f2bf(x - bf2f(hi)); }
__device__ __forceinline__ float lo16(unsigned w) { return __uint_as_float(w << 16); }
__device__ __forceinline__ float hi16(unsigned w) { return __uint_as_float(w & 0xffff0000u); }
__device__ __forceinline__ void unpack8(u32x4 w, float (&f)[8]) { f[0] = lo16(w.x); f[1] = hi16(w.x); f[2] = lo16(w.y); f[3] = hi16(w.y); f[4] = lo16(w.z); f[5] = hi16(w.z); f[6] = lo16(w.w); f[7] = hi16(w.w); }
__device__ __forceinline__ u32x4 pack8(const float (&f)[8]) { u32x4 w; w.x = pk2(f[0], f[1]); w.y = pk2(f[2], f[3]); w.z = pk2(f[4], f[5]); w.w = pk2(f[6], f[7]); return w; }
__device__ __forceinline__ float sigmoid_(float x) { return __builtin_amdgcn_rcpf(1.f + __expf(-x)); }
__device__ __forceinline__ float silu_(float x) { return x * __builtin_amdgcn_rcpf(1.f + __expf(-x)); }
__device__ __forceinline__ float gelu_(float x) { const float y = 1.5957691216f * (x + 0.044715f * x * x * x); return x * __builtin_amdgcn_rcpf(1.f + __expf(-y)); }
__device__ __forceinline__ float softplus_(float x) { return x > 20.f ? x : log1pf(__expf(x)); }
__device__ __forceinline__ float wave_sum(float v) {
#pragma unroll
    for (int o = 1; o < 64; o <<= 1) v += __shfl_xor(v, o);
    return v;
}

__device__ __forceinline__ int otid() { int t = (int)threadIdx.x; asm volatile("" : "+v"(t)); return t; }
__device__ __forceinline__ int obid() { int t = (int)blockIdx.x; asm volatile("" : "+s"(t)); return t; }
__device__ __forceinline__ unsigned char* ows(const unsigned char* p) { unsigned long long v = (unsigned long long)p; asm volatile("" : "+s"(v)); return (unsigned char*)(__attribute__((address_space(1))) unsigned char*)v; }
constexpr int BM = 256, BK = 64, HALF = 128, HTB = HALF * BK * 2, STAGE_BYTES = 8 * HTB, NXCD = 8, WGM = 8;
__device__ __forceinline__ int lds_byte(int r, int c) { const int st = (r >> 4) * 2 + (c >> 5), rr = r & 15, cc = c & 31, ob = rr * 64 + cc * 2; return st * 1024 + (ob ^ (((ob >> 9) & 1) << 5)); }
__device__ __forceinline__ void stage_rc(int b, int& R, int& C) { const int st = b / 1024, sb = b % 1024, swz = sb ^ (((sb >> 9) & 1) << 5); R = (st >> 1) * 16 + swz / 64; C = (st & 1) * 32 + (swz % 64) / 2; }
__device__ __forceinline__ int perm32(int rho) { const int n = rho >> 4, i = rho & 15; return 8 * (i >> 2) + 4 * n + (i & 3); }
struct Unit { int pm, pn, k0, nt, part; };
struct Gemm { const bf16_t* A; const bf16_t* Bt; int M, N, K; };
struct StaticOrder {
    int nM, nN, nwg, G, c, ntf, split;
    __device__ __forceinline__ void init(int M, int N, int K, int G_, int c_, int split_) { nM = M / BM; nN = N / BM; nwg = nM * nN; G = G_; c = c_; ntf = K / BK; split = split_; }
    __device__ __forceinline__ bool next(int i, Unit& u) const {
        u.k0 = 0; u.nt = ntf; u.part = -1;
        if (split) {
            if (i >= 2) return false;
            if (i == 0) { const int su = c >> 4, ks = c & 15, np = ntf >> 1, p0 = (np * ks) >> 4, p1 = (np * (ks + 1)) >> 4;
                u.pm = 32 + (su >> 3); u.pn = su & 7; u.k0 = 2 * p0; u.nt = 2 * (p1 - p0); u.part = ks; return true; }
        }
        const long L = split ? (long)c : (long)i * G + c; if (L >= nwg) return false;
        int wgid = (int)L; { const int q = nwg / NXCD, r = nwg % NXCD, xcd = wgid % NXCD, off = wgid / NXCD; wgid = (xcd < r ? xcd * (q + 1) : r * (q + 1) + (xcd - r) * q) + off; }
        const int nig = WGM * nN, gid = wgid / nig, fm = gid * WGM, gsz = (nM - fm) < WGM ? (nM - fm) : WGM;
        u.pm = fm + ((wgid % nig) % gsz); u.pn = (wgid % nig) / gsz; return true;
    }
};

enum { M_G1 = 0, M_G2A, M_G2B, M_G2C, M_G3, M_PE, M_G4, M_G5 };

__device__ __forceinline__ void st8bf(bf16_t* p, f32x4 a, f32x4 b) { u32x4 w; w.x = pk2(a[0], a[1]); w.y = pk2(a[2], a[3]); w.z = pk2(b[0], b[1]); w.w = pk2(b[2], b[3]); *(u32x4*)p = w; }
__device__ __forceinline__ void st8f(float* p, f32x4 a, f32x4 b) { *(f32x4*)p = a; *(f32x4*)(p + 4) = b; }
__device__ __forceinline__ bool tail_row(int r, int nk, int& seq, int& i, bool& smp) {
    if (r < MP) { seq = r >> 11; smp = false; i = (r & 2047) - (2048 - nk); return i >= 0; }
    const int rs = r - MP; seq = rs >> 2; smp = true; i = (rs & 3) - (4 - nk); return i >= 0;
}

__device__ __forceinline__ void epilogue(const KP& P, const int mode, const int l, const f32x4 (&acc)[2][2][4][2], const int pm, const int pn, const int part, const int wr, const int wc, const int fr_, const int fq_) {
    unsigned char* const ws = ows(P.ws); float* const out = (float*)ows((const unsigned char*)P.out);
    int fr = fr_, fq = fq_; asm volatile("" : "+v"(fr), "+v"(fq));
    const int rbase = pm * 256 + wr * 64 + fr, cl = wc * 32 + 8 * fq;
    if (mode == M_G1) {
        if (pn < 8) {
            bf16_t* ch = (bf16_t*)(ws + W_CH);
#pragma unroll
            for (int ai = 0; ai < 2; ++ai)
#pragma unroll
                for (int m = 0; m < 4; ++m) {
                    __builtin_amdgcn_sched_barrier(0); const int row = rbase + ai * 128 + m * 16, col = pn * 128 + cl;
                    const f32x4 a = acc[ai][0][m][0] * acc[ai][1][m][0], b = acc[ai][0][m][1] * acc[ai][1][m][1];
                    st8bf(ch + (unsigned)(row * 1024 + col), a, b);
                    int seq, i; bool smp;
                    if (tail_row(row, 2, seq, i, smp)) {
                        float* d = out + (smp ? OUT_CAS + ((size_t)(l * 128 + seq) * 2 + i) * 1024 : OUT_CAP + ((size_t)(l * 4 + seq) * 2 + i) * 1024) + col;
                        st8f(d, a, b);
                    }
                }
        } else if (pn == 60) {
            if (wc == 0 && fq < 2) {
                float* dst = (float*)(ws + (fq == 0 ? W_BETA : W_GG));
#pragma unroll
                for (int ai = 0; ai < 2; ++ai)
#pragma unroll
                    for (int m = 0; m < 4; ++m) {
                        __builtin_amdgcn_sched_barrier(0); const int row = rbase + ai * 128 + m * 16;
                        float v[8];
#pragma unroll
                        for (int j = 0; j < 4; ++j) { v[j] = acc[ai][0][m][0][j]; v[4 + j] = acc[ai][0][m][1][j]; }
#pragma unroll
                        for (int h = 0; h < 8; ++h) {
                            if (fq == 0) v[h] = sigmoid_(v[h]);
                            else v[h] = -__expf(P.in[I_ALOG][l * 8 + h]) * softplus_(v[h] + P.in[I_DTB][l * 8 + h]);
                        }
                        st8f(dst + (unsigned)(row * 8), (f32x4){v[0], v[1], v[2], v[3]}, (f32x4){v[4], v[5], v[6], v[7]});
                    }
            }
        } else {
            bf16_t* dstb; int ld, c0, act = 0; bool isq = false;
            if (pn < 12) { dstb = (bf16_t*)(ws + W_BG); ld = 1024; c0 = (pn - 8) * 256; }
            else if (pn < 24) { dstb = (bf16_t*)(ws + W_QKV); ld = 3072; c0 = (pn - 12) * 256; isq = true; }
            else if (pn < 28) { dstb = (bf16_t*)(ws + W_Z); ld = 1024; c0 = (pn - 24) * 256; }
            else if (pn < 32) { dstb = (bf16_t*)(ws + W_GU); ld = 1024; c0 = (pn - 28) * 256; act = 1; }
            else if (pn < 36) { dstb = (bf16_t*)(ws + W_GV); ld = 1024; c0 = (pn - 32) * 256; act = 1; }
            else { dstb = (bf16_t*)(ws + W_GTS); ld = 6144; c0 = (pn - 36) * 256; act = 2; }
#pragma unroll
            for (int ai = 0; ai < 2; ++ai)
#pragma unroll
                for (int m = 0; m < 4; ++m) {
                    __builtin_amdgcn_sched_barrier(0); const int row = rbase + ai * 128 + m * 16;
#pragma unroll
                    for (int bj = 0; bj < 2; ++bj) {
                        const int col = c0 + bj * 128 + cl;
                        f32x4 a = acc[ai][bj][m][0], b = acc[ai][bj][m][1];
                        if (act == 1) {
#pragma unroll
                            for (int j = 0; j < 4; ++j) { a[j] = gelu_(a[j]); b[j] = gelu_(b[j]); }
                        } else if (act == 2) {
#pragma unroll
                            for (int j = 0; j < 4; ++j) { a[j] = sigmoid_(a[j]); b[j] = sigmoid_(b[j]); }
                        }
                        st8bf(dstb + (unsigned)(row * ld + col), a, b);
                        if (isq) {
                            int seq, i; bool smp;
                            if (tail_row(row, 3, seq, i, smp)) {
                                float* d = out + (smp ? OUT_CQS + ((size_t)(l * 128 + seq) * 3 + i) * 3072 : OUT_CQP + ((size_t)(l * 4 + seq) * 3 + i) * 3072) + col;
                                st8f(d, a, b);
                            }
                        }
                    }
                }
        }
    } else if (mode == M_G2A || mode == M_G2B || mode == M_G2C) {
        const int which = mode - M_G2A;
        float* mg = (float*)(ws + W_MG32); const bf16_t* gts = (const bf16_t*)(ws + W_GTS); bf16_t* mgb = (bf16_t*)(ws + W_MGB);
#pragma unroll
        for (int ai = 0; ai < 2; ++ai)
#pragma unroll
            for (int m = 0; m < 4; ++m) {
                __builtin_amdgcn_sched_barrier(0); const int row = rbase + ai * 128 + m * 16;
#pragma unroll
                for (int bj = 0; bj < 2; ++bj) {
                    const int col = pn * 256 + bj * 128 + cl;
                    float g[8]; unpack8(*(const u32x4*)(gts + (unsigned)(row * 6144 + which * 2048 + col)), g);
                    f32x4 a = acc[ai][bj][m][0], b = acc[ai][bj][m][1];
#pragma unroll
                    for (int j = 0; j < 4; ++j) { a[j] *= g[j]; b[j] *= g[4 + j]; }
                    const unsigned mo = (unsigned)(row * DM + col);
                    if (which == 0) st8f(mg + mo, a, b);
                    else if (which == 2) st8f((float*)(ws + W_MG32C) + mo, a, b);
                    else { const float* mc = (const float*)(ws + W_MG32C) + mo;
                        a += *(const f32x4*)(mg + mo) + *(const f32x4*)mc; b += *(const f32x4*)(mg + mo + 4) + *(const f32x4*)(mc + 4);
                        st8bf(mgb + mo, a, b); }
                }
            }
    } else if (mode == M_G3 || mode == M_G5 || mode == M_PE) {
        const float* xr = (const float*)(ws + W_XRES); const float* pe = (const float*)(ws + W_PE);
        float* dst = (float*)(ws + (mode == M_PE ? W_PE : W_PRE));
#pragma unroll
        for (int ai = 0; ai < 2; ++ai)
#pragma unroll
            for (int m = 0; m < 4; ++m) {
                __builtin_amdgcn_sched_barrier(0); const int row = rbase + ai * 128 + m * 16;
#pragma unroll
                for (int bj = 0; bj < 2; ++bj) {
                    const unsigned o = (unsigned)(row * DM + pn * 256 + bj * 128 + cl);
                    f32x4 a = acc[ai][bj][m][0], b = acc[ai][bj][m][1];
                    if (part <= 0) {
                        if (mode == M_G3) { a += ALPHA * *(const f32x4*)(xr + o); b += ALPHA * *(const f32x4*)(xr + o + 4); }
                        if (mode == M_G5) { a += *(const f32x4*)(pe + o); b += *(const f32x4*)(pe + o + 4); }
                    }
                    if (part < 0) st8f(dst + o, a, b);
                    else st8f((float*)(ws + W_PART) + (unsigned)(part * (MS * DM)) + (o - (unsigned)(MP * DM)), a, b);
                }
            }
    } else {
        if (pn < 43) {
            bf16_t* hg = (bf16_t*)(ws + W_HG); bf16_t* hu = (bf16_t*)(ws + W_HU);
#pragma unroll
            for (int ai = 0; ai < 2; ++ai)
#pragma unroll
                for (int m = 0; m < 4; ++m) {
                    __builtin_amdgcn_sched_barrier(0); const int row = rbase + ai * 128 + m * 16;
#pragma unroll
                    for (int bj = 0; bj < 2; ++bj) {
                        const int c = pn * 256 + bj * 128 + cl;
                        const f32x4 a = acc[ai][bj][m][0], b = acc[ai][bj][m][1];
                        if (c < DFF) {
                            st8bf(hg + (unsigned)(row * DFF + c), a, b);
                            int seq, i; bool smp;
                            if (tail_row(row, 2, seq, i, smp)) {
                                float* d = out + (smp ? OUT_CFS + ((size_t)(l * 128 + seq) * 2 + i) * DFF : OUT_CFP + ((size_t)(l * 4 + seq) * 2 + i) * DFF) + c;
                                st8f(d, a, b);
                            }
                        } else st8bf(hu + (unsigned)(row * DFF + (c - DFF)), a, b);
                    }
                }
        } else {
            float* pe = (float*)(ws + W_PE);
#pragma unroll
            for (int ai = 0; ai < 2; ++ai)
#pragma unroll
                for (int m = 0; m < 4; ++m) {
                    __builtin_amdgcn_sched_barrier(0); const int row = rbase + ai * 128 + m * 16;
#pragma unroll
                    for (int bj = 0; bj < 2; ++bj) {
                        float* p = pe + (unsigned)(row * DM + (pn - 43) * 256 + bj * 128 + cl);
                        f32x4 a = acc[ai][bj][m][0], b = acc[ai][bj][m][1];
                        const f32x4 pa = *(const f32x4*)p, pb = *(const f32x4*)(p + 4);
                        const float* xq = (const float*)(ws + W_XRES) + (unsigned)(row * DM + (pn - 43) * 256 + bj * 128 + cl);
                        const f32x4 xa = *(const f32x4*)xq, xb4 = *(const f32x4*)(xq + 4);
#pragma unroll
                        for (int j = 0; j < 4; ++j) { a[j] = sigmoid_(a[j]) * pa[j] + ALPHA * xa[j]; b[j] = sigmoid_(b[j]) * pb[j] + ALPHA * xb4[j]; }
                        st8f(p, a, b);
                    }
                }
        }
    }
}

__device__ __forceinline__ void gemm_phase(LAS unsigned char* lds, const Gemm g, const StaticOrder& S, const KP& P, const int mode, const int layer) {
    const int tidx_ = otid(), bidx_ = obid(); (void)tidx_; (void)bidx_;
    const int tid = tidx_, wid = __builtin_amdgcn_readfirstlane(tid >> 6), lane = tid & 63, wr = wid >> 2, wc = wid & 3, fr = lane & 15, fq = lane >> 4;
    const int K = g.K;
    unsigned voffA[2], voffB[2];
#pragma unroll
    for (int i = 0; i < 2; ++i) { int R, C; stage_rc(tid * 16 + i * 8192, R, C); const int Rb = (R & ~31) + perm32(R & 31);
        voffA[i] = (unsigned)(R * K + C) * 2u; voffB[i] = (unsigned)(Rb * K + C) * 2u; }
    const size_t kstep = (size_t)(BK * 2);
    const size_t hstep = (size_t)HALF * K * 2;
    const size_t tstep = 2 * hstep;
    const unsigned ldsw = (unsigned)wid * 1024u;
    const int aoff = lds_byte(wr * 64 + fr, fq * 8), boff = lds_byte(wc * 32 + fr, fq * 8);
#define PG8_SA(b, h) (((b) * 2 + (h)) * HTB)
#define PG8_SB(b, h) ((4 + (b) * 2 + (h)) * HTB)
#define PG8_STAGE(bufoff, gbase, voff) do { _Pragma("unroll") for (int _i = 0; _i < 2; ++_i) \
        __builtin_amdgcn_global_load_lds((const unsigned*)((const char*)(gbase) + (voff)[_i]), (LAS unsigned*)(lds + (bufoff) + ldsw + _i * 8192), 16, 0, 0); } while (0)
#define PG8_LDA(dst, b, h) do { _Pragma("unroll") for (int m = 0; m < 4; ++m) _Pragma("unroll") for (int k = 0; k < 2; ++k) dst[m][k] = *(const LAS bf16x8*)(lds + PG8_SA(b, h) + aoff + m * 2048 + k * 1024); } while (0)
#define PG8_LDB(dst, b, h) do { _Pragma("unroll") for (int n = 0; n < 2; ++n) _Pragma("unroll") for (int k = 0; k < 2; ++k) dst[n][k] = *(const LAS bf16x8*)(lds + PG8_SB(b, h) + boff + n * 2048 + k * 1024); } while (0)
#define PG8_MMA(ai, bj, At, Bt) do { __builtin_amdgcn_s_setprio(1); _Pragma("unroll") for (int m = 0; m < 4; ++m) _Pragma("unroll") for (int n = 0; n < 2; ++n) _Pragma("unroll") for (int k = 0; k < 2; ++k) \
        acc[ai][bj][m][n] = __builtin_amdgcn_mfma_f32_16x16x32_bf16(Bt[n][k], At[m][k], acc[ai][bj][m][n], 0, 0, 0); __builtin_amdgcn_s_setprio(0); } while (0)
#define PG8_WAIT_V(n) asm volatile("s_waitcnt vmcnt(" #n ")" ::: "memory")
#define PG8_WAIT_L(n) asm volatile("s_waitcnt lgkmcnt(" #n ")" ::: "memory")
#define PG8_BAR __builtin_amdgcn_s_barrier()
#define PG8_SCHED __builtin_amdgcn_sched_barrier(0)
    Unit cur, nxt; int ui = 0;
    if (!S.next(0, cur)) return;
    f32x4 acc[2][2][4][2];
#pragma unroll
    for (int a = 0; a < 2; ++a)
#pragma unroll
        for (int b = 0; b < 2; ++b)
#pragma unroll
            for (int m = 0; m < 4; ++m)
#pragma unroll
                for (int n = 0; n < 2; ++n) acc[a][b][m][n] = (f32x4){0.f, 0.f, 0.f, 0.f};
    bf16x8 At[4][2], B0[2][2], B1[2][2];
    const char* cA = (const char*)g.A + (size_t)cur.pm * tstep + (size_t)cur.k0 * kstep; const char* cB = (const char*)g.Bt + (size_t)cur.pn * tstep + (size_t)cur.k0 * kstep;
    PG8_STAGE(PG8_SB(0, 0), cB, voffB); PG8_STAGE(PG8_SB(0, 1), cB + hstep, voffB); PG8_STAGE(PG8_SA(0, 0), cA, voffA); PG8_STAGE(PG8_SA(0, 1), cA + hstep, voffA);
    if (wr == 1) PG8_BAR;
    PG8_WAIT_V(2); PG8_BAR;
    PG8_STAGE(PG8_SB(1, 0), cB + kstep, voffB); PG8_STAGE(PG8_SA(1, 0), cA + kstep, voffA); PG8_STAGE(PG8_SB(1, 1), cB + hstep + kstep, voffB);
    PG8_WAIT_V(6); PG8_BAR;
    for (;;) {
        const bool has_next = S.next(ui + 1, nxt);
        const char* nA = has_next ? (const char*)g.A + (size_t)nxt.pm * tstep + (size_t)nxt.k0 * kstep : cA; const char* nB = has_next ? (const char*)g.Bt + (size_t)nxt.pn * tstep + (size_t)nxt.k0 * kstep : cB;
        const int nt = cur.nt;
        for (int t = 0; t < nt; t += 2) {
            const bool last = (t == nt - 2);
            const char* a1 = cA + (size_t)(t + 1) * kstep;
            const char* a2 = last ? nA : cA + (size_t)(t + 2) * kstep; const char* b2 = last ? nB : cB + (size_t)(t + 2) * kstep;
            const char* a3 = a2 + kstep; const char* b3 = b2 + kstep;
            PG8_LDB(B0, 0, 0); PG8_LDB(B1, 0, 1); PG8_SCHED; PG8_LDA(At, 0, 0); PG8_STAGE(PG8_SA(1, 1), a1 + hstep, voffA);
            PG8_WAIT_V(8); PG8_WAIT_L(0); PG8_BAR; PG8_MMA(0, 0, At, B0); PG8_MMA(0, 1, At, B1); PG8_BAR; PG8_SCHED;
            PG8_LDA(At, 0, 1); PG8_STAGE(PG8_SB(0, 0), b2, voffB); PG8_STAGE(PG8_SB(0, 1), b2 + hstep, voffB); PG8_STAGE(PG8_SA(0, 0), a2, voffA);
            PG8_WAIT_V(8); PG8_WAIT_L(0); PG8_BAR; PG8_MMA(1, 0, At, B0); PG8_MMA(1, 1, At, B1); PG8_BAR; PG8_SCHED;
            PG8_LDB(B0, 1, 0); PG8_LDB(B1, 1, 1); PG8_SCHED; PG8_LDA(At, 1, 0); PG8_STAGE(PG8_SA(0, 1), a2 + hstep, voffA);
            PG8_WAIT_V(8); PG8_WAIT_L(0); PG8_BAR; PG8_MMA(0, 0, At, B0); PG8_MMA(0, 1, At, B1); PG8_BAR; PG8_SCHED;
            PG8_LDA(At, 1, 1); PG8_STAGE(PG8_SB(1, 0), b3, voffB); PG8_STAGE(PG8_SB(1, 1), b3 + hstep, voffB); PG8_STAGE(PG8_SA(1, 0), a3, voffA);
            PG8_WAIT_V(8); PG8_WAIT_L(0); PG8_BAR; PG8_MMA(1, 0, At, B0); PG8_MMA(1, 1, At, B1); PG8_BAR; PG8_SCHED;
        }
        if (wr == 0) PG8_BAR;
        epilogue(P, mode, layer, acc, cur.pm, cur.pn, cur.part, wr, wc, fr, fq);
        if (!has_next) break;
#pragma unroll
        for (int a = 0; a < 2; ++a)
#pragma unroll
            for (int b = 0; b < 2; ++b)
#pragma unroll
                for (int m = 0; m < 4; ++m)
#pragma unroll
                    for (int n = 0; n < 2; ++n) acc[a][b][m][n] = (f32x4){0.f, 0.f, 0.f, 0.f};
        cur = nxt; cA = nA; cB = nB; ++ui;
        if (wr == 1) PG8_BAR;
    }
    PG8_WAIT_V(0);
    PG8_BAR;
#undef PG8_SA
#undef PG8_SB
#undef PG8_STAGE
#undef PG8_LDA
#undef PG8_LDB
#undef PG8_MMA
#undef PG8_WAIT_V
#undef PG8_WAIT_L
#undef PG8_BAR
#undef PG8_SCHED
}

__device__ __forceinline__ void tr_tile_w(const float* src, const int ldsrc, const int scol0, const int nvalid, const int k0, bf16_t* dst, const int K, const int drow0, float* scr, const int lane) {
    const int kk = lane >> 3, c4 = (lane & 7) * 4;
    f32x4 v[8];
#pragma unroll
    for (int p = 0; p < 8; ++p) { v[p] = (f32x4){0.f, 0.f, 0.f, 0.f}; if (c4 < nvalid) v[p] = __builtin_nontemporal_load((const f32x4*)(src + (size_t)(k0 + kk + 8 * p) * ldsrc + scol0 + c4)); }
#pragma unroll
    for (int p = 0; p < 8; ++p) {
        scr[(c4 + 0) * 65 + kk + 8 * p] = v[p][0]; scr[(c4 + 1) * 65 + kk + 8 * p] = v[p][1]; scr[(c4 + 2) * 65 + kk + 8 * p] = v[p][2]; scr[(c4 + 3) * 65 + kk + 8 * p] = v[p][3];
    }
    __builtin_amdgcn_wave_barrier();
#pragma unroll
    for (int q = 0; q < 4; ++q) {
        const int id = lane + 64 * q, n = id >> 3, c = id & 7; const float* sp = scr + n * 65 + 8 * c;
        u32x4 o; o.x = pk2(sp[0], sp[1]); o.y = pk2(sp[2], sp[3]); o.z = pk2(sp[4], sp[5]); o.w = pk2(sp[6], sp[7]);
        *(u32x4*)(dst + (size_t)(drow0 + n) * K + k0 + 8 * c) = o;
    }
    __builtin_amdgcn_wave_barrier();
}
__device__ __forceinline__ void convert_weights(const KP& P, const int l, float* scr0, const int part, const int wb0, const int nwb) {
    const int tidx_ = otid(), bidx_ = obid(); (void)tidx_; (void)bidx_;
    unsigned char* ws = ows(P.ws);
    const int lane = tidx_ & 63, wv = tidx_ >> 6, gw = (bidx_ - wb0) * 8 + wv, ngw = nwb * 8;
    float* scr = scr0 + wv * (32 * 65);
    constexpr int T_WIN = (NV1 / 32) * 32, T_W1 = 64 * 16, T_WO = 64 * 32, T_WUP = (2 * DFF / 32) * 32, T_WPG = 64 * 32, T_WDN = 64 * (DFF / 64), T_WPE = 64 * 4;
    constexpr int T_ALL = T_WIN + 3 * T_W1 + T_WO + T_WUP + T_WPG + T_WDN + T_WPE;
    constexpr int T_A = T_WIN + 3 * T_W1 + T_WO, T_LATE = T_WUP + T_WPG;
    const int njobs = part ? T_LATE : T_ALL - T_LATE;
    for (int jt = gw; jt < njobs; jt += ngw) {
        const int it = part ? T_A + jt : (jt < T_A ? jt : jt + T_LATE);
        int r = it;
        if (r < T_WIN) {
            const int nj = r >> 5, kj = r & 31, nv0 = nj * 32; int sc, nv = 32;
            if (nv0 < 2048) { const int t = nv0 >> 8, hf = (nv0 >> 7) & 1, i = nv0 & 127; sc = (hf ? 2048 : 0) + 128 * t + i; }
            else if (nv0 < 3072) sc = nv0 - 1024;
            else if (nv0 < 7168) sc = nv0;
            else if (nv0 < 15360) sc = nv0 + 16;
            else if (nv0 == 15360) { sc = 7168; nv = 16; }
            else { sc = 0; nv = 0; }
            tr_tile_w(P.in[I_WIN] + (size_t)l * 2048 * NIN, NIN, sc, nv, kj * 64, (bf16_t*)(ws + W_WIN), 2048, nv0, scr, lane); continue;
        }
        r -= T_WIN;
        if (r < 3 * T_W1) {
            const int w = r / T_W1, rr = r % T_W1, nj = rr >> 4, kj = rr & 15;
            const float* src = (w == 0 ? P.in[I_WAO] : (w == 1 ? P.in[I_WBO] : P.in[I_WCO])) + (size_t)l * 1024 * 2048;
            bf16_t* dst = (bf16_t*)(ws + (w == 0 ? W_WA : (w == 1 ? W_WB : W_WC)));
            tr_tile_w(src, 2048, nj * 32, 32, kj * 64, dst, 1024, nj * 32, scr, lane); continue;
        }
        r -= 3 * T_W1;
        if (r < T_WO) { const int nj = r >> 5, kj = r & 31; tr_tile_w(P.in[I_WO] + (size_t)l * 2048 * 2048, 2048, nj * 32, 32, kj * 64, (bf16_t*)(ws + W_WO), 2048, nj * 32, scr, lane); continue; }
        r -= T_WO;
        if (r < T_WUP) { const int nj = r >> 5, kj = r & 31; tr_tile_w(P.in[I_WUP] + (size_t)l * 2048 * 2 * DFF, 2 * DFF, nj * 32, 32, kj * 64, (bf16_t*)(ws + W_WUP), 2048, nj * 32, scr, lane); continue; }
        r -= T_WUP;
        if (r < T_WPG) { const int nj = r >> 5, kj = r & 31; tr_tile_w(P.in[I_WPG] + (size_t)l * 2048 * 2048, 2048, nj * 32, 32, kj * 64, (bf16_t*)(ws + W_WUP), 2048, 2 * DFF + nj * 32, scr, lane); continue; }
        r -= T_WPG;
        if (r < T_WDN) { const int nj = r / (DFF / 64), kj = r % (DFF / 64); tr_tile_w(P.in[I_WDN] + (size_t)l * DFF * 2048, 2048, nj * 32, 32, kj * 64, (bf16_t*)(ws + W_WDN), DFF, nj * 32, scr, lane); continue; }
        r -= T_WDN;
        { const int nj = r >> 2, kj = r & 3; tr_tile_w(P.in[I_WPE] + (size_t)l * 256 * 2048, 2048, nj * 32, 32, kj * 64, (bf16_t*)(ws + W_WPE), 256, nj * 32, scr, lane); }
    }
    bf16_t* pb = (bf16_t*)(ws + W_PB);
    if (part == 0) for (int i = bidx_ * 512 + tidx_; i < MT * 32; i += gridDim.x * 512) {
        const int r = i >> 5, c8 = (i & 31) * 8;
        const float* s = (r < MP ? P.in[I_PP] + ((size_t)l * MP + r) * 256 : P.in[I_PS] + ((size_t)l * MS + (r - MP)) * 256) + c8;
        const f32x4 a = *(const f32x4*)s, b = *(const f32x4*)(s + 4);
        st8bf(pb + (size_t)r * 256 + c8, a, b);
    }
}

__device__ __forceinline__ void ln_rows(const KP& P, const int srcsel  , const float* g, const float* b, const bool to_out) {
    const int tidx_ = otid(), bidx_ = obid(); (void)tidx_; (void)bidx_;
    unsigned char* ws = ows(P.ws);
    const int lane = tidx_ & 63, gw = bidx_ * 8 + (tidx_ >> 6), ngw = gridDim.x * 8;
    f32x4 gv[8], bv[8];
#pragma unroll
    for (int j = 0; j < 8; ++j) { gv[j] = *(const f32x4*)(g + j * 256 + lane * 4); bv[j] = *(const f32x4*)(b + j * 256 + lane * 4); }
    for (int r = gw; r < MT; r += ngw) {
        const float* src = srcsel ? (const float*)(ws + W_PRE) + (size_t)r * DM : (r < MP ? P.in[I_XP] + (size_t)r * DM : P.in[I_XS] + (size_t)(r - MP) * DM);
        f32x4 v[8]; float s = 0.f;
        if (srcsel && r >= MP && gridDim.x == 256) {
            const float* pp = (const float*)(ws + W_PART) + (size_t)(r - MP) * DM + lane * 4;
#pragma unroll
            for (int j = 0; j < 8; ++j) v[j] = __builtin_nontemporal_load((const f32x4*)(pp + j * 256));
#pragma unroll 3
            for (int ks = 1; ks < 16; ++ks)
#pragma unroll
                for (int j = 0; j < 8; ++j) v[j] += __builtin_nontemporal_load((const f32x4*)(pp + (size_t)ks * (MS * DM) + j * 256));
#pragma unroll
            for (int j = 0; j < 8; ++j) s += (v[j][0] + v[j][1]) + (v[j][2] + v[j][3]);
        } else {
#pragma unroll
            for (int j = 0; j < 8; ++j) { v[j] = __builtin_nontemporal_load((const f32x4*)(src + j * 256 + lane * 4)); s += (v[j][0] + v[j][1]) + (v[j][2] + v[j][3]); }
        }
        const float mean = wave_sum(s) * (1.f / DM); float s2 = 0.f;
#pragma unroll
        for (int j = 0; j < 8; ++j) { v[j] = v[j] - mean; s2 += (v[j][0] * v[j][0] + v[j][1] * v[j][1]) + (v[j][2] * v[j][2] + v[j][3] * v[j][3]); }
        const float rstd = rsqrtf(wave_sum(s2) * (1.f / DM) + LN_EPS);
        float* d32 = to_out ? P.out + (size_t)r * DM : (float*)(ws + W_XRES) + (size_t)r * DM;
        bf16_t* db = (bf16_t*)(ws + W_XB) + (size_t)r * DM;
#pragma unroll
        for (int j = 0; j < 8; ++j) {
            const f32x4 y = v[j] * rstd * gv[j] + bv[j];
            if (to_out) __builtin_nontemporal_store(y, (f32x4*)(d32 + j * 256 + lane * 4)); else *(f32x4*)(d32 + j * 256 + lane * 4) = y;
            if (!to_out) { u32x2 w; w.x = pk2(y[0], y[1]); w.y = pk2(y[2], y[3]); *(u32x2*)(db + j * 256 + lane * 4) = w; }
        }
    }
}

__device__ __forceinline__ void phase_e(const KP& P, const int l) {
    const int tidx_ = otid(), bidx_ = obid(); (void)tidx_; (void)bidx_;
    unsigned char* ws = ows(P.ws);
    {
        const bf16_t* ch = (const bf16_t*)(ws + W_CH); const bf16_t* bg = (const bf16_t*)(ws + W_BG); bf16_t* ya = (bf16_t*)(ws + W_YA);
        const float* cw = P.in[I_CAW] + (size_t)l * 3 * 1024; const float* hist = P.in[I_SCA] + (size_t)l * 128 * 2 * 1024;
        for (int i = bidx_ * 512 + tidx_; i < (MT / 4) * 128; i += gridDim.x * 512) {
            const int q = i >> 7, c8 = (i & 127) * 8, r0 = 4 * q;
            const bool smp = r0 >= MP; const int t0 = smp ? 0 : (r0 & 2047), sb = (r0 - MP) >> 2;
            float x[6][8];
#pragma unroll
            for (int d = 0; d < 2; ++d) {
                if (t0 > 0) unpack8(*(const u32x4*)(ch + (size_t)(r0 - 2 + d) * 1024 + c8), x[d]);
                else if (smp) { const float* h = hist + ((size_t)sb * 2 + d) * 1024 + c8; const f32x4 h0 = *(const f32x4*)h, h1 = *(const f32x4*)(h + 4);
#pragma unroll
                    for (int j = 0; j < 4; ++j) { x[d][j] = h0[j]; x[d][4 + j] = h1[j]; } }
                else {
#pragma unroll
                    for (int j = 0; j < 8; ++j) x[d][j] = 0.f; }
            }
#pragma unroll
            for (int d = 0; d < 4; ++d) unpack8(*(const u32x4*)(ch + (size_t)(r0 + d) * 1024 + c8), x[2 + d]);
            float w[3][8];
#pragma unroll
            for (int d = 0; d < 3; ++d) { const f32x4 w0 = *(const f32x4*)(cw + d * 1024 + c8), w1 = *(const f32x4*)(cw + d * 1024 + c8 + 4);
#pragma unroll
                for (int j = 0; j < 4; ++j) { w[d][j] = w0[j]; w[d][4 + j] = w1[j]; } }
#pragma unroll
            for (int d = 0; d < 4; ++d) {
                float g[8], a[8]; unpack8(*(const u32x4*)(bg + (size_t)(r0 + d) * 1024 + c8), g);
#pragma unroll
                for (int j = 0; j < 8; ++j) a[j] = g[j] * (w[0][j] * x[d][j] + w[1][j] * x[d + 1][j] + w[2][j] * x[d + 2][j]);
                *(u32x4*)(ya + (size_t)(r0 + d) * 1024 + c8) = pack8(a);
            }
        }
    }
    const int lane = tidx_ & 63, gw = bidx_ * 8 + (tidx_ >> 6), ngw = gridDim.x * 8;
    {
        const bf16_t* qkv = (const bf16_t*)(ws + W_QKV); bf16_t* qn = (bf16_t*)(ws + W_QKVN); float* qns = (float*)(ws + W_QKVNS);
        const float* cw = P.in[I_CBW] + (size_t)l * 4 * 3072; const float* hist = P.in[I_SCQ] + (size_t)l * 128 * 3 * 3072;
        for (int it = gw; it < (MT / 4) * 6; it += ngw) {
            const int q = it / 6, s4 = it % 6, c = s4 * 512 + lane * 8, r0 = 4 * q;
            const bool smp = r0 >= MP; const int t0 = smp ? 0 : (r0 & 2047), sb = (r0 - MP) >> 2;
            float x[7][8];
#pragma unroll
            for (int d = 0; d < 3; ++d) {
                if (t0 > 0) unpack8(*(const u32x4*)(qkv + (size_t)(r0 - 3 + d) * 3072 + c), x[d]);
                else if (smp) { const float* hp = hist + ((size_t)sb * 3 + d) * 3072 + c; const f32x4 h0 = *(const f32x4*)hp, h1 = *(const f32x4*)(hp + 4);
#pragma unroll
                    for (int j = 0; j < 4; ++j) { x[d][j] = h0[j]; x[d][4 + j] = h1[j]; } }
                else {
#pragma unroll
                    for (int j = 0; j < 8; ++j) x[d][j] = 0.f; }
            }
#pragma unroll
            for (int d = 0; d < 4; ++d) unpack8(*(const u32x4*)(qkv + (size_t)(r0 + d) * 3072 + c), x[3 + d]);
            float w[4][8];
#pragma unroll
            for (int d = 0; d < 4; ++d) { const f32x4 w0 = *(const f32x4*)(cw + d * 3072 + c), w1 = *(const f32x4*)(cw + d * 3072 + c + 4);
#pragma unroll
                for (int j = 0; j < 4; ++j) { w[d][j] = w0[j]; w[d][4 + j] = w1[j]; } }
#pragma unroll
            for (int d = 0; d < 4; ++d) {
                float a[8]; float ss = 0.f;
#pragma unroll
                for (int j = 0; j < 8; ++j) { a[j] = silu_(w[0][j] * x[d][j] + w[1][j] * x[d + 1][j] + w[2][j] * x[d + 2][j] + w[3][j] * x[d + 3][j]); ss += a[j] * a[j]; }
                if (s4 < 4) {
                    ss += __shfl_xor(ss, 1); ss += __shfl_xor(ss, 2); ss += __shfl_xor(ss, 4); ss += __shfl_xor(ss, 8);
                    const float sc = rsqrtf(ss + RMS_EPS) * (s4 < 2 ? 0.08838834764831845f : 1.f);
#pragma unroll
                    for (int j = 0; j < 8; ++j) a[j] *= sc;
                }
                *(u32x4*)(qn + (size_t)(r0 + d) * 3072 + c) = pack8(a);
                if (smp) st8f(qns + (size_t)(r0 + d - MP) * 3072 + c, (f32x4){a[0], a[1], a[2], a[3]}, (f32x4){a[4], a[5], a[6], a[7]});
            }
        }
    }
    {
        const bf16_t* gv = (const bf16_t*)(ws + W_GV); bf16_t* vcn = (bf16_t*)(ws + W_VCN);
        const float* lg = P.in[I_LCG] + (size_t)l * 1024; const float* lb = P.in[I_LCB] + (size_t)l * 1024;
        for (int r = gw; r < MT; r += ngw) {
            float x[2][8]; float s = 0.f;
#pragma unroll
            for (int j = 0; j < 2; ++j) { unpack8(*(const u32x4*)(gv + (size_t)r * 1024 + j * 512 + lane * 8), x[j]);
#pragma unroll
                for (int e = 0; e < 8; ++e) s += x[j][e]; }
            const float mean = wave_sum(s) * (1.f / 1024.f); float s2 = 0.f;
#pragma unroll
            for (int j = 0; j < 2; ++j)
#pragma unroll
                for (int e = 0; e < 8; ++e) { x[j][e] -= mean; s2 += x[j][e] * x[j][e]; }
            const float rstd = rsqrtf(wave_sum(s2) * (1.f / 1024.f) + LN_EPS);
#pragma unroll
            for (int j = 0; j < 2; ++j) {
                const int c = j * 512 + lane * 8;
#pragma unroll
                for (int e = 0; e < 8; ++e) x[j][e] = x[j][e] * rstd * lg[c + e] + lb[c + e];
                *(u32x4*)(vcn + (size_t)r * 1024 + c) = pack8(x[j]);
                if (r >= MP) { float* d = P.out + OUT_VS + ((size_t)l * MS + (r - MP)) * 1024 + c;
                    st8f(d, (f32x4){x[j][0], x[j][1], x[j][2], x[j][3]}, (f32x4){x[j][4], x[j][5], x[j][6], x[j][7]}); }
            }
        }
    }
}

__device__ __forceinline__ void beta_gate(const KP& P, const int l) {
    const int tidx_ = otid(), bidx_ = obid(); (void)tidx_; (void)bidx_;
    unsigned char* ws = ows(P.ws);
    const int lane = tidx_ & 63, lr = lane & 15, lq = lane >> 4, gw = bidx_ * 8 + (tidx_ >> 6), ngw = gridDim.x * 8;
    const bf16_t* xb = (const bf16_t*)(ws + W_XB); const bf16_t* wt = (const bf16_t*)(ws + W_WIN) + (size_t)15360 * 2048;
    float* betab = (float*)(ws + W_BETA); float* ggb = (float*)(ws + W_GG);
    for (int it = gw; it < MT / 16; it += ngw) {
        const bf16_t* ap = xb + (size_t)(16 * it + lr) * 2048 + lq * 8; const bf16_t* bp = wt + (size_t)lr * 2048 + lq * 8;
        f32x4 acc0 = {0.f, 0.f, 0.f, 0.f}, acc1 = {0.f, 0.f, 0.f, 0.f};
#pragma unroll 8
        for (int ks = 0; ks < 64; ks += 2) {
            acc0 = __builtin_amdgcn_mfma_f32_16x16x32_bf16(*(const bf16x8*)(ap + ks * 32), *(const bf16x8*)(bp + ks * 32), acc0, 0, 0, 0);
            acc1 = __builtin_amdgcn_mfma_f32_16x16x32_bf16(*(const bf16x8*)(ap + ks * 32 + 32), *(const bf16x8*)(bp + ks * 32 + 32), acc1, 0, 0, 0);
        }
        const int h = lr & 7; const float al = -__expf(P.in[I_ALOG][l * 8 + h]), dtb = P.in[I_DTB][l * 8 + h];
#pragma unroll
        for (int j = 0; j < 4; ++j) {
            const float v = acc0[j] + acc1[j]; const int row = 16 * it + 4 * lq + j;
            if (lr < 8) betab[row * 8 + h] = sigmoid_(v); else ggb[row * 8 + h] = al * softplus_(v + dtb);
        }
    }
}
__device__ __forceinline__ void d1_prep(const KP& P, const int l, float* shm) {
    const int tidx_ = otid(), bidx_ = obid(); (void)tidx_; (void)bidx_;
    unsigned char* ws = ows(P.ws);
    const int tid = tidx_, w = tid >> 6, lane = tid & 63, lr = lane & 15, lq = lane >> 4;
    float* Am = shm;
    float* gc = Am + 64 * 68;
    float* bt = gc + 64;
    float* X = shm + 8192;
    const bf16_t* qn = (const bf16_t*)(ws + W_QKVN);
    const float* betab = (const float*)(ws + W_BETA); const float* ggb = (const float*)(ws + W_GG);
    float* DU = (float*)(ws + W_DU); bf16_t* DNW = (bf16_t*)(ws + W_DNW); bf16_t* DQD = (bf16_t*)(ws + W_DQD); bf16_t* DKDT = (bf16_t*)(ws + W_DKDT);
    bf16_t* DQK = (bf16_t*)(ws + W_DQK); float* DGL = (float*)(ws + W_DGL);
    for (int T = bidx_; T < 1024; T += gridDim.x) {
        const int chain = T >> 5, n = T & 31, b = chain >> 3, h = chain & 7, r0 = b * 2048 + n * 64;
        const bf16_t* qp = qn + (size_t)r0 * 3072 + h * 128; const bf16_t* kp = qp + 1024; const bf16_t* vp = qp + 2048;
        if (w == 0) {
            float v = ggb[(size_t)(r0 + lane) * 8 + h];
#pragma unroll
            for (int o = 1; o < 64; o <<= 1) { const float t = __shfl_up(v, o); if (lane >= o) v += t; }
            gc[lane] = v; bt[lane] = betab[(size_t)(r0 + lane) * 8 + h];
        }
        __syncthreads();
        {
            const int rt = w & 3;
            bf16x8 ak[4], aq[4];
#pragma unroll
            for (int ks = 0; ks < 4; ++ks) { ak[ks] = *(const bf16x8*)(kp + (size_t)(16 * rt + lr) * 3072 + ks * 32 + lq * 8); aq[ks] = *(const bf16x8*)(qp + (size_t)(16 * rt + lr) * 3072 + ks * 32 + lq * 8); }
#pragma unroll
            for (int c2 = 0; c2 < 2; ++c2) {
                const int nt = 2 * (w >> 2) + c2;
                f32x4 ckk = {0.f, 0.f, 0.f, 0.f}, cqk = {0.f, 0.f, 0.f, 0.f};
#pragma unroll
                for (int ks = 0; ks < 4; ++ks) {
                    const bf16x8 bb = *(const bf16x8*)(kp + (size_t)(16 * nt + lr) * 3072 + ks * 32 + lq * 8);
                    ckk = __builtin_amdgcn_mfma_f32_16x16x32_bf16(ak[ks], bb, ckk, 0, 0, 0);
                    cqk = __builtin_amdgcn_mfma_f32_16x16x32_bf16(aq[ks], bb, cqk, 0, 0, 0);
                }
                const int jj = 16 * nt + lr; const float gj = gc[jj];
#pragma unroll
                for (int j = 0; j < 4; ++j) {
                    const int i = 16 * rt + 4 * lq + j; const float dec = __expf(fminf(gc[i] - gj, 0.f));
                    Am[i * 68 + jj] = (i > jj) ? bt[i] * ckk[j] * dec : 0.f;
                    DQK[(size_t)T * 4096 + i * 64 + jj] = f2bf((i >= jj) ? cqk[j] * dec : 0.f);
                }
            }
        }
        __syncthreads();
        {
            const int c = tid & 255, hf = tid >> 8; const bool isv = c < 128; const bf16_t* colp = isv ? vp + c : kp + (c - 128);
#pragma unroll 16
            for (int i2 = 0; i2 < 32; ++i2) { const int i = hf * 32 + i2; float rhs = bf2f(colp[(size_t)i * 3072]) * bt[i]; if (!isv) rhs *= __expf(gc[i]); X[i * 256 + c] = rhs; }
            const float glast = gc[63];
#pragma unroll 8
            for (int e = tid; e < 8192; e += 512) { const int i = e >> 7, d = e & 127; DQD[(size_t)T * 8192 + e] = f2bf(bf2f(qp[(size_t)i * 3072 + d]) * __expf(gc[i])); }
#pragma unroll 8
            for (int e = tid; e < 8192; e += 512) { const int d = e >> 6, i = e & 63; DKDT[(size_t)T * 8192 + e] = f2bf(bf2f(kp[(size_t)i * 3072 + d]) * __expf(glast - gc[i])); }
            if (tid == 0) DGL[T] = __expf(glast);
        }
        __syncthreads();
#pragma unroll
        for (int I = 0; I < 4; ++I) {
            if (I > 0) {
#pragma unroll
                for (int c2 = 0; c2 < 2; ++c2) {
                    const int ct = 2 * w + c2;
                    f32x4 acc = {0.f, 0.f, 0.f, 0.f};
#pragma unroll
                    for (int kk = 0; kk < 4 * I; ++kk)
                        acc = __builtin_amdgcn_mfma_f32_16x16x4f32(Am[(16 * I + lr) * 68 + 4 * kk + lq], X[(4 * kk + lq) * 256 + 16 * ct + lr], acc, 0, 0, 0);
#pragma unroll
                    for (int j = 0; j < 4; ++j) X[(16 * I + 4 * lq + j) * 256 + 16 * ct + lr] -= acc[j];
                }
                __syncthreads();
            }
            if (tid < 256) {
                float x[16];
#pragma unroll
                for (int r = 0; r < 16; ++r) x[r] = X[(16 * I + r) * 256 + tid];
#pragma unroll
                for (int r = 1; r < 16; ++r) {
                    float sacc = 0.f;
#pragma unroll
                    for (int j = 0; j < r; ++j) sacc += Am[(16 * I + r) * 68 + 16 * I + j] * x[j];
                    x[r] -= sacc;
                }
#pragma unroll
                for (int r = 1; r < 16; ++r) X[(16 * I + r) * 256 + tid] = x[r];
            }
            __syncthreads();
        }
        {
            const int c = tid & 255, hf = tid >> 8;
            if (c < 128) {
#pragma unroll 8
                for (int i2 = 0; i2 < 32; ++i2) { const int i = hf * 32 + i2; DU[(size_t)T * 8192 + i * 128 + c] = X[i * 256 + c]; }
            } else {
#pragma unroll 8
                for (int i2 = 0; i2 < 32; ++i2) { const int i = hf * 32 + i2; DNW[(size_t)T * 8192 + i * 128 + (c - 128)] = f2bf(-X[i * 256 + c]); }
            }
        }
        __syncthreads();
    }
}
__device__ __forceinline__ void d1_mix(const KP& P, const int l) {
    const int tidx_ = otid(), bidx_ = obid(); (void)tidx_; (void)bidx_;
    unsigned char* ws = ows(P.ws);
    const int tid = tidx_, w = tid >> 6, lane = tid & 63, lr = lane & 15, lq = lane >> 4;
    const bf16_t* vcn = (const bf16_t*)(ws + W_VCN); const bf16_t* gu = (const bf16_t*)(ws + W_GU); bf16_t* yc = (bf16_t*)(ws + W_YC);
    for (int it = bidx_; it < 512; it += gridDim.x) {
        const int g = it & 7, cn = (it >> 3) & 15, b = it >> 7, r0 = b * 2048 + cn * 128;
        const float* wsg = P.in[I_WS] + ((size_t)l * 8 + g) * 128 * 128; const float* bsg = P.in[I_BS] + ((size_t)l * 8 + g) * 128;
        bf16x8 xv[4];
#pragma unroll
        for (int ks = 0; ks < 4; ++ks)
#pragma unroll
            for (int e = 0; e < 8; ++e) xv[ks][e] = (short)vcn[(size_t)(r0 + 32 * ks + 8 * lq + e) * 1024 + g * 128 + 16 * w + lr];
#pragma unroll
        for (int mt = 0; mt < 8; ++mt) {
            const int t = 16 * mt + lr;
            f32x4 acc = {0.f, 0.f, 0.f, 0.f};
#pragma unroll
            for (int ks = 0; ks < 4; ++ks) {
                if (32 * ks <= 16 * mt + 15) {
                    const float* wp = wsg + (size_t)t * 128 + 32 * ks + 8 * lq; const f32x4 w0 = *(const f32x4*)wp, w1 = *(const f32x4*)(wp + 4);
                    float wv[8] = {w0[0], w0[1], w0[2], w0[3], w1[0], w1[1], w1[2], w1[3]};
                    bf16x8 yw;
#pragma unroll
                    for (int e = 0; e < 8; ++e) yw[e] = (short)f2bf((32 * ks + 8 * lq + e <= t) ? wv[e] : 0.f);
                    acc = __builtin_amdgcn_mfma_f32_16x16x32_bf16(xv[ks], yw, acc, 0, 0, 0);
                }
            }
            const float bias = bsg[t]; const size_t o = (size_t)(r0 + t) * 1024 + g * 128 + 16 * w + 4 * lq;
            const u32x2 gw2 = *(const u32x2*)(gu + o);
            u32x2 r; r.x = pk2(lo16(gw2.x) * (acc[0] + bias), hi16(gw2.x) * (acc[1] + bias)); r.y = pk2(lo16(gw2.y) * (acc[2] + bias), hi16(gw2.y) * (acc[3] + bias));
            *(u32x2*)(yc + o) = r;
        }
    }
    for (int i = bidx_ * 512 + tidx_; i < MS * 128; i += gridDim.x * 512) {
        const int rs = i >> 7, c8 = (i & 127) * 8, t = rs & 3, g = c8 >> 7, r = MP + rs;
        const float* wsg = P.in[I_WS] + (((size_t)l * 8 + g) * 128 + t) * 128; const float bias = P.in[I_BS][((size_t)l * 8 + g) * 128 + t];
        float a[8];
#pragma unroll
        for (int e = 0; e < 8; ++e) a[e] = bias;
#pragma unroll
        for (int s = 0; s < 4; ++s) if (s <= t) { float x[8]; unpack8(*(const u32x4*)(vcn + (size_t)(r - t + s) * 1024 + c8), x); const float wv = wsg[s];
#pragma unroll
            for (int e = 0; e < 8; ++e) a[e] += wv * x[e]; }
        float gq[8]; unpack8(*(const u32x4*)(gu + (size_t)r * 1024 + c8), gq);
#pragma unroll
        for (int e = 0; e < 8; ++e) a[e] *= gq[e];
        *(u32x4*)(yc + (size_t)r * 1024 + c8) = pack8(a);
    }
}
__device__ __forceinline__ void d1_sample_delta(const KP& P, const int l, float* shm) {
    const int tidx_ = otid(), bidx_ = obid(); (void)tidx_; (void)bidx_;
    unsigned char* ws = ows(P.ws);
    const int tid = tidx_, dvq = tid & 31, dkg = tid >> 5, lane = tid & 63;
    float* part = shm;
    float* part2 = shm + 2048;
    float* qs = shm + 4096;
    float* ks = qs + 512; float* vs = ks + 512;
    const float* qns = (const float*)(ws + W_QKVNS); const float* betab = (const float*)(ws + W_BETA); const float* ggb = (const float*)(ws + W_GG);
    const bf16_t* zb = (const bf16_t*)(ws + W_Z); bf16_t* yb = (bf16_t*)(ws + W_YB);
    for (int it = bidx_ - 128; it < 1024; it += gridDim.x - 128) {
        const int b = it >> 3, h = it & 7;
        const size_t so = ((size_t)(l * 128 + b) * 8 + h) * 16384;
        const float* s0 = P.in[I_SD] + so; float* sout = P.out + OUT_DS + so;
        f32x4 S[8];
#pragma unroll
        for (int i = 0; i < 8; ++i) S[i] = __builtin_nontemporal_load((const f32x4*)(s0 + (size_t)(8 * dkg + i) * 128 + 4 * dvq));
        __syncthreads();
        for (int e = tid; e < 1536; e += 512) { const int t = (e >> 7) & 3, d = e & 127, wh = e >> 9; qs[e] = qns[(size_t)(b * 4 + t) * 3072 + wh * 1024 + h * 128 + d]; }
        __syncthreads();
#pragma unroll 1
        for (int t = 0; t < 4; ++t) {
            const int row = MP + b * 4 + t;
            const float a = __expf(ggb[(size_t)row * 8 + h]), be = betab[(size_t)row * 8 + h];
            f32x4 p = {0.f, 0.f, 0.f, 0.f};
#pragma unroll
            for (int i = 0; i < 8; ++i) p += ks[t * 128 + 8 * dkg + i] * S[i];
            *(f32x4*)(part + dkg * 128 + 4 * dvq) = p;
            __syncthreads();
            f32x4 kS = {0.f, 0.f, 0.f, 0.f};
#pragma unroll
            for (int j = 0; j < 16; ++j) kS += *(const f32x4*)(part + j * 128 + 4 * dvq);
            const f32x4 vv = *(const f32x4*)(vs + t * 128 + 4 * dvq);
            const f32x4 vn = be * (vv - a * kS);
            f32x4 po = {0.f, 0.f, 0.f, 0.f};
#pragma unroll
            for (int i = 0; i < 8; ++i) { S[i] = a * S[i] + ks[t * 128 + 8 * dkg + i] * vn; po += qs[t * 128 + 8 * dkg + i] * S[i]; }
            *(f32x4*)(part2 + dkg * 128 + 4 * dvq) = po;
            __syncthreads();
            if (tid < 64) {
                float o0 = 0.f, o1 = 0.f;
#pragma unroll
                for (int j = 0; j < 16; ++j) { o0 += part2[j * 128 + lane]; o1 += part2[j * 128 + 64 + lane]; }
                const float rstd = rsqrtf(wave_sum(o0 * o0 + o1 * o1) * (1.f / 128.f) + RMS_EPS);
                const float* ng = P.in[I_NBG] + (size_t)l * 128;
                const size_t o = (size_t)row * 1024 + h * 128;
                yb[o + lane] = f2bf(o0 * rstd * ng[lane] * silu_(bf2f(zb[o + lane])));
                yb[o + 64 + lane] = f2bf(o1 * rstd * ng[64 + lane] * silu_(bf2f(zb[o + 64 + lane])));
            }
        }
#pragma unroll
        for (int i = 0; i < 8; ++i) __builtin_nontemporal_store(S[i], (f32x4*)(sout + (size_t)(8 * dkg + i) * 128 + 4 * dvq));
    }
}

struct D2Frags { bf16x8 nwh[4], qd[4], qk[2], kd[2][2]; float u[4]; float gl; };
__device__ __forceinline__ void d2_load(D2Frags& f, const unsigned char* ws, const int T, const int rg, const int lr, const int lq, const int dvc) {
    const bf16_t* DNW = (const bf16_t*)(ws + W_DNW); const bf16_t* DQD = (const bf16_t*)(ws + W_DQD);
    const bf16_t* DKDT = (const bf16_t*)(ws + W_DKDT); const bf16_t* DQK = (const bf16_t*)(ws + W_DQK);
    const unsigned o8 = (unsigned)T * 8192u + (unsigned)(16 * rg + lr) * 128u + lq * 8;
#pragma unroll
    for (int ks = 0; ks < 4; ++ks) { f.nwh[ks] = *(const bf16x8*)(DNW + o8 + ks * 32); f.qd[ks] = *(const bf16x8*)(DQD + o8 + ks * 32); }
#pragma unroll
    for (int k2 = 0; k2 < 2; ++k2) {
        f.qk[k2] = *(const bf16x8*)(DQK + (unsigned)T * 4096u + (unsigned)(16 * rg + lr) * 64u + k2 * 32 + lq * 8);
#pragma unroll
        for (int t2 = 0; t2 < 2; ++t2) f.kd[t2][k2] = *(const bf16x8*)(DKDT + (unsigned)T * 8192u + (unsigned)(32 * rg + 16 * t2 + lr) * 64u + k2 * 32 + lq * 8);
    }
#pragma unroll
    for (int j = 0; j < 4; ++j) f.u[j] = ((const float*)(ws + W_DU))[(unsigned)T * 8192u + (unsigned)(16 * rg + 4 * lq + j) * 128u + dvc];
    f.gl = ((const float*)(ws + W_DGL))[T];
}
#define MF(a_, b_, c_) c_ = __builtin_amdgcn_mfma_f32_16x16x32_bf16(a_, b_, c_, 0, 0, 0)
__device__ __forceinline__ void d2_step(const D2Frags& cur, D2Frags& nxt, const unsigned char* ws, const int Tn, const int r0, const int h, const int rg, const int lr, const int lq, const int dvc,
                                        bf16_t* StH, bf16_t* StL, bf16_t* vnT, float* ob, f32x4 (&S)[2]) {
    d2_load(nxt, ws, Tn, rg, lr, lq, dvc);
    asm volatile("" ::: "memory");
    bf16x8 bSh[4], bSl[4];
#pragma unroll
    for (int ks = 0; ks < 4; ++ks) { bSh[ks] = *(const bf16x8*)(StH + lr * 136 + ks * 32 + lq * 8); bSl[ks] = *(const bf16x8*)(StL + lr * 136 + ks * 32 + lq * 8); }
    f32x4 av = {cur.u[0], cur.u[1], cur.u[2], cur.u[3]};
#pragma unroll
    for (int ks = 0; ks < 4; ++ks) { MF(cur.nwh[ks], bSh[ks], av); MF(cur.nwh[ks], bSl[ks], av); }
    { u32x2 q; q.x = pk2(av[0], av[1]); q.y = pk2(av[2], av[3]); *(u32x2*)(vnT + lr * 72 + 16 * rg + 4 * lq) = q; }
    f32x4 ao = {0.f, 0.f, 0.f, 0.f};
#pragma unroll
    for (int ks = 0; ks < 4; ++ks) MF(cur.qd[ks], bSh[ks], ao);
    __syncthreads();
    bf16x8 bV[2];
#pragma unroll
    for (int k2 = 0; k2 < 2; ++k2) bV[k2] = *(const bf16x8*)(vnT + lr * 72 + k2 * 32 + lq * 8);
#pragma unroll
    for (int k2 = 0; k2 < 2; ++k2) MF(cur.qk[k2], bV[k2], ao);
#pragma unroll
    for (int t2 = 0; t2 < 2; ++t2) {
        S[t2] *= cur.gl;
#pragma unroll
        for (int k2 = 0; k2 < 2; ++k2) MF(cur.kd[t2][k2], bV[k2], S[t2]);
        float hf[4], lf[4];
#pragma unroll
        for (int j = 0; j < 4; ++j) { hf[j] = bf2f(f2bf(S[t2][j])); lf[j] = S[t2][j] - hf[j]; }
        u32x2 q; q.x = pk2(hf[0], hf[1]); q.y = pk2(hf[2], hf[3]); *(u32x2*)(StH + lr * 136 + 32 * rg + 16 * t2 + 4 * lq) = q;
        q.x = pk2(lf[0], lf[1]); q.y = pk2(lf[2], lf[3]); *(u32x2*)(StL + lr * 136 + 32 * rg + 16 * t2 + 4 * lq) = q;
    }
#pragma unroll
    for (int j = 0; j < 4; ++j) ob[(unsigned)(r0 + 16 * rg + 4 * lq + j) * 1024u + h * 128 + dvc] = ao[j];
    __syncthreads();
}
__device__ __forceinline__ void d2_scan(const KP& P, const int l, unsigned char* shmb) {
    const int tidx_ = otid(), bidx_ = obid(); (void)tidx_; (void)bidx_;
    unsigned char* ws = ows(P.ws);
    const int tid = tidx_, w = tid >> 6, lane = tid & 63, lr = lane & 15, lq = lane >> 4, sl = w >> 2, rg = w & 3;
    bf16_t* StH = (bf16_t*)(shmb + sl * 11008); bf16_t* StL = StH + 16 * 136; bf16_t* vnT = StL + 16 * 136;
    float* ob = (float*)(ws + W_OB);
    for (int item = bidx_; item < 128; item += gridDim.x) {
        const int chain = item >> 2, dq = item & 3, b = chain >> 3, h = chain & 7, dv0 = 32 * dq + 16 * sl, dvc = dv0 + lr;
        f32x4 S[2];
        S[0] = (f32x4){0.f, 0.f, 0.f, 0.f}; S[1] = (f32x4){0.f, 0.f, 0.f, 0.f};
        __syncthreads();
        for (int e = tid; e < 2 * 11008 / 4; e += 512) ((unsigned*)shmb)[e] = 0u;
        __syncthreads();
        D2Frags fa, fb; d2_load(fa, ws, chain * 32, rg, lr, lq, dvc);
#pragma unroll 1
        for (int n = 0; n < 32; n += 2) {
            const int T = chain * 32 + n, r0 = b * 2048 + n * 64;
            d2_step(fa, fb, ws, T + 1, r0, h, rg, lr, lq, dvc, StH, StL, vnT, ob, S);
            d2_step(fb, fa, ws, (n < 30) ? T + 2 : T + 1, r0 + 64, h, rg, lr, lq, dvc, StH, StL, vnT, ob, S);
        }
        float* sout = P.out + OUT_DP + ((size_t)(l * 4 + b) * 8 + h) * 16384;
#pragma unroll
        for (int t2 = 0; t2 < 2; ++t2)
#pragma unroll
            for (int j = 0; j < 4; ++j) sout[(unsigned)(32 * rg + 16 * t2 + 4 * lq + j) * 128u + dvc] = S[t2][j];
    }
}
#undef MF
__device__ __forceinline__ void onorm(const KP& P, const int l) {
    const int tidx_ = otid(), bidx_ = obid(); (void)tidx_; (void)bidx_;
    unsigned char* ws = ows(P.ws);
    const int lane = tidx_ & 63, gw = bidx_ * 8 + (tidx_ >> 6), ngw = gridDim.x * 8;
    const float* ob = (const float*)(ws + W_OB); const bf16_t* zb = (const bf16_t*)(ws + W_Z); bf16_t* yb = (bf16_t*)(ws + W_YB);
    const float* ng = P.in[I_NBG] + (size_t)l * 128 + (lane & 7) * 16;
    for (int r = gw; r < MP; r += ngw) {
        const unsigned o = (unsigned)r * 1024u + lane * 16;
        float x[16]; float ss = 0.f;
#pragma unroll
        for (int q = 0; q < 4; ++q) { const f32x4 v = *(const f32x4*)(ob + o + 4 * q); x[4 * q] = v[0]; x[4 * q + 1] = v[1]; x[4 * q + 2] = v[2]; x[4 * q + 3] = v[3]; ss += (v[0] * v[0] + v[1] * v[1]) + (v[2] * v[2] + v[3] * v[3]); }
        ss += __shfl_xor(ss, 1); ss += __shfl_xor(ss, 2); ss += __shfl_xor(ss, 4);
        const float rstd = rsqrtf(ss * (1.f / 128.f) + RMS_EPS);
        float z0[8], z1[8]; unpack8(*(const u32x4*)(zb + o), z0); unpack8(*(const u32x4*)(zb + o + 8), z1);
        float y0[8], y1[8];
#pragma unroll
        for (int e = 0; e < 8; ++e) { y0[e] = x[e] * rstd * ng[e] * silu_(z0[e]); y1[e] = x[8 + e] * rstd * ng[8 + e] * silu_(z1[e]); }
        *(u32x4*)(yb + o) = pack8(y0); *(u32x4*)(yb + o + 8) = pack8(y1);
    }
}

__device__ __forceinline__ void phase_f(const KP& P, const int l) {
    const int tidx_ = otid(), bidx_ = obid(); (void)tidx_; (void)bidx_;
    unsigned char* ws = ows(P.ws);
    const bf16_t* hg = (const bf16_t*)(ws + W_HG); const bf16_t* hu = (const bf16_t*)(ws + W_HU); bf16_t* hh = (bf16_t*)(ws + W_H);
    const float* cw = P.in[I_CFW] + (size_t)l * 3 * DFF; const float* hist = P.in[I_SCF] + (size_t)l * 128 * 2 * DFF;
    constexpr int C8 = DFF / 8;
    for (int i = bidx_ * 512 + tidx_; i < (MT / 4) * C8; i += gridDim.x * 512) {
        const int q = i / C8, c8 = (i % C8) * 8, r0 = 4 * q;
        const bool smp = r0 >= MP; const int t0 = smp ? 0 : (r0 & 2047), sb = (r0 - MP) >> 2;
        float x[6][8];
#pragma unroll
        for (int d = 0; d < 2; ++d) {
            if (t0 > 0) unpack8(*(const u32x4*)(hg + (size_t)(r0 - 2 + d) * DFF + c8), x[d]);
            else if (smp) { const float* hp = hist + ((size_t)sb * 2 + d) * DFF + c8; const f32x4 h0 = *(const f32x4*)hp, h1 = *(const f32x4*)(hp + 4);
#pragma unroll
                for (int j = 0; j < 4; ++j) { x[d][j] = h0[j]; x[d][4 + j] = h1[j]; } }
            else {
#pragma unroll
                for (int j = 0; j < 8; ++j) x[d][j] = 0.f; }
        }
#pragma unroll
        for (int d = 0; d < 4; ++d) unpack8(*(const u32x4*)(hg + (size_t)(r0 + d) * DFF + c8), x[2 + d]);
        float w[3][8];
#pragma unroll
        for (int d = 0; d < 3; ++d) { const f32x4 w0 = *(const f32x4*)(cw + d * DFF + c8), w1 = *(const f32x4*)(cw + d * DFF + c8 + 4);
#pragma unroll
            for (int j = 0; j < 4; ++j) { w[d][j] = w0[j]; w[d][4 + j] = w1[j]; } }
#pragma unroll
        for (int d = 0; d < 4; ++d) {
            float u[8], a[8]; unpack8(*(const u32x4*)(hu + (size_t)(r0 + d) * DFF + c8), u);
#pragma unroll
            for (int j = 0; j < 8; ++j) a[j] = silu_(w[0][j] * x[d][j] + w[1][j] * x[d + 1][j] + w[2][j] * x[d + 2][j]) * u[j];
            *(u32x4*)(hh + (size_t)(r0 + d) * DFF + c8) = pack8(a);
        }
    }
}

#define XB_TMO      128
#define XB_XCNT(j)  (256  + 64 * (j))
#define XB_XSUB(j)  (1280 + 64 * (j))
#define XB_XGEN(j)  (2304 + 64 * (j))
#define XB_TOP      3328
#define XB_TOPGEN   3392
#define XCD_BAR_WORDS 3456
#define XB_SPIN_CAP (1u << 18)

__device__ __forceinline__ unsigned xb_ld(unsigned* p)              { return __hip_atomic_load(p, __ATOMIC_RELAXED, __HIP_MEMORY_SCOPE_AGENT); }
__device__ __forceinline__ unsigned xb_add(unsigned* p, unsigned v) { return __hip_atomic_fetch_add(p, v, __ATOMIC_RELAXED, __HIP_MEMORY_SCOPE_AGENT); }
__device__ __forceinline__ unsigned xb_xcc_id() { return (unsigned)__builtin_amdgcn_s_getreg((3 << 11) | 20) & 0xFu; }
#define XB_SPIN(cond, bar) do { unsigned _sp = 0; while (cond) { __builtin_amdgcn_s_sleep(1); \
    if ((++_sp & 255u) == 0u) { if (xb_ld(&(bar)[XB_TMO])) break; if (_sp > XB_SPIN_CAP) { atomicAdd(&(bar)[XB_TMO], 1u); break; } } } } while (0)

struct XcdBarrier {
    unsigned* bar; unsigned x;
    volatile LAS unsigned* st;
};

__device__ __forceinline__ XcdBarrier xcd_barrier_post(unsigned* bar, volatile LAS unsigned* st) {
    XcdBarrier b; b.bar = bar; b.x = xb_xcc_id(); b.st = st;
    if (threadIdx.x == 0) (void)xb_add(&bar[XB_XCNT(b.x)], 1u);
    return b;
}
__device__ __forceinline__ void xcd_barrier_complete(unsigned* bar, unsigned x, unsigned& nloc, unsigned& nx) {
    const unsigned G = gridDim.x * gridDim.y * gridDim.z;
    unsigned sum, cnt, mine, sp = 0u;
    for (;;) {
        sum = 0u; cnt = 0u; mine = 0u;
#pragma unroll
        for (unsigned j = 0; j < 16; ++j) { const unsigned c = xb_ld(&bar[XB_XCNT(j)]); sum += c; cnt += (c > 0u) ? 1u : 0u; mine = (j == x) ? c : mine; }
        if (sum == G) break;
        __builtin_amdgcn_s_sleep(1);
        if ((++sp & 255u) == 0u) { if (xb_ld(&bar[XB_TMO])) break; if (sp > XB_SPIN_CAP) { atomicAdd(&bar[XB_TMO], 1u); break; } }
    }
    nloc = mine > 0u ? mine : 1u; nx = cnt > 0u ? cnt : 1u;
}

__device__ __forceinline__ void xcd_barrier(const XcdBarrier& b) {
    asm volatile("s_waitcnt vmcnt(0)" ::: "memory");
    __syncthreads();
    if (threadIdx.x == 0) {
        unsigned* bar = b.bar;
        __builtin_amdgcn_s_waitcnt(0);
        unsigned nloc = b.st[0], nx = b.st[1];
        if (nloc == 0u) { xcd_barrier_complete(bar, b.x, nloc, nx); b.st[0] = nloc; b.st[1] = nx; }
        const unsigned old = xb_add(&bar[XB_XSUB(b.x)], 1u);
        const unsigned gen = old / nloc;
        if (old + 1u == (gen + 1u) * nloc) {
            __builtin_amdgcn_fence(__ATOMIC_RELEASE, "agent");
            asm volatile("s_waitcnt vmcnt(0)" ::: "memory");
            const unsigned og = xb_add(&bar[XB_TOP], 1u);
            const unsigned tg = og / nx;
            if (og + 1u == (tg + 1u) * nx) xb_add(&bar[XB_TOPGEN], 1u);
            else XB_SPIN(xb_ld(&bar[XB_TOPGEN]) == tg, bar);
            __builtin_amdgcn_fence(__ATOMIC_ACQUIRE, "agent");
            xb_add(&bar[XB_XGEN(b.x)], 1u);
            asm volatile("s_waitcnt vmcnt(0)" ::: "memory");
        } else {
            XB_SPIN(xb_ld(&bar[XB_XGEN(b.x)]) == gen, bar);
            __builtin_amdgcn_fence(__ATOMIC_ACQUIRE, "agent");
            asm volatile("s_waitcnt vmcnt(0)" ::: "memory");
        }
    }
    __syncthreads();
}

enum { K_G1 = 0, K_E, K_D1, K_D2, K_G2A, K_G2B, K_G3, K_LN1, K_G4, K_F, K_G5, K_LN2, K_PER_LAYER };
constexpr int N_PHASES = 1 + 2 * K_PER_LAYER;

__global__ void __launch_bounds__(512, 2) mega(const KP P, const int ph_lo, const int ph_hi) {
    extern __shared__ __attribute__((aligned(16))) unsigned char shm[];
    cg::grid_group grid = cg::this_grid();
    unsigned char* const ws = P.ws;
    volatile LAS unsigned* xst = (volatile LAS unsigned*)((LAS unsigned char*)shm + STAGE_BYTES);
    if (threadIdx.x == 0) { xst[0] = 0u; xst[1] = 0u; xst[2] = 0u; xst[3] = 0u; }
    __syncthreads();
    (void)xcd_barrier_post((unsigned*)(ws + W_BAR), xst);
    int again = 0;
#pragma unroll 1
    for (int ph = ph_lo; ph < ph_hi;) {
        if (ph == 0) {
#if !defined(PHSEL) || PHSEL == 0
            ln_rows(P, 0, P.in[I_LNG], P.in[I_LNB], false);
#endif
#if !defined(PHSEL) || PHSEL == 1
#endif
        } else {
            const int l = (ph - 1) / K_PER_LAYER, k = (ph - 1) % K_PER_LAYER;
            Gemm g; g.A = nullptr; g.Bt = nullptr; g.M = MT; g.N = 0; g.K = 0; int mode = -1;
            switch (k) {
                case K_G1: g.A = (const bf16_t*)(ws + W_XB); g.Bt = (const bf16_t*)(ws + W_WIN); g.N = NV1 - 256; g.K = 2048; mode = M_G1; break;
                case K_G2A: g.A = (const bf16_t*)(ws + W_YA); g.Bt = (const bf16_t*)(ws + W_WA); g.N = 2048; g.K = 1024; mode = M_G2A; break;
                case K_G2B: g.A = (const bf16_t*)(ws + W_YB); g.Bt = (const bf16_t*)(ws + W_WB); g.N = 2048; g.K = 1024; mode = M_G2B; break;
                case K_G3: g.A = (const bf16_t*)(ws + W_MGB); g.Bt = (const bf16_t*)(ws + W_WO); g.N = 2048; g.K = 2048; mode = M_G3; break;
                case K_G4: g.A = (const bf16_t*)(ws + W_XB); g.Bt = (const bf16_t*)(ws + W_WUP); g.N = NV4; g.K = 2048; mode = M_G4; break;
                case K_G5: g.A = (const bf16_t*)(ws + W_H); g.Bt = (const bf16_t*)(ws + W_WDN); g.N = 2048; g.K = DFF; mode = M_G5; break;
                default: break;
            }
            if (mode >= 0) {
#if !defined(PHSEL) || PHSEL == 2
                const int npass = (k == K_G2A) ? 3 : 1;
#pragma unroll 1
                for (int pass = 0; pass < npass; ++pass) {
                    int cblk = (int)blockIdx.x, G = (int)gridDim.x; bool skip = false;
                    if (pass == 1) {
                        g.A = (const bf16_t*)(ws + W_YC); g.Bt = (const bf16_t*)(ws + W_WC); mode = M_G2C; cblk = (cblk + G / 2) % G;
                    } else if (pass == 2) {
                        g.A = (const bf16_t*)(ws + W_PB); g.Bt = (const bf16_t*)(ws + W_WPE); g.K = 256; mode = M_PE;
                        skip = (cblk < 16) || (cblk >= 128 && cblk < 144); cblk -= (cblk < 128) ? 16 : 32; G -= 32;
                    }
                    if (!skip) {
                        const int split = ((mode == M_G3 || mode == M_G5) && gridDim.x == 256) ? 1 : 0;
                        StaticOrder S; S.init(split ? MP : g.M, g.N, g.K, G, cblk, split);
                        gemm_phase((LAS unsigned char*)shm, g, S, P, mode, l);
                    }
                }
#endif
                if (k == K_G2A) onorm(P, l);
            } else if (k == K_E) {
#if !defined(PHSEL) || PHSEL == 3
                beta_gate(P, l);
                phase_e(P, l);
#endif
            } else if (k == K_D1) {
#if !defined(PHSEL) || PHSEL == 4
                d1_prep(P, l, (float*)shm);
#endif
#if !defined(PHSEL) || PHSEL == 5
                d1_mix(P, l);
#endif

            } else if (k == K_D2) {
#if !defined(PHSEL) || PHSEL == 7
                if (blockIdx.x < 128) d2_scan(P, l, shm);
                else d1_sample_delta(P, l, (float*)shm);
#endif
            } else if (k == K_LN1) {
                ln_rows(P, 1, P.in[I_L1G] + (size_t)l * DM, P.in[I_L1B] + (size_t)l * DM, false);
            } else if (k == K_F) {
#if !defined(PHSEL) || PHSEL == 8
                phase_f(P, l);
#endif
            } else if (k == K_LN2) {
                ln_rows(P, 1, P.in[I_L2G] + (size_t)l * DM, P.in[I_L2B] + (size_t)l * DM, l == 1);
            }
        }
        {
            int cl = -1, cpart = 0, cb0 = 0, cnb = (int)gridDim.x;
            if (ph == 0) cl = 0;
            else { const int l2 = (ph - 1) / K_PER_LAYER, k2 = (ph - 1) % K_PER_LAYER;
                if (k2 == K_LN2 && l2 == 0) cl = 1;
                else if (k2 == K_G2B && blockIdx.x >= 16) { cl = l2; cpart = 1; cb0 = 16; cnb -= 16; } }
            if (cl >= 0) convert_weights(P, cl, (float*)shm, cpart, cb0, cnb);
        }
#ifdef REPMASK
        {
            const int k = ph == 0 ? -1 : (ph - 1) % K_PER_LAYER; int bit = -1;
            if (ph == 0 || k == K_LN2) bit = 0; else if (k == K_E || k == K_F) bit = 1; else if (k == K_D1) bit = 2; else if (k == K_D2) bit = 3;
            else if (k == K_G1 || k == K_G5) bit = 4; else if (k == K_G3) bit = 5; else if (k == K_LN1) bit = 6;
            if (!again && bit >= 0 && ((REPMASK >> bit) & 1)) again = 1; else { again = 0; ++ph; }
        }
#else
        ++ph; (void)again;
#endif
        if (ph < ph_hi) { if (ph_hi < 0) grid.sync();   { XcdBarrier xb; xb.bar = (unsigned*)(ows(P.ws) + W_BAR); xb.x = xb_xcc_id(); xb.st = (volatile LAS unsigned*)((LAS unsigned char*)shm + STAGE_BYTES); xcd_barrier(xb); } }
    }
}

extern "C" void kernel_launch(void* const* d_in, const int* in_sizes, int n_in, void* d_out, int out_size, void* d_ws, size_t ws_size, hipStream_t stream) {
    static int grid_blocks = 0;
    constexpr int LDS_BYTES = STAGE_BYTES + 256;
    if (grid_blocks == 0) {
        if (n_in != 33 || (size_t)out_size != OUT_END || ws_size < WS_TOTAL) {
            fprintf(stderr, "kernel_launch: unexpected problem (n_in %d, out %d vs %zu, ws %zu vs %zu)\n", n_in, out_size, (size_t)OUT_END, ws_size, (size_t)WS_TOTAL);
            grid_blocks = -1; return;
        }
        int dev = 0, cus = 0, per_cu = 0;
        hipGetDevice(&dev);
        hipDeviceGetAttribute(&cus, hipDeviceAttributeMultiprocessorCount, dev);
        hipFuncSetAttribute((const void*)mega, hipFuncAttributeMaxDynamicSharedMemorySize, LDS_BYTES);
        hipOccupancyMaxActiveBlocksPerMultiprocessor(&per_cu, (const void*)mega, 512, LDS_BYTES);
        if (per_cu < 1) per_cu = 1;
        grid_blocks = cus * 1;
        (void)hipGetLastError();
    }
    if (grid_blocks < 0) return;
    if (hipMemsetAsync((unsigned char*)d_ws + W_BAR, 0, XCD_BAR_WORDS * sizeof(unsigned), stream) != hipSuccess) { fprintf(stderr, "kernel_launch: memset of the barrier words failed\n"); return; }
    KP p{};
    for (int i = 0; i < 33; ++i) p.in[i] = (const float*)d_in[i];
    p.out = (float*)d_out; p.ws = (unsigned char*)d_ws;
    int lo = 0, hi = N_PHASES;
    void* args[] = {&p, &lo, &hi};
    hipError_t e = hipLaunchCooperativeKernel((const void*)mega, dim3(grid_blocks), dim3(512), args, LDS_BYTES, stream);
    if (e != hipSuccess) fprintf(stderr, "cooperative launch failed: %s (grid %d)\n", hipGetErrorString(e), grid_blocks);
}
```

```cpp
#include <hip/hip_runtime.h>
#include <hip/hip_cooperative_groups.h>
#include <cstdio>
#include <cstdint>
namespace cg = cooperative_groups;

#define LAS __attribute__((address_space(3)))
typedef unsigned short bf16_t;
typedef short bf16x8 __attribute__((ext_vector_type(8)));
typedef float f32x4 __attribute__((ext_vector_type(4)));
typedef unsigned u32x4 __attribute__((ext_vector_type(4)));
typedef unsigned u32x2 __attribute__((ext_vector_type(2)));

constexpr int DM = 2048, NBP = 4, SEQ = 2048, NBS = 128, DSQ = 4;
constexpr int MP = NBP * SEQ, MS = NBS * DSQ, MT = MP + MS;
constexpr int DPLE = 256, DA = 1024, HB = 8, DB = 1024, DC = 1024, DFF = 5504, NIN = 15376;
constexpr int NV1 = 61 * 256, NV4 = 2 * DFF + DM;
constexpr float ALPHA = 1.41421356237f, LN_EPS = 1e-5f, RMS_EPS = 1e-6f;

constexpr size_t OUT_YP = 0, OUT_YS = OUT_YP + (size_t)MP * DM, OUT_CAP = OUT_YS + (size_t)MS * DM, OUT_CQP = OUT_CAP + 2 * 4 * 2 * 1024,
                 OUT_DP = OUT_CQP + 2 * 4 * 3 * 3072, OUT_CFP = OUT_DP + 2 * 4 * 8 * 16384, OUT_CAS = OUT_CFP + 2 * 4 * 2 * 5504,
                 OUT_CQS = OUT_CAS + 2 * 128 * 2 * 1024, OUT_DS = OUT_CQS + 2 * 128 * 3 * 3072, OUT_CFS = OUT_DS + (size_t)2 * 128 * 8 * 16384,
                 OUT_VS = OUT_CFS + 2 * 128 * 2 * 5504, OUT_END = OUT_VS + 2 * 128 * 4 * 1024;

constexpr size_t al256(size_t x) { return (x + 255) & ~(size_t)255; }
constexpr size_t W_WIN = 0, W_WA = W_WIN + (size_t)NV1 * 2048 * 2, W_WB = W_WA + (size_t)2048 * 1024 * 2, W_WC = W_WB + (size_t)2048 * 1024 * 2,
                 W_WO = W_WC + (size_t)2048 * 1024 * 2, W_WUP = W_WO + (size_t)2048 * 2048 * 2, W_WDN = W_WUP + (size_t)NV4 * 2048 * 2,
                 W_WPE = W_WDN + (size_t)2048 * DFF * 2, W_XRES = W_WPE + (size_t)2048 * 256 * 2, W_XB = W_XRES + (size_t)MT * DM * 4,
                 W_PRE = W_XB + (size_t)MT * DM * 2, W_PB = W_PRE + (size_t)MT * DM * 4, W_R = W_PB + (size_t)MT * DPLE * 2;
constexpr size_t W_CH = W_R, W_BG = W_CH + (size_t)MT * 1024 * 2, W_QKV = W_BG + (size_t)MT * 1024 * 2, W_Z = W_QKV + (size_t)MT * 3072 * 2,
                 W_GU = W_Z + (size_t)MT * 1024 * 2, W_GV = W_GU + (size_t)MT * 1024 * 2, W_GTS = W_GV + (size_t)MT * 1024 * 2,
                 W_BETA = W_GTS + (size_t)MT * 6144 * 2, W_GG = W_BETA + al256((size_t)MT * 8 * 4), W_YA = W_GG + al256((size_t)MT * 8 * 4),
                 W_YB = W_YA + (size_t)MT * 1024 * 2, W_YC = W_YB + (size_t)MT * 1024 * 2, W_QKVN = W_YC + (size_t)MT * 1024 * 2,
                 W_QKVNS = W_QKVN + (size_t)MT * 3072 * 2, W_VCN = W_QKVNS + (size_t)MS * 3072 * 4, W_DU = W_VCN + (size_t)MT * 1024 * 2,
                 W_DNW = W_DU + (size_t)1024 * 8192 * 4, W_DQD = W_DNW + (size_t)1024 * 8192 * 2, W_DKDT = W_DQD + (size_t)1024 * 8192 * 2,
                 W_DQK = W_DKDT + (size_t)1024 * 8192 * 2, W_DNW2 = W_DQK + (size_t)1024 * 4096 * 2, W_OB = W_DNW2 + (size_t)1024 * 8192 * 2,
                 W_DGL = W_OB + (size_t)MP * 1024 * 4, W_MG32 = W_DGL + 4096,
                 W_MGB = W_MG32 + (size_t)MT * DM * 4, W_REND = W_MGB + (size_t)MT * DM * 2;
constexpr size_t W_PE = W_R, W_HG = W_PE + (size_t)MT * DM * 4, W_HU = W_HG + (size_t)MT * DFF * 2, W_H = W_HU + (size_t)MT * DFF * 2,
                 W_FEND = W_H + (size_t)MT * DFF * 2;
constexpr size_t W_MG32C = W_VCN;
static_assert(W_MG32C + (size_t)MT * DM * 4 <= W_DKDT, "MG32C overlay");
constexpr size_t W_PART = W_VCN;
static_assert(W_PART >= W_FEND && W_PART + (size_t)16 * MS * DM * 4 <= W_OB, "partial buffer overlay");
constexpr size_t WS_NEED = W_REND > W_FEND ? W_REND : W_FEND;
constexpr size_t W_BAR = WS_NEED;
constexpr size_t WS_TOTAL = W_BAR + 16384;
static_assert(WS_TOTAL <= (size_t)1007681536, "workspace too large");

struct KP { const float* in[33]; float* out; unsigned char* ws; };
enum { I_XP = 0, I_XS, I_SCA, I_SCQ, I_SD, I_SCF, I_PP, I_PS, I_LNG, I_LNB, I_WIN, I_CAW, I_WAO, I_CBW, I_ALOG, I_DTB, I_NBG, I_WBO, I_LCG, I_LCB, I_WS, I_BS,
       I_WCO, I_WO, I_L1G, I_L1B, I_WUP, I_CFW, I_WDN, I_WPE, I_WPG, I_L2G, I_L2B };

__device__ __forceinline__ float bf2f(bf16_t h) { return __uint_as_float(((unsigned)h) << 16); }
__device__ __forceinline__ bf16_t f2bf(float f) { unsigned u = __float_as_uint(f); u += 0x7FFFu + ((u >> 16) & 1u); return (bf16_t)(u >> 16); }
typedef __bf16 bf16x2_t __attribute__((ext_vector_type(2)));
typedef float f32x2_t __attribute__((ext_vector_type(2)));
__device__ __forceinline__ unsigned pk2(float lo, float hi) { const bf16x2_t r = __builtin_convertvector((f32x2_t){lo, hi}, bf16x2_t); return __builtin_bit_cast(unsigned, r); }
__device__ __forceinline__ void split_bf(float x, bf16_t& hi, bf16_t& lo) { hi = f2bf(x); lo = f2bf(x - bf2f(hi)); }
__device__ __forceinline__ float lo16(unsigned w) { return __uint_as_float(w << 16); }
__device__ __forceinline__ float hi16(unsigned w) { return __uint_as_float(w & 0xffff0000u); }
__device__ __forceinline__ void unpack8(u32x4 w, float (&f)[8]) { f[0] = lo16(w.x); f[1] = hi16(w.x); f[2] = lo16(w.y); f[3] = hi16(w.y); f[4] = lo16(w.z); f[5] = hi16(w.z); f[6] = lo16(w.w); f[7] = hi16(w.w); }
__device__ __forceinline__ u32x4 pack8(const float (&f)[8]) { u32x4 w; w.x = pk2(f[0], f[1]); w.y = pk2(f[2], f[3]); w.z = pk2(f[4], f[5]); w.w = pk2(f[6], f[7]); return w; }
__device__ __forceinline__ float sigmoid_(float x) { return __builtin_amdgcn_rcpf(1.f + __expf(-x)); }
__device__ __forceinline__ float silu_(float x) { return x * __builtin_amdgcn_rcpf(1.f + __expf(-x)); }
__device__ __forceinline__ float gelu_(float x) { const float y = 1.5957691216f * (x + 0.044715f * x * x * x); return x * __builtin_amdgcn_rcpf(1.f + __expf(-y)); }
__device__ __forceinline__ float softplus_(float x) { return x > 20.f ? x : log1pf(__expf(x)); }
__device__ __forceinline__ float wave_sum(float v) {
#pragma unroll
    for (int o = 1; o < 64; o <<= 1) v += __shfl_xor(v, o);
    return v;
}

__device__ __forceinline__ int otid() { int t = (int)threadIdx.x; asm volatile("" : "+v"(t)); return t; }
__device__ __forceinline__ int obid() { int t = (int)blockIdx.x; asm volatile("" : "+s"(t)); return t; }
__device__ __forceinline__ unsigned char* ows(const unsigned char* p) { unsigned long long v = (unsigned long long)p; asm volatile("" : "+s"(v)); return (unsigned char*)(__attribute__((address_space(1))) unsigned char*)v; }
constexpr int BM = 256, BK = 64, HALF = 128, HTB = HALF * BK * 2, STAGE_BYTES = 8 * HTB, NXCD = 8, WGM = 8;
__device__ __forceinline__ int lds_byte(int r, int c) { const int st = (r >> 4) * 2 + (c >> 5), rr = r & 15, cc = c & 31, ob = rr * 64 + cc * 2; return st * 1024 + (ob ^ (((ob >> 9) & 1) << 5)); }
__device__ __forceinline__ void stage_rc(int b, int& R, int& C) { const int st = b / 1024, sb = b % 1024, swz = sb ^ (((sb >> 9) & 1) << 5); R = (st >> 1) * 16 + swz / 64; C = (st & 1) * 32 + (swz % 64) / 2; }
__device__ __forceinline__ int perm32(int rho) { const int n = rho >> 4, i = rho & 15; return 8 * (i >> 2) + 4 * n + (i & 3); }
struct Unit { int pm, pn, k0, nt, part; };
struct Gemm { const bf16_t* A; const bf16_t* Bt; int M, N, K; };
struct StaticOrder {
    int nM, nN, nwg, G, c, ntf, split;
    __device__ __forceinline__ void init(int M, int N, int K, int G_, int c_, int split_) { nM = M / BM; nN = N / BM; nwg = nM * nN; G = G_; c = c_; ntf = K / BK; split = split_; }
    __device__ __forceinline__ bool next(int i, Unit& u) const {
        u.k0 = 0; u.nt = ntf; u.part = -1;
        if (split) {
            if (i >= 2) return false;
            if (i == 0) { const int su = c >> 4, ks = c & 15, np = ntf >> 1, p0 = (np * ks) >> 4, p1 = (np * (ks + 1)) >> 4;
                u.pm = 32 + (su >> 3); u.pn = su & 7; u.k0 = 2 * p0; u.nt = 2 * (p1 - p0); u.part = ks; return true; }
        }
        const long L = split ? (long)c : (long)i * G + c; if (L >= nwg) return false;
        int wgid = (int)L; { const int q = nwg / NXCD, r = nwg % NXCD, xcd = wgid % NXCD, off = wgid / NXCD; wgid = (xcd < r ? xcd * (q + 1) : r * (q + 1) + (xcd - r) * q) + off; }
        const int nig = WGM * nN, gid = wgid / nig, fm = gid * WGM, gsz = (nM - fm) < WGM ? (nM - fm) : WGM;
        u.pm = fm + ((wgid % nig) % gsz); u.pn = (wgid % nig) / gsz; return true;
    }
};

enum { M_G1 = 0, M_G2A, M_G2B, M_G2C, M_G3, M_PE, M_G4, M_G5 };

__device__ __forceinline__ void st8bf(bf16_t* p, f32x4 a, f32x4 b) { u32x4 w; w.x = pk2(a[0], a[1]); w.y = pk2(a[2], a[3]); w.z = pk2(b[0], b[1]); w.w = pk2(b[2], b[3]); *(u32x4*)p = w; }
__device__ __forceinline__ void st8f(float* p, f32x4 a, f32x4 b) { *(f32x4*)p = a; *(f32x4*)(p + 4) = b; }
__device__ __forceinline__ bool tail_row(int r, int nk, int& seq, int& i, bool& smp) {
    if (r < MP) { seq = r >> 11; smp = false; i = (r & 2047) - (2048 - nk); return i >= 0; }
    const int rs = r - MP; seq = rs >> 2; smp = true; i = (rs & 3) - (4 - nk); return i >= 0;
}

__device__ __forceinline__ void epilogue(const KP& P, const int mode, const int l, const f32x4 (&acc)[2][2][4][2], const int pm, const int pn, const int part, const int wr, const int wc, const int fr_, const int fq_) {
    unsigned char* const ws = ows(P.ws); float* const out = (float*)ows((const unsigned char*)P.out);
    int fr = fr_, fq = fq_; asm volatile("" : "+v"(fr), "+v"(fq));
    const int rbase = pm * 256 + wr * 64 + fr, cl = wc * 32 + 8 * fq;
    if (mode == M_G1) {
        if (pn < 8) {
            bf16_t* ch = (bf16_t*)(ws + W_CH);
#pragma unroll
            for (int ai = 0; ai < 2; ++ai)
#pragma unroll
                for (int m = 0; m < 4; ++m) {
                    __builtin_amdgcn_sched_barrier(0); const int row = rbase + ai * 128 + m * 16, col = pn * 128 + cl;
                    const f32x4 a = acc[ai][0][m][0] * acc[ai][1][m][0], b = acc[ai][0][m][1] * acc[ai][1][m][1];
                    st8bf(ch + (unsigned)(row * 1024 + col), a, b);
                    int seq, i; bool smp;
                    if (tail_row(row, 2, seq, i, smp)) {
                        float* d = out + (smp ? OUT_CAS + ((size_t)(l * 128 + seq) * 2 + i) * 1024 : OUT_CAP + ((size_t)(l * 4 + seq) * 2 + i) * 1024) + col;
                        st8f(d, a, b);
                    }
                }
        } else if (pn == 60) {
            if (wc == 0 && fq < 2) {
                float* dst = (float*)(ws + (fq == 0 ? W_BETA : W_GG));
#pragma unroll
                for (int ai = 0; ai < 2; ++ai)
#pragma unroll
                    for (int m = 0; m < 4; ++m) {
                        __builtin_amdgcn_sched_barrier(0); const int row = rbase + ai * 128 + m * 16;
                        float v[8];
#pragma unroll
                        for (int j = 0; j < 4; ++j) { v[j] = acc[ai][0][m][0][j]; v[4 + j] = acc[ai][0][m][1][j]; }
#pragma unroll
                        for (int h = 0; h < 8; ++h) {
                            if (fq == 0) v[h] = sigmoid_(v[h]);
                            else v[h] = -__expf(P.in[I_ALOG][l * 8 + h]) * softplus_(v[h] + P.in[I_DTB][l * 8 + h]);
                        }
                        st8f(dst + (unsigned)(row * 8), (f32x4){v[0], v[1], v[2], v[3]}, (f32x4){v[4], v[5], v[6], v[7]});
                    }
            }
        } else {
            bf16_t* dstb; int ld, c0, act = 0; bool isq = false;
            if (pn < 12) { dstb = (bf16_t*)(ws + W_BG); ld = 1024; c0 = (pn - 8) * 256; }
            else if (pn < 24) { dstb = (bf16_t*)(ws + W_QKV); ld = 3072; c0 = (pn - 12) * 256; isq = true; }
            else if (pn < 28) { dstb = (bf16_t*)(ws + W_Z); ld = 1024; c0 = (pn - 24) * 256; }
            else if (pn < 32) { dstb = (bf16_t*)(ws + W_GU); ld = 1024; c0 = (pn - 28) * 256; act = 1; }
            else if (pn < 36) { dstb = (bf16_t*)(ws + W_GV); ld = 1024; c0 = (pn - 32) * 256; act = 1; }
            else { dstb = (bf16_t*)(ws + W_GTS); ld = 6144; c0 = (pn - 36) * 256; act = 2; }
#pragma unroll
            for (int ai = 0; ai < 2; ++ai)
#pragma unroll
                for (int m = 0; m < 4; ++m) {
                    __builtin_amdgcn_sched_barrier(0); const int row = rbase + ai * 128 + m * 16;
#pragma unroll
                    for (int bj = 0; bj < 2; ++bj) {
                        const int col = c0 + bj * 128 + cl;
                        f32x4 a = acc[ai][bj][m][0], b = acc[ai][bj][m][1];
                        if (act == 1) {
#pragma unroll
                            for (int j = 0; j < 4; ++j) { a[j] = gelu_(a[j]); b[j] = gelu_(b[j]); }
                        } else if (act == 2) {
#pragma unroll
                            for (int j = 0; j < 4; ++j) { a[j] = sigmoid_(a[j]); b[j] = sigmoid_(b[j]); }
                        }
                        st8bf(dstb + (unsigned)(row * ld + col), a, b);
                        if (isq) {
                            int seq, i; bool smp;
                            if (tail_row(row, 3, seq, i, smp)) {
                                float* d = out + (smp ? OUT_CQS + ((size_t)(l * 128 + seq) * 3 + i) * 3072 : OUT_CQP + ((size_t)(l * 4 + seq) * 3 + i) * 3072) + col;
                                st8f(d, a, b);
                            }
                        }
                    }
                }
        }
    } else if (mode == M_G2A || mode == M_G2B || mode == M_G2C) {
        const int which = mode - M_G2A;
        float* mg = (float*)(ws + W_MG32); const bf16_t* gts = (const bf16_t*)(ws + W_GTS); bf16_t* mgb = (bf16_t*)(ws + W_MGB);
#pragma unroll
        for (int ai = 0; ai < 2; ++ai)
#pragma unroll
            for (int m = 0; m < 4; ++m) {
                __builtin_amdgcn_sched_barrier(0); const int row = rbase + ai * 128 + m * 16;
#pragma unroll
                for (int bj = 0; bj < 2; ++bj) {
                    const int col = pn * 256 + bj * 128 + cl;
                    float g[8]; unpack8(*(const u32x4*)(gts + (unsigned)(row * 6144 + which * 2048 + col)), g);
                    f32x4 a = acc[ai][bj][m][0], b = acc[ai][bj][m][1];
#pragma unroll
                    for (int j = 0; j < 4; ++j) { a[j] *= g[j]; b[j] *= g[4 + j]; }
                    const unsigned mo = (unsigned)(row * DM + col);
                    if (which == 0) st8f(mg + mo, a, b);
                    else if (which == 2) st8f((float*)(ws + W_MG32C) + mo, a, b);
                    else { const float* mc = (const float*)(ws + W_MG32C) + mo;
                        a += *(const f32x4*)(mg + mo) + *(const f32x4*)mc; b += *(const f32x4*)(mg + mo + 4) + *(const f32x4*)(mc + 4);
                        st8bf(mgb + mo, a, b); }
                }
            }
    } else if (mode == M_G3 || mode == M_G5 || mode == M_PE) {
        const float* xr = (const float*)(ws + W_XRES); const float* pe = (const float*)(ws + W_PE);
        float* dst = (float*)(ws + (mode == M_PE ? W_PE : W_PRE));
#pragma unroll
        for (int ai = 0; ai < 2; ++ai)
#pragma unroll
            for (int m = 0; m < 4; ++m) {
                __builtin_amdgcn_sched_barrier(0); const int row = rbase + ai * 128 + m * 16;
#pragma unroll
                for (int bj = 0; bj < 2; ++bj) {
                    const unsigned o = (unsigned)(row * DM + pn * 256 + bj * 128 + cl);
                    f32x4 a = acc[ai][bj][m][0], b = acc[ai][bj][m][1];
                    if (part <= 0) {
                        if (mode == M_G3) { a += ALPHA * *(const f32x4*)(xr + o); b += ALPHA * *(const f32x4*)(xr + o + 4); }
                        if (mode == M_G5) { a += *(const f32x4*)(pe + o); b += *(const f32x4*)(pe + o + 4); }
                    }
                    if (part < 0) st8f(dst + o, a, b);
                    else st8f((float*)(ws + W_PART) + (unsigned)(part * (MS * DM)) + (o - (unsigned)(MP * DM)), a, b);
                }
            }
    } else {
        if (pn < 43) {
            bf16_t* hg = (bf16_t*)(ws + W_HG); bf16_t* hu = (bf16_t*)(ws + W_HU);
#pragma unroll
            for (int ai = 0; ai < 2; ++ai)
#pragma unroll
                for (int m = 0; m < 4; ++m) {
                    __builtin_amdgcn_sched_barrier(0); const int row = rbase + ai * 128 + m * 16;
#pragma unroll
                    for (int bj = 0; bj < 2; ++bj) {
                        const int c = pn * 256 + bj * 128 + cl;
                        const f32x4 a = acc[ai][bj][m][0], b = acc[ai][bj][m][1];
                        if (c < DFF) {
                            st8bf(hg + (unsigned)(row * DFF + c), a, b);
                            int seq, i; bool smp;
                            if (tail_row(row, 2, seq, i, smp)) {
                                float* d = out + (smp ? OUT_CFS + ((size_t)(l * 128 + seq) * 2 + i) * DFF : OUT_CFP + ((size_t)(l * 4 + seq) * 2 + i) * DFF) + c;
                                st8f(d, a, b);
                            }
                        } else st8bf(hu + (unsigned)(row * DFF + (c - DFF)), a, b);
                    }
                }
        } else {
            float* pe = (float*)(ws + W_PE);
#pragma unroll
            for (int ai = 0; ai < 2; ++ai)
#pragma unroll
                for (int m = 0; m < 4; ++m) {
                    __builtin_amdgcn_sched_barrier(0); const int row = rbase + ai * 128 + m * 16;
#pragma unroll
                    for (int bj = 0; bj < 2; ++bj) {
                        float* p = pe + (unsigned)(row * DM + (pn - 43) * 256 + bj * 128 + cl);
                        f32x4 a = acc[ai][bj][m][0], b = acc[ai][bj][m][1];
                        const f32x4 pa = *(const f32x4*)p, pb = *(const f32x4*)(p + 4);
                        const float* xq = (const float*)(ws + W_XRES) + (unsigned)(row * DM + (pn - 43) * 256 + bj * 128 + cl);
                        const f32x4 xa = *(const f32x4*)xq, xb4 = *(const f32x4*)(xq + 4);
#pragma unroll
                        for (int j = 0; j < 4; ++j) { a[j] = sigmoid_(a[j]) * pa[j] + ALPHA * xa[j]; b[j] = sigmoid_(b[j]) * pb[j] + ALPHA * xb4[j]; }
                        st8f(p, a, b);
                    }
                }
        }
    }
}

__device__ __forceinline__ void gemm_phase(LAS unsigned char* lds, const Gemm g, const StaticOrder& S, const KP& P, const int mode, const int layer) {
    const int tidx_ = otid(), bidx_ = obid(); (void)tidx_; (void)bidx_;
    const int tid = tidx_, wid = __builtin_amdgcn_readfirstlane(tid >> 6), lane = tid & 63, wr = wid >> 2, wc = wid & 3, fr = lane & 15, fq = lane >> 4;
    const int K = g.K;
    unsigned voffA[2], voffB[2];
#pragma unroll
    for (int i = 0; i < 2; ++i) { int R, C; stage_rc(tid * 16 + i * 8192, R, C); const int Rb = (R & ~31) + perm32(R & 31);
        voffA[i] = (unsigned)(R * K + C) * 2u; voffB[i] = (unsigned)(Rb * K + C) * 2u; }
    const size_t kstep = (size_t)(BK * 2);
    const size_t hstep = (size_t)HALF * K * 2;
    const size_t tstep = 2 * hstep;
    const unsigned ldsw = (unsigned)wid * 1024u;
    const int aoff = lds_byte(wr * 64 + fr, fq * 8), boff = lds_byte(wc * 32 + fr, fq * 8);
#define PG8_SA(b, h) (((b) * 2 + (h)) * HTB)
#define PG8_SB(b, h) ((4 + (b) * 2 + (h)) * HTB)
#define PG8_STAGE(bufoff, gbase, voff) do { _Pragma("unroll") for (int _i = 0; _i < 2; ++_i) \
        __builtin_amdgcn_global_load_lds((const unsigned*)((const char*)(gbase) + (voff)[_i]), (LAS unsigned*)(lds + (bufoff) + ldsw + _i * 8192), 16, 0, 0); } while (0)
#define PG8_LDA(dst, b, h) do { _Pragma("unroll") for (int m = 0; m < 4; ++m) _Pragma("unroll") for (int k = 0; k < 2; ++k) dst[m][k] = *(const LAS bf16x8*)(lds + PG8_SA(b, h) + aoff + m * 2048 + k * 1024); } while (0)
#define PG8_LDB(dst, b, h) do { _Pragma("unroll") for (int n = 0; n < 2; ++n) _Pragma("unroll") for (int k = 0; k < 2; ++k) dst[n][k] = *(const LAS bf16x8*)(lds + PG8_SB(b, h) + boff + n * 2048 + k * 1024); } while (0)
#define PG8_MMA(ai, bj, At, Bt) do { __builtin_amdgcn_s_setprio(1); _Pragma("unroll") for (int m = 0; m < 4; ++m) _Pragma("unroll") for (int n = 0; n < 2; ++n) _Pragma("unroll") for (int k = 0; k < 2; ++k) \
        acc[ai][bj][m][n] = __builtin_amdgcn_mfma_f32_16x16x32_bf16(Bt[n][k], At[m][k], acc[ai][bj][m][n], 0, 0, 0); __builtin_amdgcn_s_setprio(0); } while (0)
#define PG8_WAIT_V(n) asm volatile("s_waitcnt vmcnt(" #n ")" ::: "memory")
#define PG8_WAIT_L(n) asm volatile("s_waitcnt lgkmcnt(" #n ")" ::: "memory")
#define PG8_BAR __builtin_amdgcn_s_barrier()
#define PG8_SCHED __builtin_amdgcn_sched_barrier(0)
    Unit cur, nxt; int ui = 0;
    if (!S.next(0, cur)) return;
    f32x4 acc[2][2][4][2];
#pragma unroll
    for (int a = 0; a < 2; ++a)
#pragma unroll
        for (int b = 0; b < 2; ++b)
#pragma unroll
            for (int m = 0; m < 4; ++m)
#pragma unroll
                for (int n = 0; n < 2; ++n) acc[a][b][m][n] = (f32x4){0.f, 0.f, 0.f, 0.f};
    bf16x8 At[4][2], B0[2][2], B1[2][2];
    const char* cA = (const char*)g.A + (size_t)cur.pm * tstep + (size_t)cur.k0 * kstep; const char* cB = (const char*)g.Bt + (size_t)cur.pn * tstep + (size_t)cur.k0 * kstep;
    PG8_STAGE(PG8_SB(0, 0), cB, voffB); PG8_STAGE(PG8_SB(0, 1), cB + hstep, voffB); PG8_STAGE(PG8_SA(0, 0), cA, voffA); PG8_STAGE(PG8_SA(0, 1), cA + hstep, voffA);
    if (wr == 1) PG8_BAR;
    PG8_WAIT_V(2); PG8_BAR;
    PG8_STAGE(PG8_SB(1, 0), cB + kstep, voffB); PG8_STAGE(PG8_SA(1, 0), cA + kstep, voffA); PG8_STAGE(PG8_SB(1, 1), cB + hstep + kstep, voffB);
    PG8_WAIT_V(6); PG8_BAR;
    for (;;) {
        const bool has_next = S.next(ui + 1, nxt);
        const char* nA = has_next ? (const char*)g.A + (size_t)nxt.pm * tstep + (size_t)nxt.k0 * kstep : cA; const char* nB = has_next ? (const char*)g.Bt + (size_t)nxt.pn * tstep + (size_t)nxt.k0 * kstep : cB;
        const int nt = cur.nt;
        for (int t = 0; t < nt; t += 2) {
            const bool last = (t == nt - 2);
            const char* a1 = cA + (size_t)(t + 1) * kstep;
            const char* a2 = last ? nA : cA + (size_t)(t + 2) * kstep; const char* b2 = last ? nB : cB + (size_t)(t + 2) * kstep;
            const char* a3 = a2 + kstep; const char* b3 = b2 + kstep;
            PG8_LDB(B0, 0, 0); PG8_LDB(B1, 0, 1); PG8_SCHED; PG8_LDA(At, 0, 0); PG8_STAGE(PG8_SA(1, 1), a1 + hstep, voffA);
            PG8_WAIT_V(8); PG8_WAIT_L(0); PG8_BAR; PG8_MMA(0, 0, At, B0); PG8_MMA(0, 1, At, B1); PG8_BAR; PG8_SCHED;
            PG8_LDA(At, 0, 1); PG8_STAGE(PG8_SB(0, 0), b2, voffB); PG8_STAGE(PG8_SB(0, 1), b2 + hstep, voffB); PG8_STAGE(PG8_SA(0, 0), a2, voffA);
            PG8_WAIT_V(8); PG8_WAIT_L(0); PG8_BAR; PG8_MMA(1, 0, At, B0); PG8_MMA(1, 1, At, B1); PG8_BAR; PG8_SCHED;
            PG8_LDB(B0, 1, 0); PG8_LDB(B1, 1, 1); PG8_SCHED; PG8_LDA(At, 1, 0); PG8_STAGE(PG8_SA(0, 1), a2 + hstep, voffA);
            PG8_WAIT_V(8); PG8_WAIT_L(0); PG8_BAR; PG8_MMA(0, 0, At, B0); PG8_MMA(0, 1, At, B1); PG8_BAR; PG8_SCHED;
            PG8_LDA(At, 1, 1); PG8_STAGE(PG8_SB(1, 0), b3, voffB); PG8_STAGE(PG8_SB(1, 1), b3 + hstep, voffB); PG8_STAGE(PG8_SA(1, 0), a3, voffA);
            PG8_WAIT_V(8); PG8_WAIT_L(0); PG8_BAR; PG8_MMA(1, 0, At, B0); PG8_MMA(1, 1, At, B1); PG8_BAR; PG8_SCHED;
        }
        if (wr == 0) PG8_BAR;
        epilogue(P, mode, layer, acc, cur.pm, cur.pn, cur.part, wr, wc, fr, fq);
        if (!has_next) break;
#pragma unroll
        for (int a = 0; a < 2; ++a)
#pragma unroll
            for (int b = 0; b < 2; ++b)
#pragma unroll
                for (int m = 0; m < 4; ++m)
#pragma unroll
                    for (int n = 0; n < 2; ++n) acc[a][b][m][n] = (f32x4){0.f, 0.f, 0.f, 0.f};
        cur = nxt; cA = nA; cB = nB; ++ui;
        if (wr == 1) PG8_BAR;
    }
    PG8_WAIT_V(0);
    PG8_BAR;
#undef PG8_SA
#undef PG8_SB
#undef PG8_STAGE
#undef PG8_LDA
#undef PG8_LDB
#undef PG8_MMA
#undef PG8_WAIT_V
#undef PG8_WAIT_L
#undef PG8_BAR
#undef PG8_SCHED
}

__device__ __forceinline__ void tr_tile_w(const float* src, const int ldsrc, const int scol0, const int nvalid, const int k0, bf16_t* dst, const int K, const int drow0, float* scr, const int lane) {
    const int kk = lane >> 3, c4 = (lane & 7) * 4;
    f32x4 v[8];
#pragma unroll
    for (int p = 0; p < 8; ++p) { v[p] = (f32x4){0.f, 0.f, 0.f, 0.f}; if (c4 < nvalid) v[p] = __builtin_nontemporal_load((const f32x4*)(src + (size_t)(k0 + kk + 8 * p) * ldsrc + scol0 + c4)); }
#pragma unroll
    for (int p = 0; p < 8; ++p) {
        scr[(c4 + 0) * 65 + kk + 8 * p] = v[p][0]; scr[(c4 + 1) * 65 + kk + 8 * p] = v[p][1]; scr[(c4 + 2) * 65 + kk + 8 * p] = v[p][2]; scr[(c4 + 3) * 65 + kk + 8 * p] = v[p][3];
    }
    __builtin_amdgcn_wave_barrier();
#pragma unroll
    for (int q = 0; q < 4; ++q) {
        const int id = lane + 64 * q, n = id >> 3, c = id & 7; const float* sp = scr + n * 65 + 8 * c;
        u32x4 o; o.x = pk2(sp[0], sp[1]); o.y = pk2(sp[2], sp[3]); o.z = pk2(sp[4], sp[5]); o.w = pk2(sp[6], sp[7]);
        *(u32x4*)(dst + (size_t)(drow0 + n) * K + k0 + 8 * c) = o;
    }
    __builtin_amdgcn_wave_barrier();
}
__device__ __forceinline__ void convert_weights(const KP& P, const int l, float* scr0, const int part, const int wb0, const int nwb) {
    const int tidx_ = otid(), bidx_ = obid(); (void)tidx_; (void)bidx_;
    unsigned char* ws = ows(P.ws);
    const int lane = tidx_ & 63, wv = tidx_ >> 6, gw = (bidx_ - wb0) * 8 + wv, ngw = nwb * 8;
    float* scr = scr0 + wv * (32 * 65);
    constexpr int T_WIN = (NV1 / 32) * 32, T_W1 = 64 * 16, T_WO = 64 * 32, T_WUP = (2 * DFF / 32) * 32, T_WPG = 64 * 32, T_WDN = 64 * (DFF / 64), T_WPE = 64 * 4;
    constexpr int T_ALL = T_WIN + 3 * T_W1 + T_WO + T_WUP + T_WPG + T_WDN + T_WPE;
    constexpr int T_A = T_WIN + 3 * T_W1 + T_WO, T_LATE = T_WUP + T_WPG;
    const int njobs = part ? T_LATE : T_ALL - T_LATE;
    for (int jt = gw; jt < njobs; jt += ngw) {
        const int it = part ? T_A + jt : (jt < T_A ? jt : jt + T_LATE);
        int r = it;
        if (r < T_WIN) {
            const int nj = r >> 5, kj = r & 31, nv0 = nj * 32; int sc, nv = 32;
            if (nv0 < 2048) { const int t = nv0 >> 8, hf = (nv0 >> 7) & 1, i = nv0 & 127; sc = (hf ? 2048 : 0) + 128 * t + i; }
            else if (nv0 < 3072) sc = nv0 - 1024;
            else if (nv0 < 7168) sc = nv0;
            else if (nv0 < 15360) sc = nv0 + 16;
            else if (nv0 == 15360) { sc = 7168; nv = 16; }
            else { sc = 0; nv = 0; }
            tr_tile_w(P.in[I_WIN] + (size_t)l * 2048 * NIN, NIN, sc, nv, kj * 64, (bf16_t*)(ws + W_WIN), 2048, nv0, scr, lane); continue;
        }
        r -= T_WIN;
        if (r < 3 * T_W1) {
            const int w = r / T_W1, rr = r % T_W1, nj = rr >> 4, kj = rr & 15;
            const float* src = (w == 0 ? P.in[I_WAO] : (w == 1 ? P.in[I_WBO] : P.in[I_WCO])) + (size_t)l * 1024 * 2048;
            bf16_t* dst = (bf16_t*)(ws + (w == 0 ? W_WA : (w == 1 ? W_WB : W_WC)));
            tr_tile_w(src, 2048, nj * 32, 32, kj * 64, dst, 1024, nj * 32, scr, lane); continue;
        }
        r -= 3 * T_W1;
        if (r < T_WO) { const int nj = r >> 5, kj = r & 31; tr_tile_w(P.in[I_WO] + (size_t)l * 2048 * 2048, 2048, nj * 32, 32, kj * 64, (bf16_t*)(ws + W_WO), 2048, nj * 32, scr, lane); continue; }
        r -= T_WO;
        if (r < T_WUP) { const int nj = r >> 5, kj = r & 31; tr_tile_w(P.in[I_WUP] + (size_t)l * 2048 * 2 * DFF, 2 * DFF, nj * 32, 32, kj * 64, (bf16_t*)(ws + W_WUP), 2048, nj * 32, scr, lane); continue; }
        r -= T_WUP;
        if (r < T_WPG) { const int nj = r >> 5, kj = r & 31; tr_tile_w(P.in[I_WPG] + (size_t)l * 2048 * 2048, 2048, nj * 32, 32, kj * 64, (bf16_t*)(ws + W_WUP), 2048, 2 * DFF + nj * 32, scr, lane); continue; }
        r -= T_WPG;
        if (r < T_WDN) { const int nj = r / (DFF / 64), kj = r % (DFF / 64); tr_tile_w(P.in[I_WDN] + (size_t)l * DFF * 2048, 2048, nj * 32, 32, kj * 64, (bf16_t*)(ws + W_WDN), DFF, nj * 32, scr, lane); continue; }
        r -= T_WDN;
        { const int nj = r >> 2, kj = r & 3; tr_tile_w(P.in[I_WPE] + (size_t)l * 256 * 2048, 2048, nj * 32, 32, kj * 64, (bf16_t*)(ws + W_WPE), 256, nj * 32, scr, lane); }
    }
    bf16_t* pb = (bf16_t*)(ws + W_PB);
    if (part == 0) for (int i = bidx_ * 512 + tidx_; i < MT * 32; i += gridDim.x * 512) {
        const int r = i >> 5, c8 = (i & 31) * 8;
        const float* s = (r < MP ? P.in[I_PP] + ((size_t)l * MP + r) * 256 : P.in[I_PS] + ((size_t)l * MS + (r - MP)) * 256) + c8;
        const f32x4 a = *(const f32x4*)s, b = *(const f32x4*)(s + 4);
        st8bf(pb + (size_t)r * 256 + c8, a, b);
    }
}

__device__ __forceinline__ void ln_rows(const KP& P, const int srcsel  , const float* g, const float* b, const bool to_out) {
    const int tidx_ = otid(), bidx_ = obid(); (void)tidx_; (void)bidx_;
    unsigned char* ws = ows(P.ws);
    const int lane = tidx_ & 63, gw = bidx_ * 8 + (tidx_ >> 6), ngw = gridDim.x * 8;
    f32x4 gv[8], bv[8];
#pragma unroll
    for (int j = 0; j < 8; ++j) { gv[j] = *(const f32x4*)(g + j * 256 + lane * 4); bv[j] = *(const f32x4*)(b + j * 256 + lane * 4); }
    for (int r = gw; r < MT; r += ngw) {
        const float* src = srcsel ? (const float*)(ws + W_PRE) + (size_t)r * DM : (r < MP ? P.in[I_XP] + (size_t)r * DM : P.in[I_XS] + (size_t)(r - MP) * DM);
        f32x4 v[8]; float s = 0.f;
        if (srcsel && r >= MP && gridDim.x == 256) {
            const float* pp = (const float*)(ws + W_PART) + (size_t)(r - MP) * DM + lane * 4;
#pragma unroll
            for (int j = 0; j < 8; ++j) v[j] = __builtin_nontemporal_load((const f32x4*)(pp + j * 256));
#pragma unroll 3
            for (int ks = 1; ks < 16; ++ks)
#pragma unroll
                for (int j = 0; j < 8; ++j) v[j] += __builtin_nontemporal_load((const f32x4*)(pp + (size_t)ks * (MS * DM) + j * 256));
#pragma unroll
            for (int j = 0; j < 8; ++j) s += (v[j][0] + v[j][1]) + (v[j][2] + v[j][3]);
        } else {
#pragma unroll
            for (int j = 0; j < 8; ++j) { v[j] = __builtin_nontemporal_load((const f32x4*)(src + j * 256 + lane * 4)); s += (v[j][0] + v[j][1]) + (v[j][2] + v[j][3]); }
        }
        const float mean = wave_sum(s) * (1.f / DM); float s2 = 0.f;
#pragma unroll
        for (int j = 0; j < 8; ++j) { v[j] = v[j] - mean; s2 += (v[j][0] * v[j][0] + v[j][1] * v[j][1]) + (v[j][2] * v[j][2] + v[j][3] * v[j][3]); }
        const float rstd = rsqrtf(wave_sum(s2) * (1.f / DM) + LN_EPS);
        float* d32 = to_out ? P.out + (size_t)r * DM : (float*)(ws + W_XRES) + (size_t)r * DM;
        bf16_t* db = (bf16_t*)(ws + W_XB) + (size_t)r * DM;
#pragma unroll
        for (int j = 0; j < 8; ++j) {
            const f32x4 y = v[j] * rstd * gv[j] + bv[j];
            if (to_out) __builtin_nontemporal_store(y, (f32x4*)(d32 + j * 256 + lane * 4)); else *(f32x4*)(d32 + j * 256 + lane * 4) = y;
            if (!to_out) { u32x2 w; w.x = pk2(y[0], y[1]); w.y = pk2(y[2], y[3]); *(u32x2*)(db + j * 256 + lane * 4) = w; }
        }
    }
}

__device__ __forceinline__ void phase_e(const KP& P, const int l) {
    const int tidx_ = otid(), bidx_ = obid(); (void)tidx_; (void)bidx_;
    unsigned char* ws = ows(P.ws);
    {
        const bf16_t* ch = (const bf16_t*)(ws + W_CH); const bf16_t* bg = (const bf16_t*)(ws + W_BG); bf16_t* ya = (bf16_t*)(ws + W_YA);
        const float* cw = P.in[I_CAW] + (size_t)l * 3 * 1024; const float* hist = P.in[I_SCA] + (size_t)l * 128 * 2 * 1024;
        for (int i = bidx_ * 512 + tidx_; i < (MT / 4) * 128; i += gridDim.x * 512) {
            const int q = i >> 7, c8 = (i & 127) * 8, r0 = 4 * q;
            const bool smp = r0 >= MP; const int t0 = smp ? 0 : (r0 & 2047), sb = (r0 - MP) >> 2;
            float x[6][8];
#pragma unroll
            for (int d = 0; d < 2; ++d) {
                if (t0 > 0) unpack8(*(const u32x4*)(ch + (size_t)(r0 - 2 + d) * 1024 + c8), x[d]);
                else if (smp) { const float* h = hist + ((size_t)sb * 2 + d) * 1024 + c8; const f32x4 h0 = *(const f32x4*)h, h1 = *(const f32x4*)(h + 4);
#pragma unroll
                    for (int j = 0; j < 4; ++j) { x[d][j] = h0[j]; x[d][4 + j] = h1[j]; } }
                else {
#pragma unroll
                    for (int j = 0; j < 8; ++j) x[d][j] = 0.f; }
            }
#pragma unroll
            for (int d = 0; d < 4; ++d) unpack8(*(const u32x4*)(ch + (size_t)(r0 + d) * 1024 + c8), x[2 + d]);
            float w[3][8];
#pragma unroll
            for (int d = 0; d < 3; ++d) { const f32x4 w0 = *(const f32x4*)(cw + d * 1024 + c8), w1 = *(const f32x4*)(cw + d * 1024 + c8 + 4);
#pragma unroll
                for (int j = 0; j < 4; ++j) { w[d][j] = w0[j]; w[d][4 + j] = w1[j]; } }
#pragma unroll
            for (int d = 0; d < 4; ++d) {
                float g[8], a[8]; unpack8(*(const u32x4*)(bg + (size_t)(r0 + d) * 1024 + c8), g);
#pragma unroll
                for (int j = 0; j < 8; ++j) a[j] = g[j] * (w[0][j] * x[d][j] + w[1][j] * x[d + 1][j] + w[2][j] * x[d + 2][j]);
                *(u32x4*)(ya + (size_t)(r0 + d) * 1024 + c8) = pack8(a);
            }
        }
    }
    const int lane = tidx_ & 63, gw = bidx_ * 8 + (tidx_ >> 6), ngw = gridDim.x * 8;
    {
        const bf16_t* qkv = (const bf16_t*)(ws + W_QKV); bf16_t* qn = (bf16_t*)(ws + W_QKVN); float* qns = (float*)(ws + W_QKVNS);
        const float* cw = P.in[I_CBW] + (size_t)l * 4 * 3072; const float* hist = P.in[I_SCQ] + (size_t)l * 128 * 3 * 3072;
        for (int it = gw; it < (MT / 4) * 6; it += ngw) {
            const int q = it / 6, s4 = it % 6, c = s4 * 512 + lane * 8, r0 = 4 * q;
            const bool smp = r0 >= MP; const int t0 = smp ? 0 : (r0 & 2047), sb = (r0 - MP) >> 2;
            float x[7][8];
#pragma unroll
            for (int d = 0; d < 3; ++d) {
                if (t0 > 0) unpack8(*(const u32x4*)(qkv + (size_t)(r0 - 3 + d) * 3072 + c), x[d]);
                else if (smp) { const float* hp = hist + ((size_t)sb * 3 + d) * 3072 + c; const f32x4 h0 = *(const f32x4*)hp, h1 = *(const f32x4*)(hp + 4);
#pragma unroll
                    for (int j = 0; j < 4; ++j) { x[d][j] = h0[j]; x[d][4 + j] = h1[j]; } }
                else {
#pragma unroll
                    for (int j = 0; j < 8; ++j) x[d][j] = 0.f; }
            }
#pragma unroll
            for (int d = 0; d < 4; ++d) unpack8(*(const u32x4*)(qkv + (size_t)(r0 + d) * 3072 + c), x[3 + d]);
            float w[4][8];
#pragma unroll
            for (int d = 0; d < 4; ++d) { const f32x4 w0 = *(const f32x4*)(cw + d * 3072 + c), w1 = *(const f32x4*)(cw + d * 3072 + c + 4);
#pragma unroll
                for (int j = 0; j < 4; ++j) { w[d][j] = w0[j]; w[d][4 + j] = w1[j]; } }
#pragma unroll
            for (int d = 0; d < 4; ++d) {
                float a[8]; float ss = 0.f;
#pragma unroll
                for (int j = 0; j < 8; ++j) { a[j] = silu_(w[0][j] * x[d][j] + w[1][j] * x[d + 1][j] + w[2][j] * x[d + 2][j] + w[3][j] * x[d + 3][j]); ss += a[j] * a[j]; }
                if (s4 < 4) {
                    ss += __shfl_xor(ss, 1); ss += __shfl_xor(ss, 2); ss += __shfl_xor(ss, 4); ss += __shfl_xor(ss, 8);
                    const float sc = rsqrtf(ss + RMS_EPS) * (s4 < 2 ? 0.08838834764831845f : 1.f);
#pragma unroll
                    for (int j = 0; j < 8; ++j) a[j] *= sc;
                }
                *(u32x4*)(qn + (size_t)(r0 + d) * 3072 + c) = pack8(a);
                if (smp) st8f(qns + (size_t)(r0 + d - MP) * 3072 + c, (f32x4){a[0], a[1], a[2], a[3]}, (f32x4){a[4], a[5], a[6], a[7]});
            }
        }
    }
    {
        const bf16_t* gv = (const bf16_t*)(ws + W_GV); bf16_t* vcn = (bf16_t*)(ws + W_VCN);
        const float* lg = P.in[I_LCG] + (size_t)l * 1024; const float* lb = P.in[I_LCB] + (size_t)l * 1024;
        for (int r = gw; r < MT; r += ngw) {
            float x[2][8]; float s = 0.f;
#pragma unroll
            for (int j = 0; j < 2; ++j) { unpack8(*(const u32x4*)(gv + (size_t)r * 1024 + j * 512 + lane * 8), x[j]);
#pragma unroll
                for (int e = 0; e < 8; ++e) s += x[j][e]; }
            const float mean = wave_sum(s) * (1.f / 1024.f); float s2 = 0.f;
#pragma unroll
            for (int j = 0; j < 2; ++j)
#pragma unroll
                for (int e = 0; e < 8; ++e) { x[j][e] -= mean; s2 += x[j][e] * x[j][e]; }
            const float rstd = rsqrtf(wave_sum(s2) * (1.f / 1024.f) + LN_EPS);
#pragma unroll
            for (int j = 0; j < 2; ++j) {
                const int c = j * 512 + lane * 8;
#pragma unroll
                for (int e = 0; e < 8; ++e) x[j][e] = x[j][e] * rstd * lg[c + e] + lb[c + e];
                *(u32x4*)(vcn + (size_t)r * 1024 + c) = pack8(x[j]);
                if (r >= MP) { float* d = P.out + OUT_VS + ((size_t)l * MS + (r - MP)) * 1024 + c;
                    st8f(d, (f32x4){x[j][0], x[j][1], x[j][2], x[j][3]}, (f32x4){x[j][4], x[j][5], x[j][6], x[j][7]}); }
            }
        }
    }
}

__device__ __forceinline__ void beta_gate(const KP& P, const int l) {
    const int tidx_ = otid(), bidx_ = obid(); (void)tidx_; (void)bidx_;
    unsigned char* ws = ows(P.ws);
    const int lane = tidx_ & 63, lr = lane & 15, lq = lane >> 4, gw = bidx_ * 8 + (tidx_ >> 6), ngw = gridDim.x * 8;
    const bf16_t* xb = (const bf16_t*)(ws + W_XB); const bf16_t* wt = (const bf16_t*)(ws + W_WIN) + (size_t)15360 * 2048;
    float* betab = (float*)(ws + W_BETA); float* ggb = (float*)(ws + W_GG);
    for (int it = gw; it < MT / 16; it += ngw) {
        const bf16_t* ap = xb + (size_t)(16 * it + lr) * 2048 + lq * 8; const bf16_t* bp = wt + (size_t)lr * 2048 + lq * 8;
        f32x4 acc0 = {0.f, 0.f, 0.f, 0.f}, acc1 = {0.f, 0.f, 0.f, 0.f};
#pragma unroll 8
        for (int ks = 0; ks < 64; ks += 2) {
            acc0 = __builtin_amdgcn_mfma_f32_16x16x32_bf16(*(const bf16x8*)(ap + ks * 32), *(const bf16x8*)(bp + ks * 32), acc0, 0, 0, 0);
            acc1 = __builtin_amdgcn_mfma_f32_16x16x32_bf16(*(const bf16x8*)(ap + ks * 32 + 32), *(const bf16x8*)(bp + ks * 32 + 32), acc1, 0, 0, 0);
        }
        const int h = lr & 7; const float al = -__expf(P.in[I_ALOG][l * 8 + h]), dtb = P.in[I_DTB][l * 8 + h];
#pragma unroll
        for (int j = 0; j < 4; ++j) {
            const float v = acc0[j] + acc1[j]; const int row = 16 * it + 4 * lq + j;
            if (lr < 8) betab[row * 8 + h] = sigmoid_(v); else ggb[row * 8 + h] = al * softplus_(v + dtb);
        }
    }
}
__device__ __forceinline__ void d1_prep(const KP& P, const int l, float* shm) {
    const int tidx_ = otid(), bidx_ = obid(); (void)tidx_; (void)bidx_;
    unsigned char* ws = ows(P.ws);
    const int tid = tidx_, w = tid >> 6, lane = tid & 63, lr = lane & 15, lq = lane >> 4;
    float* Am = shm;
    float* gc = Am + 64 * 68;
    float* bt = gc + 64;
    float* X = shm + 8192;
    const bf16_t* qn = (const bf16_t*)(ws + W_QKVN);
    const float* betab = (const float*)(ws + W_BETA); const float* ggb = (const float*)(ws + W_GG);
    float* DU = (float*)(ws + W_DU); bf16_t* DNW = (bf16_t*)(ws + W_DNW); bf16_t* DQD = (bf16_t*)(ws + W_DQD); bf16_t* DKDT = (bf16_t*)(ws + W_DKDT);
    bf16_t* DQK = (bf16_t*)(ws + W_DQK); float* DGL = (float*)(ws + W_DGL);
    for (int T = bidx_; T < 1024; T += gridDim.x) {
        const int chain = T >> 5, n = T & 31, b = chain >> 3, h = chain & 7, r0 = b * 2048 + n * 64;
        const bf16_t* qp = qn + (size_t)r0 * 3072 + h * 128; const bf16_t* kp = qp + 1024; const bf16_t* vp = qp + 2048;
        if (w == 0) {
            float v = ggb[(size_t)(r0 + lane) * 8 + h];
#pragma unroll
            for (int o = 1; o < 64; o <<= 1) { const float t = __shfl_up(v, o); if (lane >= o) v += t; }
            gc[lane] = v; bt[lane] = betab[(size_t)(r0 + lane) * 8 + h];
        }
        __syncthreads();
        {
            const int rt = w & 3;
            bf16x8 ak[4], aq[4];
#pragma unroll
            for (int ks = 0; ks < 4; ++ks) { ak[ks] = *(const bf16x8*)(kp + (size_t)(16 * rt + lr) * 3072 + ks * 32 + lq * 8); aq[ks] = *(const bf16x8*)(qp + (size_t)(16 * rt + lr) * 3072 + ks * 32 + lq * 8); }
#pragma unroll
            for (int c2 = 0; c2 < 2; ++c2) {
                const int nt = 2 * (w >> 2) + c2;
                f32x4 ckk = {0.f, 0.f, 0.f, 0.f}, cqk = {0.f, 0.f, 0.f, 0.f};
#pragma unroll
                for (int ks = 0; ks < 4; ++ks) {
                    const bf16x8 bb = *(const bf16x8*)(kp + (size_t)(16 * nt + lr) * 3072 + ks * 32 + lq * 8);
                    ckk = __builtin_amdgcn_mfma_f32_16x16x32_bf16(ak[ks], bb, ckk, 0, 0, 0);
                    cqk = __builtin_amdgcn_mfma_f32_16x16x32_bf16(aq[ks], bb, cqk, 0, 0, 0);
                }
                const int jj = 16 * nt + lr; const float gj = gc[jj];
#pragma unroll
                for (int j = 0; j < 4; ++j) {
                    const int i = 16 * rt + 4 * lq + j; const float dec = __expf(fminf(gc[i] - gj, 0.f));
                    Am[i * 68 + jj] = (i > jj) ? bt[i] * ckk[j] * dec : 0.f;
                    DQK[(size_t)T * 4096 + i * 64 + jj] = f2bf((i >= jj) ? cqk[j] * dec : 0.f);
                }
            }
        }
        __syncthreads();
        {
            const int c = tid & 255, hf = tid >> 8; const bool isv = c < 128; const bf16_t* colp = isv ? vp + c : kp + (c - 128);
#pragma unroll 16
            for (int i2 = 0; i2 < 32; ++i2) { const int i = hf * 32 + i2; float rhs = bf2f(colp[(size_t)i * 3072]) * bt[i]; if (!isv) rhs *= __expf(gc[i]); X[i * 256 + c] = rhs; }
            const float glast = gc[63];
#pragma unroll 8
            for (int e = tid; e < 8192; e += 512) { const int i = e >> 7, d = e & 127; DQD[(size_t)T * 8192 + e] = f2bf(bf2f(qp[(size_t)i * 3072 + d]) * __expf(gc[i])); }
#pragma unroll 8
            for (int e = tid; e < 8192; e += 512) { const int d = e >> 6, i = e & 63; DKDT[(size_t)T * 8192 + e] = f2bf(bf2f(kp[(size_t)i * 3072 + d]) * __expf(glast - gc[i])); }
            if (tid == 0) DGL[T] = __expf(glast);
        }
        __syncthreads();
#pragma unroll
        for (int I = 0; I < 4; ++I) {
            if (I > 0) {
#pragma unroll
                for (int c2 = 0; c2 < 2; ++c2) {
                    const int ct = 2 * w + c2;
                    f32x4 acc = {0.f, 0.f, 0.f, 0.f};
#pragma unroll
                    for (int kk = 0; kk < 4 * I; ++kk)
                        acc = __builtin_amdgcn_mfma_f32_16x16x4f32(Am[(16 * I + lr) * 68 + 4 * kk + lq], X[(4 * kk + lq) * 256 + 16 * ct + lr], acc, 0, 0, 0);
#pragma unroll
                    for (int j = 0; j < 4; ++j) X[(16 * I + 4 * lq + j) * 256 + 16 * ct + lr] -= acc[j];
                }
                __syncthreads();
            }
            if (tid < 256) {
                float x[16];
#pragma unroll
                for (int r = 0; r < 16; ++r) x[r] = X[(16 * I + r) * 256 + tid];
#pragma unroll
                for (int r = 1; r < 16; ++r) {
                    float sacc = 0.f;
#pragma unroll
                    for (int j = 0; j < r; ++j) sacc += Am[(16 * I + r) * 68 + 16 * I + j] * x[j];
                    x[r] -= sacc;
                }
#pragma unroll
                for (int r = 1; r < 16; ++r) X[(16 * I + r) * 256 + tid] = x[r];
            }
            __syncthreads();
        }
        {
            const int c = tid & 255, hf = tid >> 8;
            if (c < 128) {
#pragma unroll 8
                for (int i2 = 0; i2 < 32; ++i2) { const int i = hf * 32 + i2; DU[(size_t)T * 8192 + i * 128 + c] = X[i * 256 + c]; }
            } else {
#pragma unroll 8
                for (int i2 = 0; i2 < 32; ++i2) { const int i = hf * 32 + i2; DNW[(size_t)T * 8192 + i * 128 + (c - 128)] = f2bf(-X[i * 256 + c]); }
            }
        }
        __syncthreads();
    }
}
__device__ __forceinline__ void d1_mix(const KP& P, const int l) {
    const int tidx_ = otid(), bidx_ = obid(); (void)tidx_; (void)bidx_;
    unsigned char* ws = ows(P.ws);
    const int tid = tidx_, w = tid >> 6, lane = tid & 63, lr = lane & 15, lq = lane >> 4;
    const bf16_t* vcn = (const bf16_t*)(ws + W_VCN); const bf16_t* gu = (const bf16_t*)(ws + W_GU); bf16_t* yc = (bf16_t*)(ws + W_YC);
    for (int it = bidx_ - 128; it < 512; it += gridDim.x - 128) {
        const int g = it & 7, cn = (it >> 3) & 15, b = it >> 7, r0 = b * 2048 + cn * 128;
        const float* wsg = P.in[I_WS] + ((size_t)l * 8 + g) * 128 * 128; const float* bsg = P.in[I_BS] + ((size_t)l * 8 + g) * 128;
        bf16x8 xv[4];
#pragma unroll
        for (int ks = 0; ks < 4; ++ks)
#pragma unroll
            for (int e = 0; e < 8; ++e) xv[ks][e] = (short)vcn[(size_t)(r0 + 32 * ks + 8 * lq + e) * 1024 + g * 128 + 16 * w + lr];
#pragma unroll
        for (int mt = 0; mt < 8; ++mt) {
            const int t = 16 * mt + lr;
            f32x4 acc = {0.f, 0.f, 0.f, 0.f};
#pragma unroll
            for (int ks = 0; ks < 4; ++ks) {
                if (32 * ks <= 16 * mt + 15) {
                    const float* wp = wsg + (size_t)t * 128 + 32 * ks + 8 * lq; const f32x4 w0 = *(const f32x4*)wp, w1 = *(const f32x4*)(wp + 4);
                    float wv[8] = {w0[0], w0[1], w0[2], w0[3], w1[0], w1[1], w1[2], w1[3]};
                    bf16x8 yw;
#pragma unroll
                    for (int e = 0; e < 8; ++e) yw[e] = (short)f2bf((32 * ks + 8 * lq + e <= t) ? wv[e] : 0.f);
                    acc = __builtin_amdgcn_mfma_f32_16x16x32_bf16(xv[ks], yw, acc, 0, 0, 0);
                }
            }
            const float bias = bsg[t]; const size_t o = (size_t)(r0 + t) * 1024 + g * 128 + 16 * w + 4 * lq;
            const u32x2 gw2 = *(const u32x2*)(gu + o);
            u32x2 r; r.x = pk2(lo16(gw2.x) * (acc[0] + bias), hi16(gw2.x) * (acc[1] + bias)); r.y = pk2(lo16(gw2.y) * (acc[2] + bias), hi16(gw2.y) * (acc[3] + bias));
            *(u32x2*)(yc + o) = r;
        }
    }
    for (int i = (bidx_ - 128) * 512 + tidx_; i < MS * 128; i += (gridDim.x - 128) * 512) {
        const int rs = i >> 7, c8 = (i & 127) * 8, t = rs & 3, g = c8 >> 7, r = MP + rs;
        const float* wsg = P.in[I_WS] + (((size_t)l * 8 + g) * 128 + t) * 128; const float bias = P.in[I_BS][((size_t)l * 8 + g) * 128 + t];
        float a[8];
#pragma unroll
        for (int e = 0; e < 8; ++e) a[e] = bias;
#pragma unroll
        for (int s = 0; s < 4; ++s) if (s <= t) { float x[8]; unpack8(*(const u32x4*)(vcn + (size_t)(r - t + s) * 1024 + c8), x); const float wv = wsg[s];
#pragma unroll
            for (int e = 0; e < 8; ++e) a[e] += wv * x[e]; }
        float gq[8]; unpack8(*(const u32x4*)(gu + (size_t)r * 1024 + c8), gq);
#pragma unroll
        for (int e = 0; e < 8; ++e) a[e] *= gq[e];
        *(u32x4*)(yc + (size_t)r * 1024 + c8) = pack8(a);
    }
}
__device__ __forceinline__ void d1_sample_delta(const KP& P, const int l, float* shm) {
    const int tidx_ = otid(), bidx_ = obid(); (void)tidx_; (void)bidx_;
    unsigned char* ws = ows(P.ws);
    const int tid = tidx_, dvq = tid & 31, dkg = tid >> 5, lane = tid & 63;
    float* part = shm;
    float* part2 = shm + 2048;
    float* qs = shm + 4096;
    float* ks = qs + 512; float* vs = ks + 512; float* ab = vs + 512; float* zs = ab + 8;
    const float* qns = (const float*)(ws + W_QKVNS); const float* betab = (const float*)(ws + W_BETA); const float* ggb = (const float*)(ws + W_GG);
    const bf16_t* zb = (const bf16_t*)(ws + W_Z); bf16_t* yb = (bf16_t*)(ws + W_YB);
    for (int it = bidx_ - 128; it < 1024; it += gridDim.x - 128) {
        const int b = it >> 3, h = it & 7;
        const size_t so = ((size_t)(l * 128 + b) * 8 + h) * 16384;
        const float* s0 = P.in[I_SD] + so; float* sout = P.out + OUT_DS + so;
        f32x4 S[8];
#pragma unroll
        for (int i = 0; i < 8; ++i) S[i] = __builtin_nontemporal_load((const f32x4*)(s0 + (size_t)(8 * dkg + i) * 128 + 4 * dvq));
        __syncthreads();
        for (int e = tid; e < 1536; e += 512) { const int t = (e >> 7) & 3, d = e & 127, wh = e >> 9; qs[e] = qns[(size_t)(b * 4 + t) * 3072 + wh * 1024 + h * 128 + d]; }
        { const int t = tid >> 7, d = tid & 127; zs[tid] = silu_(bf2f(zb[(size_t)(MP + b * 4 + t) * 1024 + h * 128 + d])) * P.in[I_NBG][(size_t)l * 128 + d]; }
        if (tid < 4) { const int row = MP + b * 4 + tid; ab[tid] = __expf(ggb[(size_t)row * 8 + h]); ab[4 + tid] = betab[(size_t)row * 8 + h]; }
        __syncthreads();
#pragma unroll 1
        for (int t = 0; t < 4; ++t) {
            const int row = MP + b * 4 + t;
            const float a = ab[t], be = ab[4 + t];
            f32x4 p = {0.f, 0.f, 0.f, 0.f};
#pragma unroll
            for (int i = 0; i < 8; ++i) p += ks[t * 128 + 8 * dkg + i] * S[i];
            *(f32x4*)(part + dkg * 128 + 4 * dvq) = p;
            __syncthreads();
            f32x4 kS = {0.f, 0.f, 0.f, 0.f};
#pragma unroll
            for (int j = 0; j < 16; ++j) kS += *(const f32x4*)(part + j * 128 + 4 * dvq);
            const f32x4 vv = *(const f32x4*)(vs + t * 128 + 4 * dvq);
            const f32x4 vn = be * (vv - a * kS);
            f32x4 po = {0.f, 0.f, 0.f, 0.f};
#pragma unroll
            for (int i = 0; i < 8; ++i) { S[i] = a * S[i] + ks[t * 128 + 8 * dkg + i] * vn; po += qs[t * 128 + 8 * dkg + i] * S[i]; }
            *(f32x4*)(part2 + dkg * 128 + 4 * dvq) = po;
            __syncthreads();
            if (tid < 64) {
                float o0 = 0.f, o1 = 0.f;
#pragma unroll
                for (int j = 0; j < 16; ++j) { o0 += part2[j * 128 + lane]; o1 += part2[j * 128 + 64 + lane]; }
                const float rstd = rsqrtf(wave_sum(o0 * o0 + o1 * o1) * (1.f / 128.f) + RMS_EPS);
                const size_t o = (size_t)row * 1024 + h * 128;
                yb[o + lane] = f2bf(o0 * rstd * zs[t * 128 + lane]);
                yb[o + 64 + lane] = f2bf(o1 * rstd * zs[t * 128 + 64 + lane]);
            }
        }
#pragma unroll
        for (int i = 0; i < 8; ++i) __builtin_nontemporal_store(S[i], (f32x4*)(sout + (size_t)(8 * dkg + i) * 128 + 4 * dvq));
    }
}

struct D2Frags { bf16x8 nwh[4], qd[4], qk[2], kd[2][2]; float u[4]; float gl; };
__device__ __forceinline__ void d2_load(D2Frags& f, const unsigned char* ws, const int T, const int rg, const int lr, const int lq, const int dvc) {
    const bf16_t* DNW = (const bf16_t*)(ws + W_DNW); const bf16_t* DQD = (const bf16_t*)(ws + W_DQD);
    const bf16_t* DKDT = (const bf16_t*)(ws + W_DKDT); const bf16_t* DQK = (const bf16_t*)(ws + W_DQK);
    const unsigned o8 = (unsigned)T * 8192u + (unsigned)(16 * rg + lr) * 128u + lq * 8;
#pragma unroll
    for (int ks = 0; ks < 4; ++ks) { f.nwh[ks] = *(const bf16x8*)(DNW + o8 + ks * 32); f.qd[ks] = *(const bf16x8*)(DQD + o8 + ks * 32); }
#pragma unroll
    for (int k2 = 0; k2 < 2; ++k2) {
        f.qk[k2] = *(const bf16x8*)(DQK + (unsigned)T * 4096u + (unsigned)(16 * rg + lr) * 64u + k2 * 32 + lq * 8);
#pragma unroll
        for (int t2 = 0; t2 < 2; ++t2) f.kd[t2][k2] = *(const bf16x8*)(DKDT + (unsigned)T * 8192u + (unsigned)(32 * rg + 16 * t2 + lr) * 64u + k2 * 32 + lq * 8);
    }
#pragma unroll
    for (int j = 0; j < 4; ++j) f.u[j] = ((const float*)(ws + W_DU))[(unsigned)T * 8192u + (unsigned)(16 * rg + 4 * lq + j) * 128u + dvc];
    f.gl = ((const float*)(ws + W_DGL))[T];
}
#define MF(a_, b_, c_) c_ = __builtin_amdgcn_mfma_f32_16x16x32_bf16(a_, b_, c_, 0, 0, 0)
__device__ __forceinline__ void d2_step(const D2Frags& cur, D2Frags& nxt, const unsigned char* ws, const int Tn, const int r0, const int h, const int rg, const int lr, const int lq, const int dvc,
                                        bf16_t* StH, bf16_t* StL, bf16_t* vnT, float* ob, f32x4 (&S)[2]) {
    d2_load(nxt, ws, Tn, rg, lr, lq, dvc);
    asm volatile("" ::: "memory");
    bf16x8 bSh[4], bSl[4];
#pragma unroll
    for (int ks = 0; ks < 4; ++ks) { bSh[ks] = *(const bf16x8*)(StH + lr * 136 + ks * 32 + lq * 8); bSl[ks] = *(const bf16x8*)(StL + lr * 136 + ks * 32 + lq * 8); }
    f32x4 av = {cur.u[0], cur.u[1], cur.u[2], cur.u[3]};
#pragma unroll
    for (int ks = 0; ks < 4; ++ks) { MF(cur.nwh[ks], bSh[ks], av); MF(cur.nwh[ks], bSl[ks], av); }
    { u32x2 q; q.x = pk2(av[0], av[1]); q.y = pk2(av[2], av[3]); *(u32x2*)(vnT + lr * 72 + 16 * rg + 4 * lq) = q; }
    f32x4 ao = {0.f, 0.f, 0.f, 0.f};
#pragma unroll
    for (int ks = 0; ks < 4; ++ks) MF(cur.qd[ks], bSh[ks], ao);
    __syncthreads();
    bf16x8 bV[2];
#pragma unroll
    for (int k2 = 0; k2 < 2; ++k2) bV[k2] = *(const bf16x8*)(vnT + lr * 72 + k2 * 32 + lq * 8);
#pragma unroll
    for (int k2 = 0; k2 < 2; ++k2) MF(cur.qk[k2], bV[k2], ao);
#pragma unroll
    for (int t2 = 0; t2 < 2; ++t2) {
        S[t2] *= cur.gl;
#pragma unroll
        for (int k2 = 0; k2 < 2; ++k2) MF(cur.kd[t2][k2], bV[k2], S[t2]);
        float hf[4], lf[4];
#pragma unroll
        for (int j = 0; j < 4; ++j) { hf[j] = bf2f(f2bf(S[t2][j])); lf[j] = S[t2][j] - hf[j]; }
        u32x2 q; q.x = pk2(hf[0], hf[1]); q.y = pk2(hf[2], hf[3]); *(u32x2*)(StH + lr * 136 + 32 * rg + 16 * t2 + 4 * lq) = q;
        q.x = pk2(lf[0], lf[1]); q.y = pk2(lf[2], lf[3]); *(u32x2*)(StL + lr * 136 + 32 * rg + 16 * t2 + 4 * lq) = q;
    }
#pragma unroll
    for (int j = 0; j < 4; ++j) ob[(unsigned)(r0 + 16 * rg + 4 * lq + j) * 1024u + h * 128 + dvc] = ao[j];
    __syncthreads();
}
__device__ __forceinline__ void d2_scan(const KP& P, const int l, unsigned char* shmb) {
    const int tidx_ = otid(), bidx_ = obid(); (void)tidx_; (void)bidx_;
    unsigned char* ws = ows(P.ws);
    const int tid = tidx_, w = tid >> 6, lane = tid & 63, lr = lane & 15, lq = lane >> 4, sl = w >> 2, rg = w & 3;
    bf16_t* StH = (bf16_t*)(shmb + sl * 11008); bf16_t* StL = StH + 16 * 136; bf16_t* vnT = StL + 16 * 136;
    float* ob = (float*)(ws + W_OB);
    for (int item = bidx_; item < 128; item += gridDim.x) {
        const int chain = item >> 2, dq = item & 3, b = chain >> 3, h = chain & 7, dv0 = 32 * dq + 16 * sl, dvc = dv0 + lr;
        f32x4 S[2];
        S[0] = (f32x4){0.f, 0.f, 0.f, 0.f}; S[1] = (f32x4){0.f, 0.f, 0.f, 0.f};
        __syncthreads();
        for (int e = tid; e < 2 * 11008 / 4; e += 512) ((unsigned*)shmb)[e] = 0u;
        __syncthreads();
        D2Frags fa, fb; d2_load(fa, ws, chain * 32, rg, lr, lq, dvc);
#pragma unroll 1
        for (int n = 0; n < 32; n += 2) {
            const int T = chain * 32 + n, r0 = b * 2048 + n * 64;
            d2_step(fa, fb, ws, T + 1, r0, h, rg, lr, lq, dvc, StH, StL, vnT, ob, S);
            d2_step(fb, fa, ws, (n < 30) ? T + 2 : T + 1, r0 + 64, h, rg, lr, lq, dvc, StH, StL, vnT, ob, S);
        }
        float* sout = P.out + OUT_DP + ((size_t)(l * 4 + b) * 8 + h) * 16384;
#pragma unroll
        for (int t2 = 0; t2 < 2; ++t2)
#pragma unroll
            for (int j = 0; j < 4; ++j) sout[(unsigned)(32 * rg + 16 * t2 + 4 * lq + j) * 128u + dvc] = S[t2][j];
    }
}
#undef MF
__device__ __forceinline__ void onorm(const KP& P, const int l) {
    const int tidx_ = otid(), bidx_ = obid(); (void)tidx_; (void)bidx_;
    unsigned char* ws = ows(P.ws);
    const int lane = tidx_ & 63, gw = bidx_ * 8 + (tidx_ >> 6), ngw = gridDim.x * 8;
    const float* ob = (const float*)(ws + W_OB); const bf16_t* zb = (const bf16_t*)(ws + W_Z); bf16_t* yb = (bf16_t*)(ws + W_YB);
    const float* ng = P.in[I_NBG] + (size_t)l * 128 + (lane & 7) * 16;
    for (int r = gw; r < MP; r += ngw) {
        const unsigned o = (unsigned)r * 1024u + lane * 16;
        float x[16]; float ss = 0.f;
#pragma unroll
        for (int q = 0; q < 4; ++q) { const f32x4 v = *(const f32x4*)(ob + o + 4 * q); x[4 * q] = v[0]; x[4 * q + 1] = v[1]; x[4 * q + 2] = v[2]; x[4 * q + 3] = v[3]; ss += (v[0] * v[0] + v[1] * v[1]) + (v[2] * v[2] + v[3] * v[3]); }
        ss += __shfl_xor(ss, 1); ss += __shfl_xor(ss, 2); ss += __shfl_xor(ss, 4);
        const float rstd = rsqrtf(ss * (1.f / 128.f) + RMS_EPS);
        float z0[8], z1[8]; unpack8(*(const u32x4*)(zb + o), z0); unpack8(*(const u32x4*)(zb + o + 8), z1);
        float y0[8], y1[8];
#pragma unroll
        for (int e = 0; e < 8; ++e) { y0[e] = x[e] * rstd * ng[e] * silu_(z0[e]); y1[e] = x[8 + e] * rstd * ng[8 + e] * silu_(z1[e]); }
        *(u32x4*)(yb + o) = pack8(y0); *(u32x4*)(yb + o + 8) = pack8(y1);
    }
}

__device__ __forceinline__ void phase_f(const KP& P, const int l) {
    const int tidx_ = otid(), bidx_ = obid(); (void)tidx_; (void)bidx_;
    unsigned char* ws = ows(P.ws);
    const bf16_t* hg = (const bf16_t*)(ws + W_HG); const bf16_t* hu = (const bf16_t*)(ws + W_HU); bf16_t* hh = (bf16_t*)(ws + W_H);
    const float* cw = P.in[I_CFW] + (size_t)l * 3 * DFF; const float* hist = P.in[I_SCF] + (size_t)l * 128 * 2 * DFF;
    constexpr int C8 = DFF / 8;
    for (int i = bidx_ * 512 + tidx_; i < (MT / 4) * C8; i += gridDim.x * 512) {
        const int q = i / C8, c8 = (i % C8) * 8, r0 = 4 * q;
        const bool smp = r0 >= MP; const int t0 = smp ? 0 : (r0 & 2047), sb = (r0 - MP) >> 2;
        float x[6][8];
#pragma unroll
        for (int d = 0; d < 2; ++d) {
            if (t0 > 0) unpack8(*(const u32x4*)(hg + (size_t)(r0 - 2 + d) * DFF + c8), x[d]);
            else if (smp) { const float* hp = hist + ((size_t)sb * 2 + d) * DFF + c8; const f32x4 h0 = *(const f32x4*)hp, h1 = *(const f32x4*)(hp + 4);
#pragma unroll
                for (int j = 0; j < 4; ++j) { x[d][j] = h0[j]; x[d][4 + j] = h1[j]; } }
            else {
#pragma unroll
                for (int j = 0; j < 8; ++j) x[d][j] = 0.f; }
        }
#pragma unroll
        for (int d = 0; d < 4; ++d) unpack8(*(const u32x4*)(hg + (size_t)(r0 + d) * DFF + c8), x[2 + d]);
        float w[3][8];
#pragma unroll
        for (int d = 0; d < 3; ++d) { const f32x4 w0 = *(const f32x4*)(cw + d * DFF + c8), w1 = *(const f32x4*)(cw + d * DFF + c8 + 4);
#pragma unroll
            for (int j = 0; j < 4; ++j) { w[d][j] = w0[j]; w[d][4 + j] = w1[j]; } }
#pragma unroll
        for (int d = 0; d < 4; ++d) {
            float u[8], a[8]; unpack8(*(const u32x4*)(hu + (size_t)(r0 + d) * DFF + c8), u);
#pragma unroll
            for (int j = 0; j < 8; ++j) a[j] = silu_(w[0][j] * x[d][j] + w[1][j] * x[d + 1][j] + w[2][j] * x[d + 2][j]) * u[j];
            *(u32x4*)(hh + (size_t)(r0 + d) * DFF + c8) = pack8(a);
        }
    }
}

#define XB_TMO      128
#define XB_XCNT(j)  (256  + 64 * (j))
#define XB_XSUB(j)  (1280 + 64 * (j))
#define XB_XGEN(j)  (2304 + 64 * (j))
#define XB_TOP      3328
#define XB_TOPGEN   3392
#define XCD_BAR_WORDS 3456
#define XB_SPIN_CAP (1u << 18)

__device__ __forceinline__ unsigned xb_ld(unsigned* p)              { return __hip_atomic_load(p, __ATOMIC_RELAXED, __HIP_MEMORY_SCOPE_AGENT); }
__device__ __forceinline__ unsigned xb_add(unsigned* p, unsigned v) { return __hip_atomic_fetch_add(p, v, __ATOMIC_RELAXED, __HIP_MEMORY_SCOPE_AGENT); }
__device__ __forceinline__ unsigned xb_xcc_id() { return (unsigned)__builtin_amdgcn_s_getreg((3 << 11) | 20) & 0xFu; }
#define XB_SPIN(cond, bar) do { unsigned _sp = 0; while (cond) { __builtin_amdgcn_s_sleep(1); \
    if ((++_sp & 255u) == 0u) { if (xb_ld(&(bar)[XB_TMO])) break; if (_sp > XB_SPIN_CAP) { atomicAdd(&(bar)[XB_TMO], 1u); break; } } } } while (0)

struct XcdBarrier {
    unsigned* bar; unsigned x;
    volatile LAS unsigned* st;
};

__device__ __forceinline__ XcdBarrier xcd_barrier_post(unsigned* bar, volatile LAS unsigned* st) {
    XcdBarrier b; b.bar = bar; b.x = xb_xcc_id(); b.st = st;
    if (threadIdx.x == 0) (void)xb_add(&bar[XB_XCNT(b.x)], 1u);
    return b;
}
__device__ __forceinline__ void xcd_barrier_complete(unsigned* bar, unsigned x, unsigned& nloc, unsigned& nx) {
    const unsigned G = gridDim.x * gridDim.y * gridDim.z;
    unsigned sum, cnt, mine, sp = 0u;
    for (;;) {
        sum = 0u; cnt = 0u; mine = 0u;
#pragma unroll
        for (unsigned j = 0; j < 16; ++j) { const unsigned c = xb_ld(&bar[XB_XCNT(j)]); sum += c; cnt += (c > 0u) ? 1u : 0u; mine = (j == x) ? c : mine; }
        if (sum == G) break;
        __builtin_amdgcn_s_sleep(1);
        if ((++sp & 255u) == 0u) { if (xb_ld(&bar[XB_TMO])) break; if (sp > XB_SPIN_CAP) { atomicAdd(&bar[XB_TMO], 1u); break; } }
    }
    nloc = mine > 0u ? mine : 1u; nx = cnt > 0u ? cnt : 1u;
}

__device__ __forceinline__ void xcd_barrier(const XcdBarrier& b) {
    asm volatile("s_waitcnt vmcnt(0)" ::: "memory");
    __syncthreads();
    if (threadIdx.x == 0) {
        unsigned* bar = b.bar;
        __builtin_amdgcn_s_waitcnt(0);
        unsigned nloc = b.st[0], nx = b.st[1];
        if (nloc == 0u) { xcd_barrier_complete(bar, b.x, nloc, nx); b.st[0] = nloc; b.st[1] = nx; }
        const unsigned old = xb_add(&bar[XB_XSUB(b.x)], 1u);
        const unsigned gen = old / nloc;
        if (old + 1u == (gen + 1u) * nloc) {
            __builtin_amdgcn_fence(__ATOMIC_RELEASE, "agent");
            asm volatile("s_waitcnt vmcnt(0)" ::: "memory");
            const unsigned og = xb_add(&bar[XB_TOP], 1u);
            const unsigned tg = og / nx;
            if (og + 1u == (tg + 1u) * nx) xb_add(&bar[XB_TOPGEN], 1u);
            else XB_SPIN(xb_ld(&bar[XB_TOPGEN]) == tg, bar);
            __builtin_amdgcn_fence(__ATOMIC_ACQUIRE, "agent");
            xb_add(&bar[XB_XGEN(b.x)], 1u);
            asm volatile("s_waitcnt vmcnt(0)" ::: "memory");
        } else {
            XB_SPIN(xb_ld(&bar[XB_XGEN(b.x)]) == gen, bar);
            __builtin_amdgcn_fence(__ATOMIC_ACQUIRE, "agent");
            asm volatile("s_waitcnt vmcnt(0)" ::: "memory");
        }
    }
    __syncthreads();
}

enum { K_G1 = 0, K_E, K_D1, K_D2, K_G2A, K_G2B, K_G3, K_LN1, K_G4, K_F, K_G5, K_LN2, K_PER_LAYER };
constexpr int N_PHASES = 1 + 2 * K_PER_LAYER;

__global__ void __launch_bounds__(512, 2) mega(const KP P, const int ph_lo, const int ph_hi) {
    extern __shared__ __attribute__((aligned(16))) unsigned char shm[];
    cg::grid_group grid = cg::this_grid();
    unsigned char* const ws = P.ws;
    volatile LAS unsigned* xst = (volatile LAS unsigned*)((LAS unsigned char*)shm + STAGE_BYTES);
    if (threadIdx.x == 0) { xst[0] = 0u; xst[1] = 0u; xst[2] = 0u; xst[3] = 0u; }
    __syncthreads();
    (void)xcd_barrier_post((unsigned*)(ws + W_BAR), xst);
    int again = 0;
#pragma unroll 1
    for (int ph = ph_lo; ph < ph_hi;) {
        if (ph == 0) {
#if !defined(PHSEL) || PHSEL == 0
            ln_rows(P, 0, P.in[I_LNG], P.in[I_LNB], false);
#endif
#if !defined(PHSEL) || PHSEL == 1
#endif
        } else {
            const int l = (ph - 1) / K_PER_LAYER, k = (ph - 1) % K_PER_LAYER;
            Gemm g; g.A = nullptr; g.Bt = nullptr; g.M = MT; g.N = 0; g.K = 0; int mode = -1;
            switch (k) {
                case K_G1: g.A = (const bf16_t*)(ws + W_XB); g.Bt = (const bf16_t*)(ws + W_WIN); g.N = NV1 - 256; g.K = 2048; mode = M_G1; break;
                case K_G2A: g.A = (const bf16_t*)(ws + W_YA); g.Bt = (const bf16_t*)(ws + W_WA); g.N = 2048; g.K = 1024; mode = M_G2A; break;
                case K_G2B: g.A = (const bf16_t*)(ws + W_YB); g.Bt = (const bf16_t*)(ws + W_WB); g.N = 2048; g.K = 1024; mode = M_G2B; break;
                case K_G3: g.A = (const bf16_t*)(ws + W_MGB); g.Bt = (const bf16_t*)(ws + W_WO); g.N = 2048; g.K = 2048; mode = M_G3; break;
                case K_G4: g.A = (const bf16_t*)(ws + W_XB); g.Bt = (const bf16_t*)(ws + W_WUP); g.N = NV4; g.K = 2048; mode = M_G4; break;
                case K_G5: g.A = (const bf16_t*)(ws + W_H); g.Bt = (const bf16_t*)(ws + W_WDN); g.N = 2048; g.K = DFF; mode = M_G5; break;
                default: break;
            }
            if (mode >= 0) {
#if !defined(PHSEL) || PHSEL == 2
                const int npass = (k == K_G2A) ? 3 : 1;
#pragma unroll 1
                for (int pass = 0; pass < npass; ++pass) {
                    int cblk = (int)blockIdx.x, G = (int)gridDim.x; bool skip = false;
                    if (pass == 1) {
                        g.A = (const bf16_t*)(ws + W_YC); g.Bt = (const bf16_t*)(ws + W_WC); mode = M_G2C; cblk = (cblk + G / 2) % G;
                    } else if (pass == 2) {
                        g.A = (const bf16_t*)(ws + W_PB); g.Bt = (const bf16_t*)(ws + W_WPE); g.K = 256; mode = M_PE;
                        skip = (cblk < 16) || (cblk >= 128 && cblk < 144); cblk -= (cblk < 128) ? 16 : 32; G -= 32;
                    }
                    if (!skip) {
                        const int split = ((mode == M_G3 || mode == M_G5) && gridDim.x == 256) ? 1 : 0;
                        StaticOrder S; S.init(split ? MP : g.M, g.N, g.K, G, cblk, split);
                        gemm_phase((LAS unsigned char*)shm, g, S, P, mode, l);
                    }
                }
#endif
                if (k == K_G2A) onorm(P, l);
            } else if (k == K_E) {
#if !defined(PHSEL) || PHSEL == 3
                beta_gate(P, l);
                phase_e(P, l);
#endif
            } else if (k == K_D1) {
#if !defined(PHSEL) || PHSEL == 4
                d1_prep(P, l, (float*)shm);
#endif

            } else if (k == K_D2) {
#if !defined(PHSEL) || PHSEL == 7
                if (blockIdx.x < 128) d2_scan(P, l, shm);
                else { d1_sample_delta(P, l, (float*)shm); d1_mix(P, l); }
#endif
            } else if (k == K_LN1) {
                ln_rows(P, 1, P.in[I_L1G] + (size_t)l * DM, P.in[I_L1B] + (size_t)l * DM, false);
            } else if (k == K_F) {
#if !defined(PHSEL) || PHSEL == 8
                phase_f(P, l);
#endif
            } else if (k == K_LN2) {
                ln_rows(P, 1, P.in[I_L2G] + (size_t)l * DM, P.in[I_L2B] + (size_t)l * DM, l == 1);
            }
        }
        {
            int cl = -1, cpart = 0, cb0 = 0, cnb = (int)gridDim.x;
            if (ph == 0) cl = 0;
            else { const int l2 = (ph - 1) / K_PER_LAYER, k2 = (ph - 1) % K_PER_LAYER;
                if (k2 == K_LN2 && l2 == 0) cl = 1;
                else if (k2 == K_G2B && blockIdx.x >= 16) { cl = l2; cpart = 1; cb0 = 16; cnb -= 16; } }
            if (cl >= 0) convert_weights(P, cl, (float*)shm, cpart, cb0, cnb);
        }
#ifdef REPMASK
        {
            const int k = ph == 0 ? -1 : (ph - 1) % K_PER_LAYER; int bit = -1;
            if (ph == 0 || k == K_LN2) bit = 0; else if (k == K_E || k == K_F) bit = 1; else if (k == K_D1) bit = 2; else if (k == K_D2) bit = 3;
            else if (k == K_G1 || k == K_G5) bit = 4; else if (k == K_G3) bit = 5; else if (k == K_LN1) bit = 6;
            if (!again && bit >= 0 && ((REPMASK >> bit) & 1)) again = 1; else { again = 0; ++ph; }
        }
#else
        ++ph; (void)again;
#endif
        if (ph < ph_hi) { if (ph_hi < 0) grid.sync();   { XcdBarrier xb; xb.bar = (unsigned*)(ows(P.ws) + W_BAR); xb.x = xb_xcc_id(); xb.st = (volatile LAS unsigned*)((LAS unsigned char*)shm + STAGE_BYTES); xcd_barrier(xb); } }
    }
}

extern "C" void kernel_launch(void* const* d_in, const int* in_sizes, int n_in, void* d_out, int out_size, void* d_ws, size_t ws_size, hipStream_t stream) {
    static int grid_blocks = 0;
    constexpr int LDS_BYTES = STAGE_BYTES + 256;
    if (grid_blocks == 0) {
        if (n_in != 33 || (size_t)out_size != OUT_END || ws_size < WS_TOTAL) {
            fprintf(stderr, "kernel_launch: unexpected problem (n_in %d, out %d vs %zu, ws %zu vs %zu)\n", n_in, out_size, (size_t)OUT_END, ws_size, (size_t)WS_TOTAL);
            grid_blocks = -1; return;
        }
        int dev = 0, cus = 0, per_cu = 0;
        hipGetDevice(&dev);
        hipDeviceGetAttribute(&cus, hipDeviceAttributeMultiprocessorCount, dev);
        hipFuncSetAttribute((const void*)mega, hipFuncAttributeMaxDynamicSharedMemorySize, LDS_BYTES);
        hipOccupancyMaxActiveBlocksPerMultiprocessor(&per_cu, (const void*)mega, 512, LDS_BYTES);
        if (per_cu < 1) per_cu = 1;
        grid_blocks = cus * 1;
        (void)hipGetLastError();
    }
    if (grid_blocks < 0) return;
    if (hipMemsetAsync((unsigned char*)d_ws + W_BAR, 0, XCD_BAR_WORDS * sizeof(unsigned), stream) != hipSuccess) { fprintf(stderr, "kernel_launch: memset of the barrier words failed\n"); return; }
    KP p{};
    for (int i = 0; i < 33; ++i) p.in[i] = (const float*)d_in[i];
    p.out = (float*)d_out; p.ws = (unsigned char*)d_ws;
    int lo = 0, hi = N_PHASES;
    void* args[] = {&p, &lo, &hi};
    hipError_t e = hipLaunchCooperativeKernel((const void*)mega, dim3(grid_blocks), dim3(512), args, LDS_BYTES, stream);
    if (e != hipSuccess) fprintf(stderr, "cooperative launch failed: %s (grid %d)\n", hipGetErrorString(e), grid_blocks);
}
```

```cpp
#include <hip/hip_runtime.h>
#include <hip/hip_cooperative_groups.h>
#include <cstdio>
#include <cstdint>
namespace cg = cooperative_groups;

#define LAS __attribute__((address_space(3)))
typedef unsigned short bf16_t;
typedef short bf16x8 __attribute__((ext_vector_type(8)));
typedef float f32x4 __attribute__((ext_vector_type(4)));
typedef unsigned u32x4 __attribute__((ext_vector_type(4)));
typedef unsigned u32x2 __attribute__((ext_vector_type(2)));

constexpr int DM = 2048, NBP = 4, SEQ = 2048, NBS = 128, DSQ = 4;
constexpr int MP = NBP * SEQ, MS = NBS * DSQ, MT = MP + MS;
constexpr int DPLE = 256, DA = 1024, HB = 8, DB = 1024, DC = 1024, DFF = 5504, NIN = 15376;
constexpr int NV1 = 61 * 256, NV4 = 2 * DFF + DM;
constexpr float ALPHA = 1.41421356237f, LN_EPS = 1e-5f, RMS_EPS = 1e-6f;

constexpr size_t OUT_YP = 0, OUT_YS = OUT_YP + (size_t)MP * DM, OUT_CAP = OUT_YS + (size_t)MS * DM, OUT_CQP = OUT_CAP + 2 * 4 * 2 * 1024,
                 OUT_DP = OUT_CQP + 2 * 4 * 3 * 3072, OUT_CFP = OUT_DP + 2 * 4 * 8 * 16384, OUT_CAS = OUT_CFP + 2 * 4 * 2 * 5504,
                 OUT_CQS = OUT_CAS + 2 * 128 * 2 * 1024, OUT_DS = OUT_CQS + 2 * 128 * 3 * 3072, OUT_CFS = OUT_DS + (size_t)2 * 128 * 8 * 16384,
                 OUT_VS = OUT_CFS + 2 * 128 * 2 * 5504, OUT_END = OUT_VS + 2 * 128 * 4 * 1024;

constexpr size_t al256(size_t x) { return (x + 255) & ~(size_t)255; }
constexpr size_t W_WIN = 0, W_WA = W_WIN + (size_t)NV1 * 2048 * 2, W_WB = W_WA + (size_t)2048 * 1024 * 2, W_WC = W_WB + (size_t)2048 * 1024 * 2,
                 W_WO = W_WC + (size_t)2048 * 1024 * 2, W_WUP = W_WO + (size_t)2048 * 2048 * 2, W_WDN = W_WUP + (size_t)NV4 * 2048 * 2,
                 W_WPE = W_WDN + (size_t)2048 * DFF * 2, W_XRES = W_WPE + (size_t)2048 * 256 * 2, W_XB = W_XRES + (size_t)MT * DM * 4,
                 W_PRE = W_XB + (size_t)MT * DM * 2, W_PB = W_PRE + (size_t)MT * DM * 4, W_R = W_PB + (size_t)MT * DPLE * 2;
constexpr size_t W_CH = W_R, W_BG = W_CH + (size_t)MT * 1024 * 2, W_QKV = W_BG + (size_t)MT * 1024 * 2, W_Z = W_QKV + (size_t)MT * 3072 * 2,
                 W_GU = W_Z + (size_t)MT * 1024 * 2, W_GV = W_GU + (size_t)MT * 1024 * 2, W_GTS = W_GV + (size_t)MT * 1024 * 2,
                 W_BETA = W_GTS + (size_t)MT * 6144 * 2, W_GG = W_BETA + al256((size_t)MT * 8 * 4), W_YA = W_GG + al256((size_t)MT * 8 * 4),
                 W_YB = W_YA + (size_t)MT * 1024 * 2, W_YC = W_YB + (size_t)MT * 1024 * 2, W_QKVN = W_YC + (size_t)MT * 1024 * 2,
                 W_QKVNS = W_QKVN + (size_t)MT * 3072 * 2, W_VCN = W_QKVNS + (size_t)MS * 3072 * 4, W_DU = W_VCN + (size_t)MT * 1024 * 2,
                 W_DNW = W_DU + (size_t)1024 * 8192 * 4, W_DQD = W_DNW + (size_t)1024 * 8192 * 2, W_DKDT = W_DQD + (size_t)1024 * 8192 * 2,
                 W_DQK = W_DKDT + (size_t)1024 * 8192 * 2, W_DNW2 = W_DQK + (size_t)1024 * 4096 * 2, W_OB = W_DNW2 + (size_t)1024 * 8192 * 2,
                 W_DGL = W_OB + (size_t)MP * 1024 * 4, W_MG32 = W_DGL + 4096,
                 W_MGB = W_MG32 + (size_t)MT * DM * 4, W_REND = W_MGB + (size_t)MT * DM * 2;
constexpr size_t W_PE = W_R, W_HG = W_PE + (size_t)MT * DM * 4, W_HU = W_HG + (size_t)MT * DFF * 2, W_H = W_HU + (size_t)MT * DFF * 2,
                 W_FEND = W_H + (size_t)MT * DFF * 2;
constexpr size_t W_MG32C = W_VCN;
static_assert(W_MG32C + (size_t)MT * DM * 4 <= W_DKDT, "MG32C overlay");
constexpr size_t W_PART = W_VCN;
static_assert(W_PART >= W_FEND && W_PART + (size_t)16 * MS * DM * 4 <= W_OB, "partial buffer overlay");
constexpr size_t WS_NEED = W_REND > W_FEND ? W_REND : W_FEND;
constexpr size_t W_BAR = WS_NEED;
constexpr size_t WS_TOTAL = W_BAR + 16384;
static_assert(WS_TOTAL <= (size_t)1007681536, "workspace too large");

struct KP { const float* in[33]; float* out; unsigned char* ws; };
enum { I_XP = 0, I_XS, I_SCA, I_SCQ, I_SD, I_SCF, I_PP, I_PS, I_LNG, I_LNB, I_WIN, I_CAW, I_WAO, I_CBW, I_ALOG, I_DTB, I_NBG, I_WBO, I_LCG, I_LCB, I_WS, I_BS,
       I_WCO, I_WO, I_L1G, I_L1B, I_WUP, I_CFW, I_WDN, I_WPE, I_WPG, I_L2G, I_L2B };

__device__ __forceinline__ float bf2f(bf16_t h) { return __uint_as_float(((unsigned)h) << 16); }
__device__ __forceinline__ bf16_t f2bf(float f) { unsigned u = __float_as_uint(f); u += 0x7FFFu + ((u >> 16) & 1u); return (bf16_t)(u >> 16); }
typedef __bf16 bf16x2_t __attribute__((ext_vector_type(2)));
typedef float f32x2_t __attribute__((ext_vector_type(2)));
__device__ __forceinline__ unsigned pk2(float lo, float hi) { const bf16x2_t r = __builtin_convertvector((f32x2_t){lo, hi}, bf16x2_t); return __builtin_bit_cast(unsigned, r); }
__device__ __forceinline__ void split_bf(float x, bf16_t& hi, bf16_t& lo) { hi = f2bf(x); lo = f2bf(x - bf2f(hi)); }
__device__ __forceinline__ float lo16(unsigned w) { return __uint_as_float(w << 16); }
__device__ __forceinline__ float hi16(unsigned w) { return __uint_as_float(w & 0xffff0000u); }
__device__ __forceinline__ void unpack8(u32x4 w, float (&f)[8]) { f[0] = lo16(w.x); f[1] = hi16(w.x); f[2] = lo16(w.y); f[3] = hi16(w.y); f[4] = lo16(w.z); f[5] = hi16(w.z); f[6] = lo16(w.w); f[7] = hi16(w.w); }
__device__ __forceinline__ u32x4 pack8(const float (&f)[8]) { u32x4 w; w.x = pk2(f[0], f[1]); w.y = pk2(f[2], f[3]); w.z = pk2(f[4], f[5]); w.w = pk2(f[6], f[7]); return w; }
__device__ __forceinline__ float sigmoid_(float x) { return __builtin_amdgcn_rcpf(1.f + __expf(-x)); }
__device__ __forceinline__ float silu_(float x) { return x * __builtin_amdgcn_rcpf(1.f + __expf(-x)); }
__device__ __forceinline__ float gelu_(float x) { const float y = 1.5957691216f * (x + 0.044715f * x * x * x); return x * __builtin_amdgcn_rcpf(1.f + __expf(-y)); }
__device__ __forceinline__ float softplus_(float x) { return x > 20.f ? x : log1pf(__expf(x)); }
__device__ __forceinline__ float wave_sum(float v) {
#pragma unroll
    for (int o = 1; o < 64; o <<= 1) v += __shfl_xor(v, o);
    return v;
}

__device__ __forceinline__ int otid() { int t = (int)threadIdx.x; asm volatile("" : "+v"(t)); return t; }
__device__ __forceinline__ int obid() { int t = (int)blockIdx.x; asm volatile("" : "+s"(t)); return t; }
__device__ __forceinline__ unsigned char* ows(const unsigned char* p) { unsigned long long v = (unsigned long long)p; asm volatile("" : "+s"(v)); return (unsigned char*)(__attribute__((address_space(1))) unsigned char*)v; }
constexpr int BM = 256, BK = 64, HALF = 128, HTB = HALF * BK * 2, STAGE_BYTES = 8 * HTB, NXCD = 8, WGM = 8;
__device__ __forceinline__ int lds_byte(int r, int c) { const int st = (r >> 4) * 2 + (c >> 5), rr = r & 15, cc = c & 31, ob = rr * 64 + cc * 2; return st * 1024 + (ob ^ (((ob >> 9) & 1) << 5)); }
__device__ __forceinline__ void stage_rc(int b, int& R, int& C) { const int st = b / 1024, sb = b % 1024, swz = sb ^ (((sb >> 9) & 1) << 5); R = (st >> 1) * 16 + swz / 64; C = (st & 1) * 32 + (swz % 64) / 2; }
__device__ __forceinline__ int perm32(int rho) { const int n = rho >> 4, i = rho & 15; return 8 * (i >> 2) + 4 * n + (i & 3); }
struct Unit { int pm, pn, k0, nt, part; };
struct Gemm { const bf16_t* A; const bf16_t* Bt; int M, N, K; };
struct StaticOrder {
    int nM, nN, nwg, G, c, ntf, split;
    __device__ __forceinline__ void init(int M, int N, int K, int G_, int c_, int split_) { nM = M / BM; nN = N / BM; nwg = nM * nN; G = G_; c = c_; ntf = K / BK; split = split_; }
    __device__ __forceinline__ bool next(int i, Unit& u) const {
        u.k0 = 0; u.nt = ntf; u.part = -1;
        if (split) {
            if (i >= 2) return false;
            if (i == 0) { const int su = c >> 4, ks = c & 15, np = ntf >> 1, p0 = (np * ks) >> 4, p1 = (np * (ks + 1)) >> 4;
                u.pm = 32 + (su >> 3); u.pn = su & 7; u.k0 = 2 * p0; u.nt = 2 * (p1 - p0); u.part = ks; return true; }
        }
        const long L = split ? (long)c : (long)i * G + c; if (L >= nwg) return false;
        int wgid = (int)L; { const int q = nwg / NXCD, r = nwg % NXCD, xcd = wgid % NXCD, off = wgid / NXCD; wgid = (xcd < r ? xcd * (q + 1) : r * (q + 1) + (xcd - r) * q) + off; }
        const int nig = WGM * nN, gid = wgid / nig, fm = gid * WGM, gsz = (nM - fm) < WGM ? (nM - fm) : WGM;
        u.pm = fm + ((wgid % nig) % gsz); u.pn = (wgid % nig) / gsz; return true;
    }
};

enum { M_G1 = 0, M_G2A, M_G2B, M_G2C, M_G3, M_PE, M_G4, M_G5 };

__device__ __forceinline__ void st8bf(bf16_t* p, f32x4 a, f32x4 b) { u32x4 w; w.x = pk2(a[0], a[1]); w.y = pk2(a[2], a[3]); w.z = pk2(b[0], b[1]); w.w = pk2(b[2], b[3]); *(u32x4*)p = w; }
__device__ __forceinline__ void st8f(float* p, f32x4 a, f32x4 b) { *(f32x4*)p = a; *(f32x4*)(p + 4) = b; }
__device__ __forceinline__ bool tail_row(int r, int nk, int& seq, int& i, bool& smp) {
    if (r < MP) { seq = r >> 11; smp = false; i = (r & 2047) - (2048 - nk); return i >= 0; }
    const int rs = r - MP; seq = rs >> 2; smp = true; i = (rs & 3) - (4 - nk); return i >= 0;
}

__device__ __forceinline__ void epilogue(const KP& P, const int mode, const int l, const f32x4 (&acc)[2][2][4][2], const int pm, const int pn, const int part, const int wr, const int wc, const int fr_, const int fq_) {
    unsigned char* const ws = ows(P.ws); float* const out = (float*)ows((const unsigned char*)P.out);
    int fr = fr_, fq = fq_; asm volatile("" : "+v"(fr), "+v"(fq));
    const int rbase = pm * 256 + wr * 64 + fr, cl = wc * 32 + 8 * fq;
    if (mode == M_G1) {
        if (pn < 8) {
            bf16_t* ch = (bf16_t*)(ws + W_CH);
#pragma unroll
            for (int ai = 0; ai < 2; ++ai)
#pragma unroll
                for (int m = 0; m < 4; ++m) {
                    __builtin_amdgcn_sched_barrier(0); const int row = rbase + ai * 128 + m * 16, col = pn * 128 + cl;
                    const f32x4 a = acc[ai][0][m][0] * acc[ai][1][m][0], b = acc[ai][0][m][1] * acc[ai][1][m][1];
                    st8bf(ch + (unsigned)(row * 1024 + col), a, b);
                    int seq, i; bool smp;
                    if (tail_row(row, 2, seq, i, smp)) {
                        float* d = out + (smp ? OUT_CAS + ((size_t)(l * 128 + seq) * 2 + i) * 1024 : OUT_CAP + ((size_t)(l * 4 + seq) * 2 + i) * 1024) + col;
                        st8f(d, a, b);
                    }
                }
        } else if (pn == 60) {
            if (wc == 0 && fq < 2) {
                float* dst = (float*)(ws + (fq == 0 ? W_BETA : W_GG));
#pragma unroll
                for (int ai = 0; ai < 2; ++ai)
#pragma unroll
                    for (int m = 0; m < 4; ++m) {
                        __builtin_amdgcn_sched_barrier(0); const int row = rbase + ai * 128 + m * 16;
                        float v[8];
#pragma unroll
                        for (int j = 0; j < 4; ++j) { v[j] = acc[ai][0][m][0][j]; v[4 + j] = acc[ai][0][m][1][j]; }
#pragma unroll
                        for (int h = 0; h < 8; ++h) {
                            if (fq == 0) v[h] = sigmoid_(v[h]);
                            else v[h] = -__expf(P.in[I_ALOG][l * 8 + h]) * softplus_(v[h] + P.in[I_DTB][l * 8 + h]);
                        }
                        st8f(dst + (unsigned)(row * 8), (f32x4){v[0], v[1], v[2], v[3]}, (f32x4){v[4], v[5], v[6], v[7]});
                    }
            }
        } else {
            bf16_t* dstb; int ld, c0, act = 0; bool isq = false;
            if (pn < 12) { dstb = (bf16_t*)(ws + W_BG); ld = 1024; c0 = (pn - 8) * 256; }
            else if (pn < 24) { dstb = (bf16_t*)(ws + W_QKV); ld = 3072; c0 = (pn - 12) * 256; isq = true; }
            else if (pn < 28) { dstb = (bf16_t*)(ws + W_Z); ld = 1024; c0 = (pn - 24) * 256; }
            else if (pn < 32) { dstb = (bf16_t*)(ws + W_GU); ld = 1024; c0 = (pn - 28) * 256; act = 1; }
            else if (pn < 36) { dstb = (bf16_t*)(ws + W_GV); ld = 1024; c0 = (pn - 32) * 256; act = 1; }
            else { dstb = (bf16_t*)(ws + W_GTS); ld = 6144; c0 = (pn - 36) * 256; act = 2; }
#pragma unroll
            for (int ai = 0; ai < 2; ++ai)
#pragma unroll
                for (int m = 0; m < 4; ++m) {
                    __builtin_amdgcn_sched_barrier(0); const int row = rbase + ai * 128 + m * 16;
#pragma unroll
                    for (int bj = 0; bj < 2; ++bj) {
                        const int col = c0 + bj * 128 + cl;
                        f32x4 a = acc[ai][bj][m][0], b = acc[ai][bj][m][1];
                        if (act == 1) {
#pragma unroll
                            for (int j = 0; j < 4; ++j) { a[j] = gelu_(a[j]); b[j] = gelu_(b[j]); }
                        } else if (act == 2) {
#pragma unroll
                            for (int j = 0; j < 4; ++j) { a[j] = sigmoid_(a[j]); b[j] = sigmoid_(b[j]); }
                        }
                        st8bf(dstb + (unsigned)(row * ld + col), a, b);
                        if (isq) {
                            int seq, i; bool smp;
                            if (tail_row(row, 3, seq, i, smp)) {
                                float* d = out + (smp ? OUT_CQS + ((size_t)(l * 128 + seq) * 3 + i) * 3072 : OUT_CQP + ((size_t)(l * 4 + seq) * 3 + i) * 3072) + col;
                                st8f(d, a, b);
                            }
                        }
                    }
                }
        }
    } else if (mode == M_G2A || mode == M_G2B || mode == M_G2C) {
        const int which = mode - M_G2A;
        float* mg = (float*)(ws + W_MG32); const bf16_t* gts = (const bf16_t*)(ws + W_GTS); bf16_t* mgb = (bf16_t*)(ws + W_MGB);
#pragma unroll
        for (int ai = 0; ai < 2; ++ai)
#pragma unroll
            for (int m = 0; m < 4; ++m) {
                __builtin_amdgcn_sched_barrier(0); const int row = rbase + ai * 128 + m * 16;
#pragma unroll
                for (int bj = 0; bj < 2; ++bj) {
                    const int col = pn * 256 + bj * 128 + cl;
                    float g[8]; unpack8(*(const u32x4*)(gts + (unsigned)(row * 6144 + which * 2048 + col)), g);
                    f32x4 a = acc[ai][bj][m][0], b = acc[ai][bj][m][1];
#pragma unroll
                    for (int j = 0; j < 4; ++j) { a[j] *= g[j]; b[j] *= g[4 + j]; }
                    const unsigned mo = (unsigned)(row * DM + col);
                    if (which == 0) st8f(mg + mo, a, b);
                    else if (which == 2) st8f((float*)(ws + W_MG32C) + mo, a, b);
                    else { const float* mc = (const float*)(ws + W_MG32C) + mo;
                        a += *(const f32x4*)(mg + mo) + *(const f32x4*)mc; b += *(const f32x4*)(mg + mo + 4) + *(const f32x4*)(mc + 4);
                        st8bf(mgb + mo, a, b); }
                }
            }
    } else if (mode == M_G3 || mode == M_G5 || mode == M_PE) {
        const float* xr = (const float*)(ws + W_XRES); const float* pe = (const float*)(ws + W_PE);
        float* dst = (float*)(ws + (mode == M_PE ? W_PE : W_PRE));
#pragma unroll
        for (int ai = 0; ai < 2; ++ai)
#pragma unroll
            for (int m = 0; m < 4; ++m) {
                __builtin_amdgcn_sched_barrier(0); const int row = rbase + ai * 128 + m * 16;
#pragma unroll
                for (int bj = 0; bj < 2; ++bj) {
                    const unsigned o = (unsigned)(row * DM + pn * 256 + bj * 128 + cl);
                    f32x4 a = acc[ai][bj][m][0], b = acc[ai][bj][m][1];
                    if (part <= 0) {
                        if (mode == M_G3) { a += ALPHA * *(const f32x4*)(xr + o); b += ALPHA * *(const f32x4*)(xr + o + 4); }
                        if (mode == M_G5) { a += *(const f32x4*)(pe + o); b += *(const f32x4*)(pe + o + 4); }
                    }
                    if (part < 0) st8f(dst + o, a, b);
                    else st8f((float*)(ws + W_PART) + (unsigned)(part * (MS * DM)) + (o - (unsigned)(MP * DM)), a, b);
                }
            }
    } else {
        if (pn < 43) {
            bf16_t* hg = (bf16_t*)(ws + W_HG); bf16_t* hu = (bf16_t*)(ws + W_HU);
#pragma unroll
            for (int ai = 0; ai < 2; ++ai)
#pragma unroll
                for (int m = 0; m < 4; ++m) {
                    __builtin_amdgcn_sched_barrier(0); const int row = rbase + ai * 128 + m * 16;
#pragma unroll
                    for (int bj = 0; bj < 2; ++bj) {
                        const int c = pn * 256 + bj * 128 + cl;
                        const f32x4 a = acc[ai][bj][m][0], b = acc[ai][bj][m][1];
                        if (c < DFF) {
                            st8bf(hg + (unsigned)(row * DFF + c), a, b);
                            int seq, i; bool smp;
                            if (tail_row(row, 2, seq, i, smp)) {
                                float* d = out + (smp ? OUT_CFS + ((size_t)(l * 128 + seq) * 2 + i) * DFF : OUT_CFP + ((size_t)(l * 4 + seq) * 2 + i) * DFF) + c;
                                st8f(d, a, b);
                            }
                        } else st8bf(hu + (unsigned)(row * DFF + (c - DFF)), a, b);
                    }
                }
        } else {
            float* pe = (float*)(ws + W_PE);
#pragma unroll
            for (int ai = 0; ai < 2; ++ai)
#pragma unroll
                for (int m = 0; m < 4; ++m) {
                    __builtin_amdgcn_sched_barrier(0); const int row = rbase + ai * 128 + m * 16;
#pragma unroll
                    for (int bj = 0; bj < 2; ++bj) {
                        float* p = pe + (unsigned)(row * DM + (pn - 43) * 256 + bj * 128 + cl);
                        f32x4 a = acc[ai][bj][m][0], b = acc[ai][bj][m][1];
                        const f32x4 pa = *(const f32x4*)p, pb = *(const f32x4*)(p + 4);
                        const float* xq = (const float*)(ws + W_XRES) + (unsigned)(row * DM + (pn - 43) * 256 + bj * 128 + cl);
                        const f32x4 xa = *(const f32x4*)xq, xb4 = *(const f32x4*)(xq + 4);
#pragma unroll
                        for (int j = 0; j < 4; ++j) { a[j] = sigmoid_(a[j]) * pa[j] + ALPHA * xa[j]; b[j] = sigmoid_(b[j]) * pb[j] + ALPHA * xb4[j]; }
                        st8f(p, a, b);
                    }
                }
        }
    }
}

__device__ __forceinline__ void gemm_phase(LAS unsigned char* lds, const Gemm g, const StaticOrder& S, const KP& P, const int mode, const int layer) {
    const int tidx_ = otid(), bidx_ = obid(); (void)tidx_; (void)bidx_;
    const int tid = tidx_, wid = __builtin_amdgcn_readfirstlane(tid >> 6), lane = tid & 63, wr = wid >> 2, wc = wid & 3, fr = lane & 15, fq = lane >> 4;
    const int K = g.K;
    unsigned voffA[2], voffB[2];
#pragma unroll
    for (int i = 0; i < 2; ++i) { int R, C; stage_rc(tid * 16 + i * 8192, R, C); const int Rb = (R & ~31) + perm32(R & 31);
        voffA[i] = (unsigned)(R * K + C) * 2u; voffB[i] = (unsigned)(Rb * K + C) * 2u; }
    const size_t kstep = (size_t)(BK * 2);
    const size_t hstep = (size_t)HALF * K * 2;
    const size_t tstep = 2 * hstep;
    const unsigned ldsw = (unsigned)wid * 1024u;
    const int aoff = lds_byte(wr * 64 + fr, fq * 8), boff = lds_byte(wc * 32 + fr, fq * 8);
#define PG8_SA(b, h) (((b) * 2 + (h)) * HTB)
#define PG8_SB(b, h) ((4 + (b) * 2 + (h)) * HTB)
#define PG8_STAGE(bufoff, gbase, voff) do { _Pragma("unroll") for (int _i = 0; _i < 2; ++_i) \
        __builtin_amdgcn_global_load_lds((const unsigned*)((const char*)(gbase) + (voff)[_i]), (LAS unsigned*)(lds + (bufoff) + ldsw + _i * 8192), 16, 0, 0); } while (0)
#define PG8_LDA(dst, b, h) do { _Pragma("unroll") for (int m = 0; m < 4; ++m) _Pragma("unroll") for (int k = 0; k < 2; ++k) dst[m][k] = *(const LAS bf16x8*)(lds + PG8_SA(b, h) + aoff + m * 2048 + k * 1024); } while (0)
#define PG8_LDB(dst, b, h) do { _Pragma("unroll") for (int n = 0; n < 2; ++n) _Pragma("unroll") for (int k = 0; k < 2; ++k) dst[n][k] = *(const LAS bf16x8*)(lds + PG8_SB(b, h) + boff + n * 2048 + k * 1024); } while (0)
#define PG8_MMA(ai, bj, At, Bt) do { __builtin_amdgcn_s_setprio(1); _Pragma("unroll") for (int m = 0; m < 4; ++m) _Pragma("unroll") for (int n = 0; n < 2; ++n) _Pragma("unroll") for (int k = 0; k < 2; ++k) \
        acc[ai][bj][m][n] = __builtin_amdgcn_mfma_f32_16x16x32_bf16(Bt[n][k], At[m][k], acc[ai][bj][m][n], 0, 0, 0); __builtin_amdgcn_s_setprio(0); } while (0)
#define PG8_WAIT_V(n) asm volatile("s_waitcnt vmcnt(" #n ")" ::: "memory")
#define PG8_WAIT_L(n) asm volatile("s_waitcnt lgkmcnt(" #n ")" ::: "memory")
#define PG8_BAR __builtin_amdgcn_s_barrier()
#define PG8_SCHED __builtin_amdgcn_sched_barrier(0)
    Unit cur, nxt; int ui = 0;
    if (!S.next(0, cur)) return;
    f32x4 acc[2][2][4][2];
#pragma unroll
    for (int a = 0; a < 2; ++a)
#pragma unroll
        for (int b = 0; b < 2; ++b)
#pragma unroll
            for (int m = 0; m < 4; ++m)
#pragma unroll
                for (int n = 0; n < 2; ++n) acc[a][b][m][n] = (f32x4){0.f, 0.f, 0.f, 0.f};
    bf16x8 At[4][2], B0[2][2], B1[2][2];
    const char* cA = (const char*)g.A + (size_t)cur.pm * tstep + (size_t)cur.k0 * kstep; const char* cB = (const char*)g.Bt + (size_t)cur.pn * tstep + (size_t)cur.k0 * kstep;
    PG8_STAGE(PG8_SB(0, 0), cB, voffB); PG8_STAGE(PG8_SB(0, 1), cB + hstep, voffB); PG8_STAGE(PG8_SA(0, 0), cA, voffA); PG8_STAGE(PG8_SA(0, 1), cA + hstep, voffA);
    if (wr == 1) PG8_BAR;
    PG8_WAIT_V(2); PG8_BAR;
    PG8_STAGE(PG8_SB(1, 0), cB + kstep, voffB); PG8_STAGE(PG8_SA(1, 0), cA + kstep, voffA); PG8_STAGE(PG8_SB(1, 1), cB + hstep + kstep, voffB);
    PG8_WAIT_V(6); PG8_BAR;
    for (;;) {
        const bool has_next = S.next(ui + 1, nxt);
        const char* nA = has_next ? (const char*)g.A + (size_t)nxt.pm * tstep + (size_t)nxt.k0 * kstep : cA; const char* nB = has_next ? (const char*)g.Bt + (size_t)nxt.pn * tstep + (size_t)nxt.k0 * kstep : cB;
        const int nt = cur.nt;
        for (int t = 0; t < nt; t += 2) {
            const bool last = (t == nt - 2);
            const char* a1 = cA + (size_t)(t + 1) * kstep;
            const char* a2 = last ? nA : cA + (size_t)(t + 2) * kstep; const char* b2 = last ? nB : cB + (size_t)(t + 2) * kstep;
            const char* a3 = a2 + kstep; const char* b3 = b2 + kstep;
            PG8_LDB(B0, 0, 0); PG8_LDB(B1, 0, 1); PG8_SCHED; PG8_LDA(At, 0, 0); PG8_STAGE(PG8_SA(1, 1), a1 + hstep, voffA);
            PG8_WAIT_V(8); PG8_WAIT_L(0); PG8_BAR; PG8_MMA(0, 0, At, B0); PG8_MMA(0, 1, At, B1); PG8_BAR; PG8_SCHED;
            PG8_LDA(At, 0, 1); PG8_STAGE(PG8_SB(0, 0), b2, voffB); PG8_STAGE(PG8_SB(0, 1), b2 + hstep, voffB); PG8_STAGE(PG8_SA(0, 0), a2, voffA);
            PG8_WAIT_V(8); PG8_WAIT_L(0); PG8_BAR; PG8_MMA(1, 0, At, B0); PG8_MMA(1, 1, At, B1); PG8_BAR; PG8_SCHED;
            PG8_LDB(B0, 1, 0); PG8_LDB(B1, 1, 1); PG8_SCHED; PG8_LDA(At, 1, 0); PG8_STAGE(PG8_SA(0, 1), a2 + hstep, voffA);
            PG8_WAIT_V(8); PG8_WAIT_L(0); PG8_BAR; PG8_MMA(0, 0, At, B0); PG8_MMA(0, 1, At, B1); PG8_BAR; PG8_SCHED;
            PG8_LDA(At, 1, 1); PG8_STAGE(PG8_SB(1, 0), b3, voffB); PG8_STAGE(PG8_SB(1, 1), b3 + hstep, voffB); PG8_STAGE(PG8_SA(1, 0), a3, voffA);
            PG8_WAIT_V(8); PG8_WAIT_L(0); PG8_BAR; PG8_MMA(1, 0, At, B0); PG8_MMA(1, 1, At, B1); PG8_BAR; PG8_SCHED;
        }
        if (wr == 0) PG8_BAR;
        epilogue(P, mode, layer, acc, cur.pm, cur.pn, cur.part, wr, wc, fr, fq);
        if (!has_next) break;
#pragma unroll
        for (int a = 0; a < 2; ++a)
#pragma unroll
            for (int b = 0; b < 2; ++b)
#pragma unroll
                for (int m = 0; m < 4; ++m)
#pragma unroll
                    for (int n = 0; n < 2; ++n) acc[a][b][m][n] = (f32x4){0.f, 0.f, 0.f, 0.f};
        cur = nxt; cA = nA; cB = nB; ++ui;
        if (wr == 1) PG8_BAR;
    }
    PG8_WAIT_V(0);
    PG8_BAR;
#undef PG8_SA
#undef PG8_SB
#undef PG8_STAGE
#undef PG8_LDA
#undef PG8_LDB
#undef PG8_MMA
#undef PG8_WAIT_V
#undef PG8_WAIT_L
#undef PG8_BAR
#undef PG8_SCHED
}

__device__ __forceinline__ void tr_tile_w(const float* src, const int ldsrc, const int scol0, const int nvalid, const int k0, bf16_t* dst, const int K, const int drow0, float* scr, const int lane) {
    const int kk = lane >> 3, c4 = (lane & 7) * 4;
    f32x4 v[8];
#pragma unroll
    for (int p = 0; p < 8; ++p) { v[p] = (f32x4){0.f, 0.f, 0.f, 0.f}; if (c4 < nvalid) v[p] = __builtin_nontemporal_load((const f32x4*)(src + (size_t)(k0 + kk + 8 * p) * ldsrc + scol0 + c4)); }
#pragma unroll
    for (int p = 0; p < 8; ++p) {
        scr[(c4 + 0) * 65 + kk + 8 * p] = v[p][0]; scr[(c4 + 1) * 65 + kk + 8 * p] = v[p][1]; scr[(c4 + 2) * 65 + kk + 8 * p] = v[p][2]; scr[(c4 + 3) * 65 + kk + 8 * p] = v[p][3];
    }
    __builtin_amdgcn_wave_barrier();
#pragma unroll
    for (int q = 0; q < 4; ++q) {
        const int id = lane + 64 * q, n = id >> 3, c = id & 7; const float* sp = scr + n * 65 + 8 * c;
        u32x4 o; o.x = pk2(sp[0], sp[1]); o.y = pk2(sp[2], sp[3]); o.z = pk2(sp[4], sp[5]); o.w = pk2(sp[6], sp[7]);
        *(u32x4*)(dst + (size_t)(drow0 + n) * K + k0 + 8 * c) = o;
    }
    __builtin_amdgcn_wave_barrier();
}
__device__ __forceinline__ void convert_weights(const KP& P, const int l, float* scr0, const int part, const int wb0, const int nwb) {
    const int tidx_ = otid(), bidx_ = obid(); (void)tidx_; (void)bidx_;
    unsigned char* ws = ows(P.ws);
    const int lane = tidx_ & 63, wv = tidx_ >> 6, gw = (bidx_ - wb0) * 8 + wv, ngw = nwb * 8;
    float* scr = scr0 + wv * (32 * 65);
    constexpr int T_WIN = (NV1 / 32) * 32, T_W1 = 64 * 16, T_WO = 64 * 32, T_WUP = (2 * DFF / 32) * 32, T_WPG = 64 * 32, T_WDN = 64 * (DFF / 64), T_WPE = 64 * 4;
    constexpr int T_ALL = T_WIN + 3 * T_W1 + T_WO + T_WUP + T_WPG + T_WDN + T_WPE;
    constexpr int T_A = T_WIN + 3 * T_W1 + T_WO, T_LATE = T_WUP + T_WPG;
    const int njobs = part ? T_LATE : T_ALL - T_LATE;
    for (int jt = gw; jt < njobs; jt += ngw) {
        const int it = part ? T_A + jt : (jt < T_A ? jt : jt + T_LATE);
        int r = it;
        if (r < T_WIN) {
            const int nj = r >> 5, kj = r & 31, nv0 = nj * 32; int sc, nv = 32;
            if (nv0 < 2048) { const int t = nv0 >> 8, hf = (nv0 >> 7) & 1, i = nv0 & 127; sc = (hf ? 2048 : 0) + 128 * t + i; }
            else if (nv0 < 3072) sc = nv0 - 1024;
            else if (nv0 < 7168) sc = nv0;
            else if (nv0 < 15360) sc = nv0 + 16;
            else if (nv0 == 15360) { sc = 7168; nv = 16; }
            else { sc = 0; nv = 0; }
            tr_tile_w(P.in[I_WIN] + (size_t)l * 2048 * NIN, NIN, sc, nv, kj * 64, (bf16_t*)(ws + W_WIN), 2048, nv0, scr, lane); continue;
        }
        r -= T_WIN;
        if (r < 3 * T_W1) {
            const int w = r / T_W1, rr = r % T_W1, nj = rr >> 4, kj = rr & 15;
            const float* src = (w == 0 ? P.in[I_WAO] : (w == 1 ? P.in[I_WBO] : P.in[I_WCO])) + (size_t)l * 1024 * 2048;
            bf16_t* dst = (bf16_t*)(ws + (w == 0 ? W_WA : (w == 1 ? W_WB : W_WC)));
            tr_tile_w(src, 2048, nj * 32, 32, kj * 64, dst, 1024, nj * 32, scr, lane); continue;
        }
        r -= 3 * T_W1;
        if (r < T_WO) { const int nj = r >> 5, kj = r & 31; tr_tile_w(P.in[I_WO] + (size_t)l * 2048 * 2048, 2048, nj * 32, 32, kj * 64, (bf16_t*)(ws + W_WO), 2048, nj * 32, scr, lane); continue; }
        r -= T_WO;
        if (r < T_WUP) { const int nj = r >> 5, kj = r & 31; tr_tile_w(P.in[I_WUP] + (size_t)l * 2048 * 2 * DFF, 2 * DFF, nj * 32, 32, kj * 64, (bf16_t*)(ws + W_WUP), 2048, nj * 32, scr, lane); continue; }
        r -= T_WUP;
        if (r < T_WPG) { const int nj = r >> 5, kj = r & 31; tr_tile_w(P.in[I_WPG] + (size_t)l * 2048 * 2048, 2048, nj * 32, 32, kj * 64, (bf16_t*)(ws + W_WUP), 2048, 2 * DFF + nj * 32, scr, lane); continue; }
        r -= T_WPG;
        if (r < T_WDN) { const int nj = r / (DFF / 64), kj = r % (DFF / 64); tr_tile_w(P.in[I_WDN] + (size_t)l * DFF * 2048, 2048, nj * 32, 32, kj * 64, (bf16_t*)(ws + W_WDN), DFF, nj * 32, scr, lane); continue; }
        r -= T_WDN;
        { const int nj = r >> 2, kj = r & 3; tr_tile_w(P.in[I_WPE] + (size_t)l * 256 * 2048, 2048, nj * 32, 32, kj * 64, (bf16_t*)(ws + W_WPE), 256, nj * 32, scr, lane); }
    }
    bf16_t* pb = (bf16_t*)(ws + W_PB);
    if (part == 0) for (int i = bidx_ * 512 + tidx_; i < MT * 32; i += gridDim.x * 512) {
        const int r = i >> 5, c8 = (i & 31) * 8;
        const float* s = (r < MP ? P.in[I_PP] + ((size_t)l * MP + r) * 256 : P.in[I_PS] + ((size_t)l * MS + (r - MP)) * 256) + c8;
        const f32x4 a = *(const f32x4*)s, b = *(const f32x4*)(s + 4);
        st8bf(pb + (size_t)r * 256 + c8, a, b);
    }
}

__device__ __forceinline__ void ln_rows(const KP& P, const int srcsel  , const float* g, const float* b, const bool to_out) {
    const int tidx_ = otid(), bidx_ = obid(); (void)tidx_; (void)bidx_;
    unsigned char* ws = ows(P.ws);
    const int lane = tidx_ & 63, gw = bidx_ * 8 + (tidx_ >> 6), ngw = gridDim.x * 8;
    f32x4 gv[8], bv[8];
#pragma unroll
    for (int j = 0; j < 8; ++j) { gv[j] = *(const f32x4*)(g + j * 256 + lane * 4); bv[j] = *(const f32x4*)(b + j * 256 + lane * 4); }
    for (int r = gw; r < MT; r += ngw) {
        const float* src = srcsel ? (const float*)(ws + W_PRE) + (size_t)r * DM : (r < MP ? P.in[I_XP] + (size_t)r * DM : P.in[I_XS] + (size_t)(r - MP) * DM);
        f32x4 v[8]; float s = 0.f;
        if (srcsel && r >= MP && gridDim.x == 256) {
            const float* pp = (const float*)(ws + W_PART) + (size_t)(r - MP) * DM + lane * 4;
#pragma unroll
            for (int j = 0; j < 8; ++j) v[j] = __builtin_nontemporal_load((const f32x4*)(pp + j * 256));
#pragma unroll 3
            for (int ks = 1; ks < 16; ++ks)
#pragma unroll
                for (int j = 0; j < 8; ++j) v[j] += __builtin_nontemporal_load((const f32x4*)(pp + (size_t)ks * (MS * DM) + j * 256));
#pragma unroll
            for (int j = 0; j < 8; ++j) s += (v[j][0] + v[j][1]) + (v[j][2] + v[j][3]);
        } else {
#pragma unroll
            for (int j = 0; j < 8; ++j) { v[j] = __builtin_nontemporal_load((const f32x4*)(src + j * 256 + lane * 4)); s += (v[j][0] + v[j][1]) + (v[j][2] + v[j][3]); }
        }
        const float mean = wave_sum(s) * (1.f / DM); float s2 = 0.f;
#pragma unroll
        for (int j = 0; j < 8; ++j) { v[j] = v[j] - mean; s2 += (v[j][0] * v[j][0] + v[j][1] * v[j][1]) + (v[j][2] * v[j][2] + v[j][3] * v[j][3]); }
        const float rstd = rsqrtf(wave_sum(s2) * (1.f / DM) + LN_EPS);
        float* d32 = to_out ? P.out + (size_t)r * DM : (float*)(ws + W_XRES) + (size_t)r * DM;
        bf16_t* db = (bf16_t*)(ws + W_XB) + (size_t)r * DM;
#pragma unroll
        for (int j = 0; j < 8; ++j) {
            const f32x4 y = v[j] * rstd * gv[j] + bv[j];
            if (to_out) __builtin_nontemporal_store(y, (f32x4*)(d32 + j * 256 + lane * 4)); else *(f32x4*)(d32 + j * 256 + lane * 4) = y;
            if (!to_out) { u32x2 w; w.x = pk2(y[0], y[1]); w.y = pk2(y[2], y[3]); *(u32x2*)(db + j * 256 + lane * 4) = w; }
        }
    }
}

__device__ __forceinline__ void phase_e(const KP& P, const int l) {
    const int tidx_ = otid(), bidx_ = obid(); (void)tidx_; (void)bidx_;
    unsigned char* ws = ows(P.ws);
    {
        const bf16_t* ch = (const bf16_t*)(ws + W_CH); const bf16_t* bg = (const bf16_t*)(ws + W_BG); bf16_t* ya = (bf16_t*)(ws + W_YA);
        const float* cw = P.in[I_CAW] + (size_t)l * 3 * 1024; const float* hist = P.in[I_SCA] + (size_t)l * 128 * 2 * 1024;
        for (int i = bidx_ * 512 + tidx_; i < (MT / 4) * 128; i += gridDim.x * 512) {
            const int q = i >> 7, c8 = (i & 127) * 8, r0 = 4 * q;
            const bool smp = r0 >= MP; const int t0 = smp ? 0 : (r0 & 2047), sb = (r0 - MP) >> 2;
            float x[6][8];
#pragma unroll
            for (int d = 0; d < 2; ++d) {
                if (t0 > 0) unpack8(*(const u32x4*)(ch + (size_t)(r0 - 2 + d) * 1024 + c8), x[d]);
                else if (smp) { const float* h = hist + ((size_t)sb * 2 + d) * 1024 + c8; const f32x4 h0 = *(const f32x4*)h, h1 = *(const f32x4*)(h + 4);
#pragma unroll
                    for (int j = 0; j < 4; ++j) { x[d][j] = h0[j]; x[d][4 + j] = h1[j]; } }
                else {
#pragma unroll
                    for (int j = 0; j < 8; ++j) x[d][j] = 0.f; }
            }
#pragma unroll
            for (int d = 0; d < 4; ++d) unpack8(*(const u32x4*)(ch + (size_t)(r0 + d) * 1024 + c8), x[2 + d]);
            float w[3][8];
#pragma unroll
            for (int d = 0; d < 3; ++d) { const f32x4 w0 = *(const f32x4*)(cw + d * 1024 + c8), w1 = *(const f32x4*)(cw + d * 1024 + c8 + 4);
#pragma unroll
                for (int j = 0; j < 4; ++j) { w[d][j] = w0[j]; w[d][4 + j] = w1[j]; } }
#pragma unroll
            for (int d = 0; d < 4; ++d) {
                float g[8], a[8]; unpack8(*(const u32x4*)(bg + (size_t)(r0 + d) * 1024 + c8), g);
#pragma unroll
                for (int j = 0; j < 8; ++j) a[j] = g[j] * (w[0][j] * x[d][j] + w[1][j] * x[d + 1][j] + w[2][j] * x[d + 2][j]);
                *(u32x4*)(ya + (size_t)(r0 + d) * 1024 + c8) = pack8(a);
            }
        }
    }
    const int lane = tidx_ & 63, gw = bidx_ * 8 + (tidx_ >> 6), ngw = gridDim.x * 8;
    {
        const bf16_t* qkv = (const bf16_t*)(ws + W_QKV); bf16_t* qn = (bf16_t*)(ws + W_QKVN); float* qns = (float*)(ws + W_QKVNS);
        const float* cw = P.in[I_CBW] + (size_t)l * 4 * 3072; const float* hist = P.in[I_SCQ] + (size_t)l * 128 * 3 * 3072;
        for (int it = gw; it < (MT / 4) * 6; it += ngw) {
            const int q = it / 6, s4 = it % 6, c = s4 * 512 + lane * 8, r0 = 4 * q;
            const bool smp = r0 >= MP; const int t0 = smp ? 0 : (r0 & 2047), sb = (r0 - MP) >> 2;
            float x[7][8];
#pragma unroll
            for (int d = 0; d < 3; ++d) {
                if (t0 > 0) unpack8(*(const u32x4*)(qkv + (size_t)(r0 - 3 + d) * 3072 + c), x[d]);
                else if (smp) { const float* hp = hist + ((size_t)sb * 3 + d) * 3072 + c; const f32x4 h0 = *(const f32x4*)hp, h1 = *(const f32x4*)(hp + 4);
#pragma unroll
                    for (int j = 0; j < 4; ++j) { x[d][j] = h0[j]; x[d][4 + j] = h1[j]; } }
                else {
#pragma unroll
                    for (int j = 0; j < 8; ++j) x[d][j] = 0.f; }
            }
#pragma unroll
            for (int d = 0; d < 4; ++d) unpack8(*(const u32x4*)(qkv + (size_t)(r0 + d) * 3072 + c), x[3 + d]);
            float w[4][8];
#pragma unroll
            for (int d = 0; d < 4; ++d) { const f32x4 w0 = *(const f32x4*)(cw + d * 3072 + c), w1 = *(const f32x4*)(cw + d * 3072 + c + 4);
#pragma unroll
                for (int j = 0; j < 4; ++j) { w[d][j] = w0[j]; w[d][4 + j] = w1[j]; } }
#pragma unroll
            for (int d = 0; d < 4; ++d) {
                float a[8]; float ss = 0.f;
#pragma unroll
                for (int j = 0; j < 8; ++j) { a[j] = silu_(w[0][j] * x[d][j] + w[1][j] * x[d + 1][j] + w[2][j] * x[d + 2][j] + w[3][j] * x[d + 3][j]); ss += a[j] * a[j]; }
                if (s4 < 4) {
                    ss += __shfl_xor(ss, 1); ss += __shfl_xor(ss, 2); ss += __shfl_xor(ss, 4); ss += __shfl_xor(ss, 8);
                    const float sc = rsqrtf(ss + RMS_EPS) * (s4 < 2 ? 0.08838834764831845f : 1.f);
#pragma unroll
                    for (int j = 0; j < 8; ++j) a[j] *= sc;
                }
                *(u32x4*)(qn + (size_t)(r0 + d) * 3072 + c) = pack8(a);
                if (smp) st8f(qns + (size_t)(r0 + d - MP) * 3072 + c, (f32x4){a[0], a[1], a[2], a[3]}, (f32x4){a[4], a[5], a[6], a[7]});
            }
        }
    }
    {
        const bf16_t* gv = (const bf16_t*)(ws + W_GV); bf16_t* vcn = (bf16_t*)(ws + W_VCN);
        const float* lg = P.in[I_LCG] + (size_t)l * 1024; const float* lb = P.in[I_LCB] + (size_t)l * 1024;
        for (int r = gw; r < MT; r += ngw) {
            float x[2][8]; float s = 0.f;
#pragma unroll
            for (int j = 0; j < 2; ++j) { unpack8(*(const u32x4*)(gv + (size_t)r * 1024 + j * 512 + lane * 8), x[j]);
#pragma unroll
                for (int e = 0; e < 8; ++e) s += x[j][e]; }
            const float mean = wave_sum(s) * (1.f / 1024.f); float s2 = 0.f;
#pragma unroll
            for (int j = 0; j < 2; ++j)
#pragma unroll
                for (int e = 0; e < 8; ++e) { x[j][e] -= mean; s2 += x[j][e] * x[j][e]; }
            const float rstd = rsqrtf(wave_sum(s2) * (1.f / 1024.f) + LN_EPS);
#pragma unroll
            for (int j = 0; j < 2; ++j) {
                const int c = j * 512 + lane * 8;
#pragma unroll
                for (int e = 0; e < 8; ++e) x[j][e] = x[j][e] * rstd * lg[c + e] + lb[c + e];
                *(u32x4*)(vcn + (size_t)r * 1024 + c) = pack8(x[j]);
                if (r >= MP) { float* d = P.out + OUT_VS + ((size_t)l * MS + (r - MP)) * 1024 + c;
                    st8f(d, (f32x4){x[j][0], x[j][1], x[j][2], x[j][3]}, (f32x4){x[j][4], x[j][5], x[j][6], x[j][7]}); }
            }
        }
    }
}

__device__ __forceinline__ void beta_gate(const KP& P, const int l) {
    const int tidx_ = otid(), bidx_ = obid(); (void)tidx_; (void)bidx_;
    unsigned char* ws = ows(P.ws);
    const int lane = tidx_ & 63, lr = lane & 15, lq = lane >> 4, gw = bidx_ * 8 + (tidx_ >> 6), ngw = gridDim.x * 8;
    const bf16_t* xb = (const bf16_t*)(ws + W_XB); const bf16_t* wt = (const bf16_t*)(ws + W_WIN) + (size_t)15360 * 2048;
    float* betab = (float*)(ws + W_BETA); float* ggb = (float*)(ws + W_GG);
    for (int it = gw; it < MT / 16; it += ngw) {
        const bf16_t* ap = xb + (size_t)(16 * it + lr) * 2048 + lq * 8; const bf16_t* bp = wt + (size_t)lr * 2048 + lq * 8;
        f32x4 acc0 = {0.f, 0.f, 0.f, 0.f}, acc1 = {0.f, 0.f, 0.f, 0.f};
#pragma unroll 8
        for (int ks = 0; ks < 64; ks += 2) {
            acc0 = __builtin_amdgcn_mfma_f32_16x16x32_bf16(*(const bf16x8*)(ap + ks * 32), *(const bf16x8*)(bp + ks * 32), acc0, 0, 0, 0);
            acc1 = __builtin_amdgcn_mfma_f32_16x16x32_bf16(*(const bf16x8*)(ap + ks * 32 + 32), *(const bf16x8*)(bp + ks * 32 + 32), acc1, 0, 0, 0);
        }
        const int h = lr & 7; const float al = -__expf(P.in[I_ALOG][l * 8 + h]), dtb = P.in[I_DTB][l * 8 + h];
#pragma unroll
        for (int j = 0; j < 4; ++j) {
            const float v = acc0[j] + acc1[j]; const int row = 16 * it + 4 * lq + j;
            if (lr < 8) betab[row * 8 + h] = sigmoid_(v); else ggb[row * 8 + h] = al * softplus_(v + dtb);
        }
    }
}
__device__ __forceinline__ void d1_prep(const KP& P, const int l, float* shm) {
    const int tidx_ = otid(), bidx_ = obid(); (void)tidx_; (void)bidx_;
    unsigned char* ws = ows(P.ws);
    const int tid = tidx_, w = tid >> 6, lane = tid & 63, lr = lane & 15, lq = lane >> 4;
    float* Am = shm;
    float* gc = Am + 64 * 68;
    float* bt = gc + 64;
    float* X = shm + 8192;
    const bf16_t* qn = (const bf16_t*)(ws + W_QKVN);
    const float* betab = (const float*)(ws + W_BETA); const float* ggb = (const float*)(ws + W_GG);
    float* DU = (float*)(ws + W_DU); bf16_t* DNW = (bf16_t*)(ws + W_DNW); bf16_t* DQD = (bf16_t*)(ws + W_DQD); bf16_t* DKDT = (bf16_t*)(ws + W_DKDT);
    bf16_t* DQK = (bf16_t*)(ws + W_DQK); float* DGL = (float*)(ws + W_DGL);
    for (int T = bidx_; T < 1024; T += gridDim.x) {
        const int chain = T >> 5, n = T & 31, b = chain >> 3, h = chain & 7, r0 = b * 2048 + n * 64;
        const bf16_t* qp = qn + (size_t)r0 * 3072 + h * 128; const bf16_t* kp = qp + 1024; const bf16_t* vp = qp + 2048;
        if (w == 0) {
            float v = ggb[(size_t)(r0 + lane) * 8 + h];
#pragma unroll
            for (int o = 1; o < 64; o <<= 1) { const float t = __shfl_up(v, o); if (lane >= o) v += t; }
            gc[lane] = v; bt[lane] = betab[(size_t)(r0 + lane) * 8 + h];
        }
        __syncthreads();
        {
            const int rt = w & 3;
            bf16x8 ak[4], aq[4];
#pragma unroll
            for (int ks = 0; ks < 4; ++ks) { ak[ks] = *(const bf16x8*)(kp + (size_t)(16 * rt + lr) * 3072 + ks * 32 + lq * 8); aq[ks] = *(const bf16x8*)(qp + (size_t)(16 * rt + lr) * 3072 + ks * 32 + lq * 8); }
#pragma unroll
            for (int c2 = 0; c2 < 2; ++c2) {
                const int nt = 2 * (w >> 2) + c2;
                f32x4 ckk = {0.f, 0.f, 0.f, 0.f}, cqk = {0.f, 0.f, 0.f, 0.f};
#pragma unroll
                for (int ks = 0; ks < 4; ++ks) {
                    const bf16x8 bb = *(const bf16x8*)(kp + (size_t)(16 * nt + lr) * 3072 + ks * 32 + lq * 8);
                    ckk = __builtin_amdgcn_mfma_f32_16x16x32_bf16(ak[ks], bb, ckk, 0, 0, 0);
                    cqk = __builtin_amdgcn_mfma_f32_16x16x32_bf16(aq[ks], bb, cqk, 0, 0, 0);
                }
                const int jj = 16 * nt + lr; const float gj = gc[jj];
#pragma unroll
                for (int j = 0; j < 4; ++j) {
                    const int i = 16 * rt + 4 * lq + j; const float dec = __expf(fminf(gc[i] - gj, 0.f));
                    Am[i * 68 + jj] = (i > jj) ? bt[i] * ckk[j] * dec : 0.f;
                    DQK[(size_t)T * 4096 + i * 64 + jj] = f2bf((i >= jj) ? cqk[j] * dec : 0.f);
                }
            }
        }
        __syncthreads();
        {
            const int c = tid & 255, hf = tid >> 8; const bool isv = c < 128; const bf16_t* colp = isv ? vp + c : kp + (c - 128);
#pragma unroll 16
            for (int i2 = 0; i2 < 32; ++i2) { const int i = hf * 32 + i2; float rhs = bf2f(colp[(size_t)i * 3072]) * bt[i]; if (!isv) rhs *= __expf(gc[i]); X[i * 256 + c] = rhs; }
            const float glast = gc[63];
#pragma unroll 8
            for (int e = tid; e < 8192; e += 512) { const int i = e >> 7, d = e & 127; DQD[(size_t)T * 8192 + e] = f2bf(bf2f(qp[(size_t)i * 3072 + d]) * __expf(gc[i])); }
#pragma unroll 8
            for (int e = tid; e < 8192; e += 512) { const int d = e >> 6, i = e & 63; DKDT[(size_t)T * 8192 + e] = f2bf(bf2f(kp[(size_t)i * 3072 + d]) * __expf(glast - gc[i])); }
            if (tid == 0) DGL[T] = __expf(glast);
        }
        __syncthreads();
#pragma unroll
        for (int I = 0; I < 4; ++I) {
            if (I > 0) {
#pragma unroll
                for (int c2 = 0; c2 < 2; ++c2) {
                    const int ct = 2 * w + c2;
                    f32x4 acc = {0.f, 0.f, 0.f, 0.f};
#pragma unroll
                    for (int kk = 0; kk < 4 * I; ++kk)
                        acc = __builtin_amdgcn_mfma_f32_16x16x4f32(Am[(16 * I + lr) * 68 + 4 * kk + lq], X[(4 * kk + lq) * 256 + 16 * ct + lr], acc, 0, 0, 0);
#pragma unroll
                    for (int j = 0; j < 4; ++j) X[(16 * I + 4 * lq + j) * 256 + 16 * ct + lr] -= acc[j];
                }
                __syncthreads();
            }
            if (tid < 256) {
                float x[16];
#pragma unroll
                for (int r = 0; r < 16; ++r) x[r] = X[(16 * I + r) * 256 + tid];
#pragma unroll
                for (int r = 1; r < 16; ++r) {
                    float sacc = 0.f;
#pragma unroll
                    for (int j = 0; j < r; ++j) sacc += Am[(16 * I + r) * 68 + 16 * I + j] * x[j];
                    x[r] -= sacc;
                }
#pragma unroll
                for (int r = 1; r < 16; ++r) X[(16 * I + r) * 256 + tid] = x[r];
            }
            __syncthreads();
        }
        {
            const int c = tid & 255, hf = tid >> 8;
            if (c < 128) {
#pragma unroll 8
                for (int i2 = 0; i2 < 32; ++i2) { const int i = hf * 32 + i2; DU[(size_t)T * 8192 + i * 128 + c] = X[i * 256 + c]; }
            } else {
#pragma unroll 8
                for (int i2 = 0; i2 < 32; ++i2) { const int i = hf * 32 + i2; DNW[(size_t)T * 8192 + i * 128 + (c - 128)] = f2bf(-X[i * 256 + c]); }
            }
        }
        __syncthreads();
    }
}
__device__ __forceinline__ void d1_mix(const KP& P, const int l) {
    const int tidx_ = otid(), bidx_ = obid(); (void)tidx_; (void)bidx_;
    unsigned char* ws = ows(P.ws);
    const int tid = tidx_, w = tid >> 6, lane = tid & 63, lr = lane & 15, lq = lane >> 4;
    const bf16_t* vcn = (const bf16_t*)(ws + W_VCN); const bf16_t* gu = (const bf16_t*)(ws + W_GU); bf16_t* yc = (bf16_t*)(ws + W_YC);
    for (int it = bidx_ - 128; it < 512; it += gridDim.x - 128) {
        const int g = it & 7, cn = (it >> 3) & 15, b = it >> 7, r0 = b * 2048 + cn * 128;
        const float* wsg = P.in[I_WS] + ((size_t)l * 8 + g) * 128 * 128; const float* bsg = P.in[I_BS] + ((size_t)l * 8 + g) * 128;
        bf16x8 xv[4];
#pragma unroll
        for (int ks = 0; ks < 4; ++ks)
#pragma unroll
            for (int e = 0; e < 8; ++e) xv[ks][e] = (short)vcn[(size_t)(r0 + 32 * ks + 8 * lq + e) * 1024 + g * 128 + 16 * w + lr];
        float biasv[8]; u32x2 gq[8];
#pragma unroll
        for (int mt = 0; mt < 8; ++mt) { biasv[mt] = bsg[16 * mt + lr]; gq[mt] = *(const u32x2*)(gu + (size_t)(r0 + 16 * mt + lr) * 1024 + g * 128 + 16 * w + 4 * lq); }
        asm volatile("" ::: "memory");
#pragma unroll
        for (int mt = 0; mt < 8; ++mt) {
            const int t = 16 * mt + lr;
            f32x4 acc = {0.f, 0.f, 0.f, 0.f};
#pragma unroll
            for (int ks = 0; ks < 4; ++ks) {
                if (32 * ks <= 16 * mt + 15) {
                    const float* wp = wsg + (size_t)t * 128 + 32 * ks + 8 * lq; const f32x4 w0 = *(const f32x4*)wp, w1 = *(const f32x4*)(wp + 4);
                    float wv[8] = {w0[0], w0[1], w0[2], w0[3], w1[0], w1[1], w1[2], w1[3]};
                    bf16x8 yw;
#pragma unroll
                    for (int e = 0; e < 8; ++e) yw[e] = (short)f2bf((32 * ks + 8 * lq + e <= t) ? wv[e] : 0.f);
                    acc = __builtin_amdgcn_mfma_f32_16x16x32_bf16(xv[ks], yw, acc, 0, 0, 0);
                }
            }
            const float bias = biasv[mt]; const size_t o = (size_t)(r0 + t) * 1024 + g * 128 + 16 * w + 4 * lq;
            const u32x2 gw2 = gq[mt];
            u32x2 r; r.x = pk2(lo16(gw2.x) * (acc[0] + bias), hi16(gw2.x) * (acc[1] + bias)); r.y = pk2(lo16(gw2.y) * (acc[2] + bias), hi16(gw2.y) * (acc[3] + bias));
            *(u32x2*)(yc + o) = r;
        }
    }
    for (int i = (bidx_ - 128) * 512 + tidx_; i < MS * 128; i += (gridDim.x - 128) * 512) {
        const int rs = i >> 7, c8 = (i & 127) * 8, t = rs & 3, g = c8 >> 7, r = MP + rs;
        const float* wsg = P.in[I_WS] + (((size_t)l * 8 + g) * 128 + t) * 128; const float bias = P.in[I_BS][((size_t)l * 8 + g) * 128 + t];
        float a[8];
#pragma unroll
        for (int e = 0; e < 8; ++e) a[e] = bias;
#pragma unroll
        for (int s = 0; s < 4; ++s) if (s <= t) { float x[8]; unpack8(*(const u32x4*)(vcn + (size_t)(r - t + s) * 1024 + c8), x); const float wv = wsg[s];
#pragma unroll
            for (int e = 0; e < 8; ++e) a[e] += wv * x[e]; }
        float gq[8]; unpack8(*(const u32x4*)(gu + (size_t)r * 1024 + c8), gq);
#pragma unroll
        for (int e = 0; e < 8; ++e) a[e] *= gq[e];
        *(u32x4*)(yc + (size_t)r * 1024 + c8) = pack8(a);
    }
}
__device__ __forceinline__ void d1_sample_delta(const KP& P, const int l, float* shm) {
    const int tidx_ = otid(), bidx_ = obid(); (void)tidx_; (void)bidx_;
    unsigned char* ws = ows(P.ws);
    const int tid = tidx_, dvq = tid & 31, dkg = tid >> 5, lane = tid & 63;
    float* part = shm;
    float* part2 = shm + 2048;
    float* qs = shm + 4096;
    float* ks = qs + 512; float* vs = ks + 512; float* ab = vs + 512; float* zs = ab + 8;
    const float* qns = (const float*)(ws + W_QKVNS); const float* betab = (const float*)(ws + W_BETA); const float* ggb = (const float*)(ws + W_GG);
    const bf16_t* zb = (const bf16_t*)(ws + W_Z); bf16_t* yb = (bf16_t*)(ws + W_YB);
    for (int it = bidx_ - 128; it < 1024; it += gridDim.x - 128) {
        const int b = it >> 3, h = it & 7;
        const size_t so = ((size_t)(l * 128 + b) * 8 + h) * 16384;
        const float* s0 = P.in[I_SD] + so; float* sout = P.out + OUT_DS + so;
        f32x4 S[8];
#pragma unroll
        for (int i = 0; i < 8; ++i) S[i] = __builtin_nontemporal_load((const f32x4*)(s0 + (size_t)(8 * dkg + i) * 128 + 4 * dvq));
        __syncthreads();
        for (int e = tid; e < 1536; e += 512) { const int t = (e >> 7) & 3, d = e & 127, wh = e >> 9; qs[e] = qns[(size_t)(b * 4 + t) * 3072 + wh * 1024 + h * 128 + d]; }
        { const int t = tid >> 7, d = tid & 127; zs[tid] = silu_(bf2f(zb[(size_t)(MP + b * 4 + t) * 1024 + h * 128 + d])) * P.in[I_NBG][(size_t)l * 128 + d]; }
        if (tid < 4) { const int row = MP + b * 4 + tid; ab[tid] = __expf(ggb[(size_t)row * 8 + h]); ab[4 + tid] = betab[(size_t)row * 8 + h]; }
        __syncthreads();
#pragma unroll 1
        for (int t = 0; t < 4; ++t) {
            const int row = MP + b * 4 + t;
            const float a = ab[t], be = ab[4 + t];
            f32x4 p = {0.f, 0.f, 0.f, 0.f};
#pragma unroll
            for (int i = 0; i < 8; ++i) p += ks[t * 128 + 8 * dkg + i] * S[i];
            *(f32x4*)(part + dkg * 128 + 4 * dvq) = p;
            __syncthreads();
            f32x4 kS = {0.f, 0.f, 0.f, 0.f};
#pragma unroll
            for (int j = 0; j < 16; ++j) kS += *(const f32x4*)(part + j * 128 + 4 * dvq);
            const f32x4 vv = *(const f32x4*)(vs + t * 128 + 4 * dvq);
            const f32x4 vn = be * (vv - a * kS);
            f32x4 po = {0.f, 0.f, 0.f, 0.f};
#pragma unroll
            for (int i = 0; i < 8; ++i) { S[i] = a * S[i] + ks[t * 128 + 8 * dkg + i] * vn; po += qs[t * 128 + 8 * dkg + i] * S[i]; }
            *(f32x4*)(part2 + dkg * 128 + 4 * dvq) = po;
            __syncthreads();
            if (tid < 64) {
                float o0 = 0.f, o1 = 0.f;
#pragma unroll
                for (int j = 0; j < 16; ++j) { o0 += part2[j * 128 + lane]; o1 += part2[j * 128 + 64 + lane]; }
                const float rstd = rsqrtf(wave_sum(o0 * o0 + o1 * o1) * (1.f / 128.f) + RMS_EPS);
                const size_t o = (size_t)row * 1024 + h * 128;
                yb[o + lane] = f2bf(o0 * rstd * zs[t * 128 + lane]);
                yb[o + 64 + lane] = f2bf(o1 * rstd * zs[t * 128 + 64 + lane]);
            }
        }
#pragma unroll
        for (int i = 0; i < 8; ++i) __builtin_nontemporal_store(S[i], (f32x4*)(sout + (size_t)(8 * dkg + i) * 128 + 4 * dvq));
    }
}

struct D2Frags { bf16x8 nwh[4], qd[4], qk[2], kd[2][2]; float u[4]; float gl; };
__device__ __forceinline__ void d2_load(D2Frags& f, const unsigned char* ws, const int T, const int rg, const int lr, const int lq, const int dvc) {
    const bf16_t* DNW = (const bf16_t*)(ws + W_DNW); const bf16_t* DQD = (const bf16_t*)(ws + W_DQD);
    const bf16_t* DKDT = (const bf16_t*)(ws + W_DKDT); const bf16_t* DQK = (const bf16_t*)(ws + W_DQK);
    const unsigned o8 = (unsigned)T * 8192u + (unsigned)(16 * rg + lr) * 128u + lq * 8;
#pragma unroll
    for (int ks = 0; ks < 4; ++ks) { f.nwh[ks] = *(const bf16x8*)(DNW + o8 + ks * 32); f.qd[ks] = *(const bf16x8*)(DQD + o8 + ks * 32); }
#pragma unroll
    for (int k2 = 0; k2 < 2; ++k2) {
        f.qk[k2] = *(const bf16x8*)(DQK + (unsigned)T * 4096u + (unsigned)(16 * rg + lr) * 64u + k2 * 32 + lq * 8);
#pragma unroll
        for (int t2 = 0; t2 < 2; ++t2) f.kd[t2][k2] = *(const bf16x8*)(DKDT + (unsigned)T * 8192u + (unsigned)(32 * rg + 16 * t2 + lr) * 64u + k2 * 32 + lq * 8);
    }
#pragma unroll
    for (int j = 0; j < 4; ++j) f.u[j] = ((const float*)(ws + W_DU))[(unsigned)T * 8192u + (unsigned)(16 * rg + 4 * lq + j) * 128u + dvc];
    f.gl = ((const float*)(ws + W_DGL))[T];
}
#define MF(a_, b_, c_) c_ = __builtin_amdgcn_mfma_f32_16x16x32_bf16(a_, b_, c_, 0, 0, 0)
__device__ __forceinline__ void d2_step(const D2Frags& cur, D2Frags& nxt, const unsigned char* ws, const int Tn, const int r0, const int h, const int rg, const int lr, const int lq, const int dvc,
                                        bf16_t* StH, bf16_t* StL, bf16_t* vnT, float* ob, f32x4 (&S)[2]) {
    d2_load(nxt, ws, Tn, rg, lr, lq, dvc);
    asm volatile("" ::: "memory");
    bf16x8 bSh[4], bSl[4];
#pragma unroll
    for (int ks = 0; ks < 4; ++ks) { bSh[ks] = *(const bf16x8*)(StH + lr * 136 + ks * 32 + lq * 8); bSl[ks] = *(const bf16x8*)(StL + lr * 136 + ks * 32 + lq * 8); }
    f32x4 av = {cur.u[0], cur.u[1], cur.u[2], cur.u[3]};
#pragma unroll
    for (int ks = 0; ks < 4; ++ks) { MF(cur.nwh[ks], bSh[ks], av); MF(cur.nwh[ks], bSl[ks], av); }
    { u32x2 q; q.x = pk2(av[0], av[1]); q.y = pk2(av[2], av[3]); *(u32x2*)(vnT + lr * 72 + 16 * rg + 4 * lq) = q; }
    f32x4 ao = {0.f, 0.f, 0.f, 0.f};
#pragma unroll
    for (int ks = 0; ks < 4; ++ks) MF(cur.qd[ks], bSh[ks], ao);
    __syncthreads();
    bf16x8 bV[2];
#pragma unroll
    for (int k2 = 0; k2 < 2; ++k2) bV[k2] = *(const bf16x8*)(vnT + lr * 72 + k2 * 32 + lq * 8);
#pragma unroll
    for (int k2 = 0; k2 < 2; ++k2) MF(cur.qk[k2], bV[k2], ao);
#pragma unroll
    for (int t2 = 0; t2 < 2; ++t2) {
        S[t2] *= cur.gl;
#pragma unroll
        for (int k2 = 0; k2 < 2; ++k2) MF(cur.kd[t2][k2], bV[k2], S[t2]);
        float hf[4], lf[4];
#pragma unroll
        for (int j = 0; j < 4; ++j) { hf[j] = bf2f(f2bf(S[t2][j])); lf[j] = S[t2][j] - hf[j]; }
        u32x2 q; q.x = pk2(hf[0], hf[1]); q.y = pk2(hf[2], hf[3]); *(u32x2*)(StH + lr * 136 + 32 * rg + 16 * t2 + 4 * lq) = q;
        q.x = pk2(lf[0], lf[1]); q.y = pk2(lf[2], lf[3]); *(u32x2*)(StL + lr * 136 + 32 * rg + 16 * t2 + 4 * lq) = q;
    }
#pragma unroll
    for (int j = 0; j < 4; ++j) ob[(unsigned)(r0 + 16 * rg + 4 * lq + j) * 1024u + h * 128 + dvc] = ao[j];
    __syncthreads();
}
__device__ __forceinline__ void d2_scan(const KP& P, const int l, unsigned char* shmb) {
    const int tidx_ = otid(), bidx_ = obid(); (void)tidx_; (void)bidx_;
    unsigned char* ws = ows(P.ws);
    const int tid = tidx_, w = tid >> 6, lane = tid & 63, lr = lane & 15, lq = lane >> 4, sl = w >> 2, rg = w & 3;
    bf16_t* StH = (bf16_t*)(shmb + sl * 11008); bf16_t* StL = StH + 16 * 136; bf16_t* vnT = StL + 16 * 136;
    float* ob = (float*)(ws + W_OB);
    for (int item = bidx_; item < 128; item += gridDim.x) {
        const int chain = item >> 2, dq = item & 3, b = chain >> 3, h = chain & 7, dv0 = 32 * dq + 16 * sl, dvc = dv0 + lr;
        f32x4 S[2];
        S[0] = (f32x4){0.f, 0.f, 0.f, 0.f}; S[1] = (f32x4){0.f, 0.f, 0.f, 0.f};
        __syncthreads();
        for (int e = tid; e < 2 * 11008 / 4; e += 512) ((unsigned*)shmb)[e] = 0u;
        __syncthreads();
        D2Frags fa, fb; d2_load(fa, ws, chain * 32, rg, lr, lq, dvc);
#pragma unroll 1
        for (int n = 0; n < 32; n += 2) {
            const int T = chain * 32 + n, r0 = b * 2048 + n * 64;
            d2_step(fa, fb, ws, T + 1, r0, h, rg, lr, lq, dvc, StH, StL, vnT, ob, S);
            d2_step(fb, fa, ws, (n < 30) ? T + 2 : T + 1, r0 + 64, h, rg, lr, lq, dvc, StH, StL, vnT, ob, S);
        }
        float* sout = P.out + OUT_DP + ((size_t)(l * 4 + b) * 8 + h) * 16384;
#pragma unroll
        for (int t2 = 0; t2 < 2; ++t2)
#pragma unroll
            for (int j = 0; j < 4; ++j) sout[(unsigned)(32 * rg + 16 * t2 + 4 * lq + j) * 128u + dvc] = S[t2][j];
    }
}
#undef MF
__device__ __forceinline__ void onorm(const KP& P, const int l) {
    const int tidx_ = otid(), bidx_ = obid(); (void)tidx_; (void)bidx_;
    unsigned char* ws = ows(P.ws);
    const int lane = tidx_ & 63, gw = bidx_ * 8 + (tidx_ >> 6), ngw = gridDim.x * 8;
    const float* ob = (const float*)(ws + W_OB); const bf16_t* zb = (const bf16_t*)(ws + W_Z); bf16_t* yb = (bf16_t*)(ws + W_YB);
    const float* ng = P.in[I_NBG] + (size_t)l * 128 + (lane & 7) * 16;
    for (int r = gw; r < MP; r += ngw) {
        const unsigned o = (unsigned)r * 1024u + lane * 16;
        float x[16]; float ss = 0.f;
#pragma unroll
        for (int q = 0; q < 4; ++q) { const f32x4 v = *(const f32x4*)(ob + o + 4 * q); x[4 * q] = v[0]; x[4 * q + 1] = v[1]; x[4 * q + 2] = v[2]; x[4 * q + 3] = v[3]; ss += (v[0] * v[0] + v[1] * v[1]) + (v[2] * v[2] + v[3] * v[3]); }
        ss += __shfl_xor(ss, 1); ss += __shfl_xor(ss, 2); ss += __shfl_xor(ss, 4);
        const float rstd = rsqrtf(ss * (1.f / 128.f) + RMS_EPS);
        float z0[8], z1[8]; unpack8(*(const u32x4*)(zb + o), z0); unpack8(*(const u32x4*)(zb + o + 8), z1);
        float y0[8], y1[8];
#pragma unroll
        for (int e = 0; e < 8; ++e) { y0[e] = x[e] * rstd * ng[e] * silu_(z0[e]); y1[e] = x[8 + e] * rstd * ng[8 + e] * silu_(z1[e]); }
        *(u32x4*)(yb + o) = pack8(y0); *(u32x4*)(yb + o + 8) = pack8(y1);
    }
}

__device__ __forceinline__ void phase_f(const KP& P, const int l) {
    const int tidx_ = otid(), bidx_ = obid(); (void)tidx_; (void)bidx_;
    unsigned char* ws = ows(P.ws);
    const bf16_t* hg = (const bf16_t*)(ws + W_HG); const bf16_t* hu = (const bf16_t*)(ws + W_HU); bf16_t* hh = (bf16_t*)(ws + W_H);
    const float* cw = P.in[I_CFW] + (size_t)l * 3 * DFF; const float* hist = P.in[I_SCF] + (size_t)l * 128 * 2 * DFF;
    constexpr int C8 = DFF / 8;
    for (int i = bidx_ * 512 + tidx_; i < (MT / 4) * C8; i += gridDim.x * 512) {
        const int q = i / C8, c8 = (i % C8) * 8, r0 = 4 * q;
        const bool smp = r0 >= MP; const int t0 = smp ? 0 : (r0 & 2047), sb = (r0 - MP) >> 2;
        float x[6][8];
#pragma unroll
        for (int d = 0; d < 2; ++d) {
            if (t0 > 0) unpack8(*(const u32x4*)(hg + (size_t)(r0 - 2 + d) * DFF + c8), x[d]);
            else if (smp) { const float* hp = hist + ((size_t)sb * 2 + d) * DFF + c8; const f32x4 h0 = *(const f32x4*)hp, h1 = *(const f32x4*)(hp + 4);
#pragma unroll
                for (int j = 0; j < 4; ++j) { x[d][j] = h0[j]; x[d][4 + j] = h1[j]; } }
            else {
#pragma unroll
                for (int j = 0; j < 8; ++j) x[d][j] = 0.f; }
        }
#pragma unroll
        for (int d = 0; d < 4; ++d) unpack8(*(const u32x4*)(hg + (size_t)(r0 + d) * DFF + c8), x[2 + d]);
        float w[3][8];
#pragma unroll
        for (int d = 0; d < 3; ++d) { const f32x4 w0 = *(const f32x4*)(cw + d * DFF + c8), w1 = *(const f32x4*)(cw + d * DFF + c8 + 4);
#pragma unroll
            for (int j = 0; j < 4; ++j) { w[d][j] = w0[j]; w[d][4 + j] = w1[j]; } }
#pragma unroll
        for (int d = 0; d < 4; ++d) {
            float u[8], a[8]; unpack8(*(const u32x4*)(hu + (size_t)(r0 + d) * DFF + c8), u);
#pragma unroll
            for (int j = 0; j < 8; ++j) a[j] = silu_(w[0][j] * x[d][j] + w[1][j] * x[d + 1][j] + w[2][j] * x[d + 2][j]) * u[j];
            *(u32x4*)(hh + (size_t)(r0 + d) * DFF + c8) = pack8(a);
        }
    }
}

#define XB_TMO      128
#define XB_XCNT(j)  (256  + 64 * (j))
#define XB_XSUB(j)  (1280 + 64 * (j))
#define XB_XGEN(j)  (2304 + 64 * (j))
#define XB_TOP      3328
#define XB_TOPGEN   3392
#define XCD_BAR_WORDS 3456
#define XB_SPIN_CAP (1u << 18)

__device__ __forceinline__ unsigned xb_ld(unsigned* p)              { return __hip_atomic_load(p, __ATOMIC_RELAXED, __HIP_MEMORY_SCOPE_AGENT); }
__device__ __forceinline__ unsigned xb_add(unsigned* p, unsigned v) { return __hip_atomic_fetch_add(p, v, __ATOMIC_RELAXED, __HIP_MEMORY_SCOPE_AGENT); }
__device__ __forceinline__ unsigned xb_xcc_id() { return (unsigned)__builtin_amdgcn_s_getreg((3 << 11) | 20) & 0xFu; }
#define XB_SPIN(cond, bar) do { unsigned _sp = 0; while (cond) { __builtin_amdgcn_s_sleep(1); \
    if ((++_sp & 255u) == 0u) { if (xb_ld(&(bar)[XB_TMO])) break; if (_sp > XB_SPIN_CAP) { atomicAdd(&(bar)[XB_TMO], 1u); break; } } } } while (0)

struct XcdBarrier {
    unsigned* bar; unsigned x;
    volatile LAS unsigned* st;
};

__device__ __forceinline__ XcdBarrier xcd_barrier_post(unsigned* bar, volatile LAS unsigned* st) {
    XcdBarrier b; b.bar = bar; b.x = xb_xcc_id(); b.st = st;
    if (threadIdx.x == 0) (void)xb_add(&bar[XB_XCNT(b.x)], 1u);
    return b;
}
__device__ __forceinline__ void xcd_barrier_complete(unsigned* bar, unsigned x, unsigned& nloc, unsigned& nx) {
    const unsigned G = gridDim.x * gridDim.y * gridDim.z;
    unsigned sum, cnt, mine, sp = 0u;
    for (;;) {
        sum = 0u; cnt = 0u; mine = 0u;
#pragma unroll
        for (unsigned j = 0; j < 16; ++j) { const unsigned c = xb_ld(&bar[XB_XCNT(j)]); sum += c; cnt += (c > 0u) ? 1u : 0u; mine = (j == x) ? c : mine; }
        if (sum == G) break;
        __builtin_amdgcn_s_sleep(1);
        if ((++sp & 255u) == 0u) { if (xb_ld(&bar[XB_TMO])) break; if (sp > XB_SPIN_CAP) { atomicAdd(&bar[XB_TMO], 1u); break; } }
    }
    nloc = mine > 0u ? mine : 1u; nx = cnt > 0u ? cnt : 1u;
}

__device__ __forceinline__ void xcd_barrier(const XcdBarrier& b) {
    asm volatile("s_waitcnt vmcnt(0)" ::: "memory");
    __syncthreads();
    if (threadIdx.x == 0) {
        unsigned* bar = b.bar;
        __builtin_amdgcn_s_waitcnt(0);
        unsigned nloc = b.st[0], nx = b.st[1];
        if (nloc == 0u) { xcd_barrier_complete(bar, b.x, nloc, nx); b.st[0] = nloc; b.st[1] = nx; }
        const unsigned old = xb_add(&bar[XB_XSUB(b.x)], 1u);
        const unsigned gen = old / nloc;
        if (old + 1u == (gen + 1u) * nloc) {
            __builtin_amdgcn_fence(__ATOMIC_RELEASE, "agent");
            asm volatile("s_waitcnt vmcnt(0)" ::: "memory");
            const unsigned og = xb_add(&bar[XB_TOP], 1u);
            const unsigned tg = og / nx;
            if (og + 1u == (tg + 1u) * nx) xb_add(&bar[XB_TOPGEN], 1u);
            else XB_SPIN(xb_ld(&bar[XB_TOPGEN]) == tg, bar);
            __builtin_amdgcn_fence(__ATOMIC_ACQUIRE, "agent");
            xb_add(&bar[XB_XGEN(b.x)], 1u);
            asm volatile("s_waitcnt vmcnt(0)" ::: "memory");
        } else {
            XB_SPIN(xb_ld(&bar[XB_XGEN(b.x)]) == gen, bar);
            __builtin_amdgcn_fence(__ATOMIC_ACQUIRE, "agent");
            asm volatile("s_waitcnt vmcnt(0)" ::: "memory");
        }
    }
    __syncthreads();
}

enum { K_G1 = 0, K_E, K_D1, K_D2, K_G2A, K_G2B, K_G3, K_LN1, K_G4, K_F, K_G5, K_LN2, K_PER_LAYER };
constexpr int N_PHASES = 1 + 2 * K_PER_LAYER;

__global__ void __launch_bounds__(512, 2) mega(const KP P, const int ph_lo, const int ph_hi) {
    extern __shared__ __attribute__((aligned(16))) unsigned char shm[];
    cg::grid_group grid = cg::this_grid();
    unsigned char* const ws = P.ws;
    volatile LAS unsigned* xst = (volatile LAS unsigned*)((LAS unsigned char*)shm + STAGE_BYTES);
    if (threadIdx.x == 0) { xst[0] = 0u; xst[1] = 0u; xst[2] = 0u; xst[3] = 0u; }
    __syncthreads();
    (void)xcd_barrier_post((unsigned*)(ws + W_BAR), xst);
    int again = 0;
#pragma unroll 1
    for (int ph = ph_lo; ph < ph_hi;) {
        if (ph == 0) {
#if !defined(PHSEL) || PHSEL == 0
            ln_rows(P, 0, P.in[I_LNG], P.in[I_LNB], false);
#endif
#if !defined(PHSEL) || PHSEL == 1
#endif
        } else {
            const int l = (ph - 1) / K_PER_LAYER, k = (ph - 1) % K_PER_LAYER;
            Gemm g; g.A = nullptr; g.Bt = nullptr; g.M = MT; g.N = 0; g.K = 0; int mode = -1;
            switch (k) {
                case K_G1: g.A = (const bf16_t*)(ws + W_XB); g.Bt = (const bf16_t*)(ws + W_WIN); g.N = NV1 - 256; g.K = 2048; mode = M_G1; break;
                case K_G2A: g.A = (const bf16_t*)(ws + W_YA); g.Bt = (const bf16_t*)(ws + W_WA); g.N = 2048; g.K = 1024; mode = M_G2A; break;
                case K_G2B: g.A = (const bf16_t*)(ws + W_YB); g.Bt = (const bf16_t*)(ws + W_WB); g.N = 2048; g.K = 1024; mode = M_G2B; break;
                case K_G3: g.A = (const bf16_t*)(ws + W_MGB); g.Bt = (const bf16_t*)(ws + W_WO); g.N = 2048; g.K = 2048; mode = M_G3; break;
                case K_G4: g.A = (const bf16_t*)(ws + W_XB); g.Bt = (const bf16_t*)(ws + W_WUP); g.N = NV4; g.K = 2048; mode = M_G4; break;
                case K_G5: g.A = (const bf16_t*)(ws + W_H); g.Bt = (const bf16_t*)(ws + W_WDN); g.N = 2048; g.K = DFF; mode = M_G5; break;
                default: break;
            }
            if (mode >= 0) {
#if !defined(PHSEL) || PHSEL == 2
                const int npass = (k == K_G2A) ? 3 : 1;
#pragma unroll 1
                for (int pass = 0; pass < npass; ++pass) {
                    int cblk = (int)blockIdx.x, G = (int)gridDim.x; bool skip = false;
                    if (pass == 1) {
                        g.A = (const bf16_t*)(ws + W_YC); g.Bt = (const bf16_t*)(ws + W_WC); mode = M_G2C; cblk = (cblk + G / 2) % G;
                    } else if (pass == 2) {
                        g.A = (const bf16_t*)(ws + W_PB); g.Bt = (const bf16_t*)(ws + W_WPE); g.K = 256; mode = M_PE;
                        skip = (cblk < 16) || (cblk >= 128 && cblk < 144); cblk -= (cblk < 128) ? 16 : 32; G -= 32;
                    }
                    if (!skip) {
                        const int split = ((mode == M_G3 || mode == M_G5) && gridDim.x == 256) ? 1 : 0;
                        StaticOrder S; S.init(split ? MP : g.M, g.N, g.K, G, cblk, split);
                        gemm_phase((LAS unsigned char*)shm, g, S, P, mode, l);
                    }
                }
#endif
                if (k == K_G2A) onorm(P, l);
            } else if (k == K_E) {
#if !defined(PHSEL) || PHSEL == 3
                beta_gate(P, l);
                phase_e(P, l);
#endif
            } else if (k == K_D1) {
#if !defined(PHSEL) || PHSEL == 4
                d1_prep(P, l, (float*)shm);
#endif

            } else if (k == K_D2) {
#if !defined(PHSEL) || PHSEL == 7
                if (blockIdx.x < 128) d2_scan(P, l, shm);
                else { d1_sample_delta(P, l, (float*)shm); d1_mix(P, l); }
#endif
            } else if (k == K_LN1) {
                ln_rows(P, 1, P.in[I_L1G] + (size_t)l * DM, P.in[I_L1B] + (size_t)l * DM, false);
            } else if (k == K_F) {
#if !defined(PHSEL) || PHSEL == 8
                phase_f(P, l);
#endif
            } else if (k == K_LN2) {
                ln_rows(P, 1, P.in[I_L2G] + (size_t)l * DM, P.in[I_L2B] + (size_t)l * DM, l == 1);
            }
        }
        {
            int cl = -1, cpart = 0, cb0 = 0, cnb = (int)gridDim.x;
            if (ph == 0) cl = 0;
            else { const int l2 = (ph - 1) / K_PER_LAYER, k2 = (ph - 1) % K_PER_LAYER;
                if (k2 == K_LN2 && l2 == 0) cl = 1;
                else if (k2 == K_G2B && blockIdx.x >= 16) { cl = l2; cpart = 1; cb0 = 16; cnb -= 16; } }
            if (cl >= 0) convert_weights(P, cl, (float*)shm, cpart, cb0, cnb);
        }
#ifdef REPMASK
        {
            const int k = ph == 0 ? -1 : (ph - 1) % K_PER_LAYER; int bit = -1;
            if (ph == 0 || k == K_LN2) bit = 0; else if (k == K_E || k == K_F) bit = 1; else if (k == K_D1) bit = 2; else if (k == K_D2) bit = 3;
            else if (k == K_G1 || k == K_G5) bit = 4; else if (k == K_G3) bit = 5; else if (k == K_LN1) bit = 6;
            if (!again && bit >= 0 && ((REPMASK >> bit) & 1)) again = 1; else { again = 0; ++ph; }
        }
#else
        ++ph; (void)again;
#endif
        if (ph < ph_hi) { if (ph_hi < 0) grid.sync();   { XcdBarrier xb; xb.bar = (unsigned*)(ows(P.ws) + W_BAR); xb.x = xb_xcc_id(); xb.st = (volatile LAS unsigned*)((LAS unsigned char*)shm + STAGE_BYTES); xcd_barrier(xb); } }
    }
}

extern "C" void kernel_launch(void* const* d_in, const int* in_sizes, int n_in, void* d_out, int out_size, void* d_ws, size_t ws_size, hipStream_t stream) {
    static int grid_blocks = 0;
    constexpr int LDS_BYTES = STAGE_BYTES + 256;
    if (grid_blocks == 0) {
        if (n_in != 33 || (size_t)out_size != OUT_END || ws_size < WS_TOTAL) {
            fprintf(stderr, "kernel_launch: unexpected problem (n_in %d, out %d vs %zu, ws %zu vs %zu)\n", n_in, out_size, (size_t)OUT_END, ws_size, (size_t)WS_TOTAL);
            grid_blocks = -1; return;
        }
        int dev = 0, cus = 0, per_cu = 0;
        hipGetDevice(&dev);
        hipDeviceGetAttribute(&cus, hipDeviceAttributeMultiprocessorCount, dev);
        hipFuncSetAttribute((const void*)mega, hipFuncAttributeMaxDynamicSharedMemorySize, LDS_BYTES);
        hipOccupancyMaxActiveBlocksPerMultiprocessor(&per_cu, (const void*)mega, 512, LDS_BYTES);
        if (per_cu < 1) per_cu = 1;
        grid_blocks = cus * 1;
        (void)hipGetLastError();
    }
    if (grid_blocks < 0) return;
    if (hipMemsetAsync((unsigned char*)d_ws + W_BAR, 0, XCD_BAR_WORDS * sizeof(unsigned), stream) != hipSuccess) { fprintf(stderr, "kernel_launch: memset of the barrier words failed\n"); return; }
    KP p{};
    for (int i = 0; i < 33; ++i) p.in[i] = (const float*)d_in[i];
    p.out = (float*)d_out; p.ws = (unsigned char*)d_ws;
    int lo = 0, hi = N_PHASES;
    void* args[] = {&p, &lo, &hi};
    hipError_t e = hipLaunchCooperativeKernel((const void*)mega, dim3(grid_blocks), dim3(512), args, LDS_BYTES, stream);
    if (e != hipSuccess) fprintf(stderr, "cooperative launch failed: %s (grid %d)\n", hipGetErrorString(e), grid_blocks);
}
```

```cpp
#include <hip/hip_runtime.h>
#include <hip/hip_cooperative_groups.h>
#include <cstdio>
#include <cstdint>
namespace cg = cooperative_groups;

#define LAS __attribute__((address_space(3)))
typedef unsigned short bf16_t;
typedef short bf16x8 __attribute__((ext_vector_type(8)));
typedef float f32x4 __attribute__((ext_vector_type(4)));
typedef unsigned u32x4 __attribute__((ext_vector_type(4)));
typedef unsigned u32x2 __attribute__((ext_vector_type(2)));

constexpr int DM = 2048, NBP = 4, SEQ = 2048, NBS = 128, DSQ = 4;
constexpr int MP = NBP * SEQ, MS = NBS * DSQ, MT = MP + MS;
constexpr int DPLE = 256, DA = 1024, HB = 8, DB = 1024, DC = 1024, DFF = 5504, NIN = 15376;
constexpr int NV1 = 61 * 256, NV4 = 2 * DFF + DM;
constexpr float ALPHA = 1.41421356237f, LN_EPS = 1e-5f, RMS_EPS = 1e-6f;

constexpr size_t OUT_YP = 0, OUT_YS = OUT_YP + (size_t)MP * DM, OUT_CAP = OUT_YS + (size_t)MS * DM, OUT_CQP = OUT_CAP + 2 * 4 * 2 * 1024,
                 OUT_DP = OUT_CQP + 2 * 4 * 3 * 3072, OUT_CFP = OUT_DP + 2 * 4 * 8 * 16384, OUT_CAS = OUT_CFP + 2 * 4 * 2 * 5504,
                 OUT_CQS = OUT_CAS + 2 * 128 * 2 * 1024, OUT_DS = OUT_CQS + 2 * 128 * 3 * 3072, OUT_CFS = OUT_DS + (size_t)2 * 128 * 8 * 16384,
                 OUT_VS = OUT_CFS + 2 * 128 * 2 * 5504, OUT_END = OUT_VS + 2 * 128 * 4 * 1024;

constexpr size_t al256(size_t x) { return (x + 255) & ~(size_t)255; }
constexpr size_t W_WIN = 0, W_WA = W_WIN + (size_t)NV1 * 2048 * 2, W_WB = W_WA + (size_t)2048 * 1024 * 2, W_WC = W_WB + (size_t)2048 * 1024 * 2,
                 W_WO = W_WC + (size_t)2048 * 1024 * 2, W_WUP = W_WO + (size_t)2048 * 2048 * 2, W_WDN = W_WUP + (size_t)NV4 * 2048 * 2,
                 W_WPE = W_WDN + (size_t)2048 * DFF * 2, W_XRES = W_WPE + (size_t)2048 * 256 * 2, W_XB = W_XRES + (size_t)MT * DM * 4,
                 W_PRE = W_XB + (size_t)MT * DM * 2, W_PB = W_PRE + (size_t)MT * DM * 4, W_R = W_PB + (size_t)MT * DPLE * 2;
constexpr size_t W_CH = W_R, W_BG = W_CH + (size_t)MT * 1024 * 2, W_QKV = W_BG + (size_t)MT * 1024 * 2, W_Z = W_QKV + (size_t)MT * 3072 * 2,
                 W_GU = W_Z + (size_t)MT * 1024 * 2, W_GV = W_GU + (size_t)MT * 1024 * 2, W_GTS = W_GV + (size_t)MT * 1024 * 2,
                 W_BETA = W_GTS + (size_t)MT * 6144 * 2, W_GG = W_BETA + al256((size_t)MT * 8 * 4), W_YA = W_GG + al256((size_t)MT * 8 * 4),
                 W_YB = W_YA + (size_t)MT * 1024 * 2, W_YC = W_YB + (size_t)MT * 1024 * 2, W_QKVN = W_YC + (size_t)MT * 1024 * 2,
                 W_QKVNS = W_QKVN + (size_t)MT * 3072 * 2, W_VCN = W_QKVNS + (size_t)MS * 3072 * 4, W_DU = W_VCN + (size_t)MT * 1024 * 2,
                 W_DNW = W_DU + (size_t)1024 * 8192 * 4, W_DQD = W_DNW + (size_t)1024 * 8192 * 2, W_DKDT = W_DQD + (size_t)1024 * 8192 * 2,
                 W_DQK = W_DKDT + (size_t)1024 * 8192 * 2, W_DNW2 = W_DQK + (size_t)1024 * 4096 * 2, W_OB = W_DNW2 + (size_t)1024 * 8192 * 2,
                 W_DGL = W_OB + (size_t)MP * 1024 * 4, W_MG32 = W_DGL + 4096,
                 W_MGB = W_MG32 + (size_t)MT * DM * 4, W_REND = W_MGB + (size_t)MT * DM * 2;
constexpr size_t W_PE = W_R, W_HG = W_PE + (size_t)MT * DM * 4, W_HU = W_HG + (size_t)MT * DFF * 2, W_H = W_HU + (size_t)MT * DFF * 2,
                 W_FEND = W_H + (size_t)MT * DFF * 2;
constexpr size_t W_MG32C = W_VCN;
static_assert(W_MG32C + (size_t)MT * DM * 4 <= W_DKDT, "MG32C overlay");
constexpr size_t W_PART = W_VCN;
static_assert(W_PART >= W_FEND && W_PART + (size_t)16 * MS * DM * 4 <= W_OB, "partial buffer overlay");
constexpr size_t WS_NEED = W_REND > W_FEND ? W_REND : W_FEND;
constexpr size_t W_BAR = WS_NEED;
constexpr size_t WS_TOTAL = W_BAR + 16384;
static_assert(WS_TOTAL <= (size_t)1007681536, "workspace too large");

struct KP { const float* in[33]; float* out; unsigned char* ws; };
enum { I_XP = 0, I_XS, I_SCA, I_SCQ, I_SD, I_SCF, I_PP, I_PS, I_LNG, I_LNB, I_WIN, I_CAW, I_WAO, I_CBW, I_ALOG, I_DTB, I_NBG, I_WBO, I_LCG, I_LCB, I_WS, I_BS,
       I_WCO, I_WO, I_L1G, I_L1B, I_WUP, I_CFW, I_WDN, I_WPE, I_WPG, I_L2G, I_L2B };

__device__ __forceinline__ float bf2f(bf16_t h) { return __uint_as_float(((unsigned)h) << 16); }
__device__ __forceinline__ bf16_t f2bf(float f) { unsigned u = __float_as_uint(f); u += 0x7FFFu + ((u >> 16) & 1u); return (bf16_t)(u >> 16); }
typedef __bf16 bf16x2_t __attribute__((ext_vector_type(2)));
typedef float f32x2_t __attribute__((ext_vector_type(2)));
__device__ __forceinline__ unsigned pk2(float lo, float hi) { const bf16x2_t r = __builtin_convertvector((f32x2_t){lo, hi}, bf16x2_t); return __builtin_bit_cast(unsigned, r); }
__device__ __forceinline__ void split_bf(float x, bf16_t& hi, bf16_t& lo) { hi = f2bf(x); lo = f2bf(x - bf2f(hi)); }
__device__ __forceinline__ float lo16(unsigned w) { return __uint_as_float(w << 16); }
__device__ __forceinline__ float hi16(unsigned w) { return __uint_as_float(w & 0xffff0000u); }
__device__ __forceinline__ void unpack8(u32x4 w, float (&f)[8]) { f[0] = lo16(w.x); f[1] = hi16(w.x); f[2] = lo16(w.y); f[3] = hi16(w.y); f[4] = lo16(w.z); f[5] = hi16(w.z); f[6] = lo16(w.w); f[7] = hi16(w.w); }
__device__ __forceinline__ u32x4 pack8(const float (&f)[8]) { u32x4 w; w.x = pk2(f[0], f[1]); w.y = pk2(f[2], f[3]); w.z = pk2(f[4], f[5]); w.w = pk2(f[6], f[7]); return w; }
__device__ __forceinline__ float sigmoid_(float x) { return __builtin_amdgcn_rcpf(1.f + __expf(-x)); }
__device__ __forceinline__ float silu_(float x) { return x * __builtin_amdgcn_rcpf(1.f + __expf(-x)); }
__device__ __forceinline__ float gelu_(float x) { const float y = 1.5957691216f * (x + 0.044715f * x * x * x); return x * __builtin_amdgcn_rcpf(1.f + __expf(-y)); }
__device__ __forceinline__ float softplus_(float x) { return x > 20.f ? x : log1pf(__expf(x)); }
__device__ __forceinline__ float wave_sum(float v) {
#pragma unroll
    for (int o = 1; o < 64; o <<= 1) v += __shfl_xor(v, o);
    return v;
}

__device__ __forceinline__ int otid() { int t = (int)threadIdx.x; asm volatile("" : "+v"(t)); return t; }
__device__ __forceinline__ int obid() { int t = (int)blockIdx.x; asm volatile("" : "+s"(t)); return t; }
__device__ __forceinline__ unsigned char* ows(const unsigned char* p) { unsigned long long v = (unsigned long long)p; asm volatile("" : "+s"(v)); return (unsigned char*)(__attribute__((address_space(1))) unsigned char*)v; }
constexpr int BM = 256, BK = 64, HALF = 128, HTB = HALF * BK * 2, STAGE_BYTES = 8 * HTB, NXCD = 8, WGM = 8;
__device__ __forceinline__ int lds_byte(int r, int c) { const int st = (r >> 4) * 2 + (c >> 5), rr = r & 15, cc = c & 31, ob = rr * 64 + cc * 2; return st * 1024 + (ob ^ (((ob >> 9) & 1) << 5)); }
__device__ __forceinline__ void stage_rc(int b, int& R, int& C) { const int st = b / 1024, sb = b % 1024, swz = sb ^ (((sb >> 9) & 1) << 5); R = (st >> 1) * 16 + swz / 64; C = (st & 1) * 32 + (swz % 64) / 2; }
__device__ __forceinline__ int perm32(int rho) { const int n = rho >> 4, i = rho & 15; return 8 * (i >> 2) + 4 * n + (i & 3); }
struct Unit { int pm, pn, k0, nt, part; };
struct Gemm { const bf16_t* A; const bf16_t* Bt; int M, N, K; };
struct StaticOrder {
    int nM, nN, nwg, G, c, ntf, split;
    __device__ __forceinline__ void init(int M, int N, int K, int G_, int c_, int split_) { nM = M / BM; nN = N / BM; nwg = nM * nN; G = G_; c = c_; ntf = K / BK; split = split_; }
    __device__ __forceinline__ bool next(int i, Unit& u) const {
        u.k0 = 0; u.nt = ntf; u.part = -1;
        if (split) {
            if (i >= 2) return false;
            if (i == 0) { const int su = c >> 4, ks = c & 15, np = ntf >> 1, p0 = (np * ks) >> 4, p1 = (np * (ks + 1)) >> 4;
                u.pm = 32 + (su >> 3); u.pn = su & 7; u.k0 = 2 * p0; u.nt = 2 * (p1 - p0); u.part = ks; return true; }
        }
        const long L = split ? (long)c : (long)i * G + c; if (L >= nwg) return false;
        int wgid = (int)L; { const int q = nwg / NXCD, r = nwg % NXCD, xcd = wgid % NXCD, off = wgid / NXCD; wgid = (xcd < r ? xcd * (q + 1) : r * (q + 1) + (xcd - r) * q) + off; }
        const int nig = WGM * nN, gid = wgid / nig, fm = gid * WGM, gsz = (nM - fm) < WGM ? (nM - fm) : WGM;
        u.pm = fm + ((wgid % nig) % gsz); u.pn = (wgid % nig) / gsz; return true;
    }
};

enum { M_G1 = 0, M_G2A, M_G2B, M_G2C, M_G3, M_PE, M_G4, M_G5 };

__device__ __forceinline__ void st8bf(bf16_t* p, f32x4 a, f32x4 b) { u32x4 w; w.x = pk2(a[0], a[1]); w.y = pk2(a[2], a[3]); w.z = pk2(b[0], b[1]); w.w = pk2(b[2], b[3]); *(u32x4*)p = w; }
__device__ __forceinline__ void st8f(float* p, f32x4 a, f32x4 b) { *(f32x4*)p = a; *(f32x4*)(p + 4) = b; }
__device__ __forceinline__ bool tail_row(int r, int nk, int& seq, int& i, bool& smp) {
    if (r < MP) { seq = r >> 11; smp = false; i = (r & 2047) - (2048 - nk); return i >= 0; }
    const int rs = r - MP; seq = rs >> 2; smp = true; i = (rs & 3) - (4 - nk); return i >= 0;
}

__device__ __forceinline__ void epilogue(const KP& P, const int mode, const int l, const f32x4 (&acc)[2][2][4][2], const int pm, const int pn, const int part, const int wr, const int wc, const int fr_, const int fq_) {
    unsigned char* const ws = ows(P.ws); float* const out = (float*)ows((const unsigned char*)P.out);
    int fr = fr_, fq = fq_; asm volatile("" : "+v"(fr), "+v"(fq));
    const int rbase = pm * 256 + wr * 64 + fr, cl = wc * 32 + 8 * fq;
    if (mode == M_G1) {
        if (pn < 8) {
            bf16_t* ch = (bf16_t*)(ws + W_CH);
#pragma unroll
            for (int ai = 0; ai < 2; ++ai)
#pragma unroll
                for (int m = 0; m < 4; ++m) {
                    __builtin_amdgcn_sched_barrier(0); const int row = rbase + ai * 128 + m * 16, col = pn * 128 + cl;
                    const f32x4 a = acc[ai][0][m][0] * acc[ai][1][m][0], b = acc[ai][0][m][1] * acc[ai][1][m][1];
                    st8bf(ch + (unsigned)(row * 1024 + col), a, b);
                    int seq, i; bool smp;
                    if (tail_row(row, 2, seq, i, smp)) {
                        float* d = out + (smp ? OUT_CAS + ((size_t)(l * 128 + seq) * 2 + i) * 1024 : OUT_CAP + ((size_t)(l * 4 + seq) * 2 + i) * 1024) + col;
                        st8f(d, a, b);
                    }
                }
        } else if (pn == 60) {
            if (wc == 0 && fq < 2) {
                float* dst = (float*)(ws + (fq == 0 ? W_BETA : W_GG));
#pragma unroll
                for (int ai = 0; ai < 2; ++ai)
#pragma unroll
                    for (int m = 0; m < 4; ++m) {
                        __builtin_amdgcn_sched_barrier(0); const int row = rbase + ai * 128 + m * 16;
                        float v[8];
#pragma unroll
                        for (int j = 0; j < 4; ++j) { v[j] = acc[ai][0][m][0][j]; v[4 + j] = acc[ai][0][m][1][j]; }
#pragma unroll
                        for (int h = 0; h < 8; ++h) {
                            if (fq == 0) v[h] = sigmoid_(v[h]);
                            else v[h] = -__expf(P.in[I_ALOG][l * 8 + h]) * softplus_(v[h] + P.in[I_DTB][l * 8 + h]);
                        }
                        st8f(dst + (unsigned)(row * 8), (f32x4){v[0], v[1], v[2], v[3]}, (f32x4){v[4], v[5], v[6], v[7]});
                    }
            }
        } else {
            bf16_t* dstb; int ld, c0, act = 0; bool isq = false;
            if (pn < 12) { dstb = (bf16_t*)(ws + W_BG); ld = 1024; c0 = (pn - 8) * 256; }
            else if (pn < 24) { dstb = (bf16_t*)(ws + W_QKV); ld = 3072; c0 = (pn - 12) * 256; isq = true; }
            else if (pn < 28) { dstb = (bf16_t*)(ws + W_Z); ld = 1024; c0 = (pn - 24) * 256; }
            else if (pn < 32) { dstb = (bf16_t*)(ws + W_GU); ld = 1024; c0 = (pn - 28) * 256; act = 1; }
            else if (pn < 36) { dstb = (bf16_t*)(ws + W_GV); ld = 1024; c0 = (pn - 32) * 256; act = 1; }
            else { dstb = (bf16_t*)(ws + W_GTS); ld = 6144; c0 = (pn - 36) * 256; act = 2; }
#pragma unroll
            for (int ai = 0; ai < 2; ++ai)
#pragma unroll
                for (int m = 0; m < 4; ++m) {
                    __builtin_amdgcn_sched_barrier(0); const int row = rbase + ai * 128 + m * 16;
#pragma unroll
                    for (int bj = 0; bj < 2; ++bj) {
                        const int col = c0 + bj * 128 + cl;
                        f32x4 a = acc[ai][bj][m][0], b = acc[ai][bj][m][1];
                        if (act == 1) {
#pragma unroll
                            for (int j = 0; j < 4; ++j) { a[j] = gelu_(a[j]); b[j] = gelu_(b[j]); }
                        } else if (act == 2) {
#pragma unroll
                            for (int j = 0; j < 4; ++j) { a[j] = sigmoid_(a[j]); b[j] = sigmoid_(b[j]); }
                        }
                        st8bf(dstb + (unsigned)(row * ld + col), a, b);
                        if (isq) {
                            int seq, i; bool smp;
                            if (tail_row(row, 3, seq, i, smp)) {
                                float* d = out + (smp ? OUT_CQS + ((size_t)(l * 128 + seq) * 3 + i) * 3072 : OUT_CQP + ((size_t)(l * 4 + seq) * 3 + i) * 3072) + col;
                                st8f(d, a, b);
                            }
                        }
                    }
                }
        }
    } else if (mode == M_G2A || mode == M_G2B || mode == M_G2C) {
        const int which = mode - M_G2A;
        float* mg = (float*)(ws + W_MG32); const bf16_t* gts = (const bf16_t*)(ws + W_GTS); bf16_t* mgb = (bf16_t*)(ws + W_MGB);
#pragma unroll
        for (int ai = 0; ai < 2; ++ai)
#pragma unroll
            for (int m = 0; m < 4; ++m) {
                __builtin_amdgcn_sched_barrier(0); const int row = rbase + ai * 128 + m * 16;
#pragma unroll
                for (int bj = 0; bj < 2; ++bj) {
                    const int col = pn * 256 + bj * 128 + cl;
                    float g[8]; unpack8(*(const u32x4*)(gts + (unsigned)(row * 6144 + which * 2048 + col)), g);
                    f32x4 a = acc[ai][bj][m][0], b = acc[ai][bj][m][1];
#pragma unroll
                    for (int j = 0; j < 4; ++j) { a[j] *= g[j]; b[j] *= g[4 + j]; }
                    const unsigned mo = (unsigned)(row * DM + col);
                    if (which == 0) st8f(mg + mo, a, b);
                    else if (which == 2) st8f((float*)(ws + W_MG32C) + mo, a, b);
                    else { const float* mc = (const float*)(ws + W_MG32C) + mo;
                        a += *(const f32x4*)(mg + mo) + *(const f32x4*)mc; b += *(const f32x4*)(mg + mo + 4) + *(const f32x4*)(mc + 4);
                        st8bf(mgb + mo, a, b); }
                }
            }
    } else if (mode == M_G3 || mode == M_G5 || mode == M_PE) {
        const float* xr = (const float*)(ws + W_XRES); const float* pe = (const float*)(ws + W_PE);
        float* dst = (float*)(ws + (mode == M_PE ? W_PE : W_PRE));
#pragma unroll
        for (int ai = 0; ai < 2; ++ai)
#pragma unroll
            for (int m = 0; m < 4; ++m) {
                __builtin_amdgcn_sched_barrier(0); const int row = rbase + ai * 128 + m * 16;
#pragma unroll
                for (int bj = 0; bj < 2; ++bj) {
                    const unsigned o = (unsigned)(row * DM + pn * 256 + bj * 128 + cl);
                    f32x4 a = acc[ai][bj][m][0], b = acc[ai][bj][m][1];
                    if (part <= 0) {
                        if (mode == M_G3) { a += ALPHA * *(const f32x4*)(xr + o); b += ALPHA * *(const f32x4*)(xr + o + 4); }
                        if (mode == M_G5) { a += *(const f32x4*)(pe + o); b += *(const f32x4*)(pe + o + 4); }
                    }
                    if (part < 0) st8f(dst + o, a, b);
                    else st8f((float*)(ws + W_PART) + (unsigned)(part * (MS * DM)) + (o - (unsigned)(MP * DM)), a, b);
                }
            }
    } else {
        if (pn < 43) {
            bf16_t* hg = (bf16_t*)(ws + W_HG); bf16_t* hu = (bf16_t*)(ws + W_HU);
#pragma unroll
            for (int ai = 0; ai < 2; ++ai)
#pragma unroll
                for (int m = 0; m < 4; ++m) {
                    __builtin_amdgcn_sched_barrier(0); const int row = rbase + ai * 128 + m * 16;
#pragma unroll
                    for (int bj = 0; bj < 2; ++bj) {
                        const int c = pn * 256 + bj * 128 + cl;
                        const f32x4 a = acc[ai][bj][m][0], b = acc[ai][bj][m][1];
                        if (c < DFF) {
                            st8bf(hg + (unsigned)(row * DFF + c), a, b);
                            int seq, i; bool smp;
                            if (tail_row(row, 2, seq, i, smp)) {
                                float* d = out + (smp ? OUT_CFS + ((size_t)(l * 128 + seq) * 2 + i) * DFF : OUT_CFP + ((size_t)(l * 4 + seq) * 2 + i) * DFF) + c;
                                st8f(d, a, b);
                            }
                        } else st8bf(hu + (unsigned)(row * DFF + (c - DFF)), a, b);
                    }
                }
        } else {
            float* pe = (float*)(ws + W_PE);
#pragma unroll
            for (int ai = 0; ai < 2; ++ai)
#pragma unroll
                for (int m = 0; m < 4; ++m) {
                    __builtin_amdgcn_sched_barrier(0); const int row = rbase + ai * 128 + m * 16;
#pragma unroll
                    for (int bj = 0; bj < 2; ++bj) {
                        float* p = pe + (unsigned)(row * DM + (pn - 43) * 256 + bj * 128 + cl);
                        f32x4 a = acc[ai][bj][m][0], b = acc[ai][bj][m][1];
                        const f32x4 pa = *(const f32x4*)p, pb = *(const f32x4*)(p + 4);
                        const float* xq = (const float*)(ws + W_XRES) + (unsigned)(row * DM + (pn - 43) * 256 + bj * 128 + cl);
                        const f32x4 xa = *(const f32x4*)xq, xb4 = *(const f32x4*)(xq + 4);
#pragma unroll
                        for (int j = 0; j < 4; ++j) { a[j] = sigmoid_(a[j]) * pa[j] + ALPHA * xa[j]; b[j] = sigmoid_(b[j]) * pb[j] + ALPHA * xb4[j]; }
                        st8f(p, a, b);
                    }
                }
        }
    }
}

__device__ __forceinline__ void gemm_phase(LAS unsigned char* lds, const Gemm g, const StaticOrder& S, const KP& P, const int mode, const int layer) {
    const int tidx_ = otid(), bidx_ = obid(); (void)tidx_; (void)bidx_;
    const int tid = tidx_, wid = __builtin_amdgcn_readfirstlane(tid >> 6), lane = tid & 63, wr = wid >> 2, wc = wid & 3, fr = lane & 15, fq = lane >> 4;
    const int K = g.K;
    unsigned voffA[2], voffB[2];
#pragma unroll
    for (int i = 0; i < 2; ++i) { int R, C; stage_rc(tid * 16 + i * 8192, R, C); const int Rb = (R & ~31) + perm32(R & 31);
        voffA[i] = (unsigned)(R * K + C) * 2u; voffB[i] = (unsigned)(Rb * K + C) * 2u; }
    const size_t kstep = (size_t)(BK * 2);
    const size_t hstep = (size_t)HALF * K * 2;
    const size_t tstep = 2 * hstep;
    const unsigned ldsw = (unsigned)wid * 1024u;
    const int aoff = lds_byte(wr * 64 + fr, fq * 8), boff = lds_byte(wc * 32 + fr, fq * 8);
#define PG8_SA(b, h) (((b) * 2 + (h)) * HTB)
#define PG8_SB(b, h) ((4 + (b) * 2 + (h)) * HTB)
#define PG8_STAGE(bufoff, gbase, voff) do { _Pragma("unroll") for (int _i = 0; _i < 2; ++_i) \
        __builtin_amdgcn_global_load_lds((const unsigned*)((const char*)(gbase) + (voff)[_i]), (LAS unsigned*)(lds + (bufoff) + ldsw + _i * 8192), 16, 0, 0); } while (0)
#define PG8_LDA(dst, b, h) do { _Pragma("unroll") for (int m = 0; m < 4; ++m) _Pragma("unroll") for (int k = 0; k < 2; ++k) dst[m][k] = *(const LAS bf16x8*)(lds + PG8_SA(b, h) + aoff + m * 2048 + k * 1024); } while (0)
#define PG8_LDB(dst, b, h) do { _Pragma("unroll") for (int n = 0; n < 2; ++n) _Pragma("unroll") for (int k = 0; k < 2; ++k) dst[n][k] = *(const LAS bf16x8*)(lds + PG8_SB(b, h) + boff + n * 2048 + k * 1024); } while (0)
#define PG8_MMA(ai, bj, At, Bt) do { __builtin_amdgcn_s_setprio(1); _Pragma("unroll") for (int m = 0; m < 4; ++m) _Pragma("unroll") for (int n = 0; n < 2; ++n) _Pragma("unroll") for (int k = 0; k < 2; ++k) \
        acc[ai][bj][m][n] = __builtin_amdgcn_mfma_f32_16x16x32_bf16(Bt[n][k], At[m][k], acc[ai][bj][m][n], 0, 0, 0); __builtin_amdgcn_s_setprio(0); } while (0)
#define PG8_WAIT_V(n) asm volatile("s_waitcnt vmcnt(" #n ")" ::: "memory")
#define PG8_WAIT_L(n) asm volatile("s_waitcnt lgkmcnt(" #n ")" ::: "memory")
#define PG8_BAR __builtin_amdgcn_s_barrier()
#define PG8_SCHED __builtin_amdgcn_sched_barrier(0)
    Unit cur, nxt; int ui = 0;
    if (!S.next(0, cur)) return;
    f32x4 acc[2][2][4][2];
#pragma unroll
    for (int a = 0; a < 2; ++a)
#pragma unroll
        for (int b = 0; b < 2; ++b)
#pragma unroll
            for (int m = 0; m < 4; ++m)
#pragma unroll
                for (int n = 0; n < 2; ++n) acc[a][b][m][n] = (f32x4){0.f, 0.f, 0.f, 0.f};
    bf16x8 At[4][2], B0[2][2], B1[2][2];
    const char* cA = (const char*)g.A + (size_t)cur.pm * tstep + (size_t)cur.k0 * kstep; const char* cB = (const char*)g.Bt + (size_t)cur.pn * tstep + (size_t)cur.k0 * kstep;
    PG8_STAGE(PG8_SB(0, 0), cB, voffB); PG8_STAGE(PG8_SB(0, 1), cB + hstep, voffB); PG8_STAGE(PG8_SA(0, 0), cA, voffA); PG8_STAGE(PG8_SA(0, 1), cA + hstep, voffA);
    if (wr == 1) PG8_BAR;
    PG8_WAIT_V(2); PG8_BAR;
    PG8_STAGE(PG8_SB(1, 0), cB + kstep, voffB); PG8_STAGE(PG8_SA(1, 0), cA + kstep, voffA); PG8_STAGE(PG8_SB(1, 1), cB + hstep + kstep, voffB);
    PG8_WAIT_V(6); PG8_BAR;
    for (;;) {
        const bool has_next = S.next(ui + 1, nxt);
        const char* nA = has_next ? (const char*)g.A + (size_t)nxt.pm * tstep + (size_t)nxt.k0 * kstep : cA; const char* nB = has_next ? (const char*)g.Bt + (size_t)nxt.pn * tstep + (size_t)nxt.k0 * kstep : cB;
        const int nt = cur.nt;
        for (int t = 0; t < nt; t += 2) {
            const bool last = (t == nt - 2);
            const char* a1 = cA + (size_t)(t + 1) * kstep;
            const char* a2 = last ? nA : cA + (size_t)(t + 2) * kstep; const char* b2 = last ? nB : cB + (size_t)(t + 2) * kstep;
            const char* a3 = a2 + kstep; const char* b3 = b2 + kstep;
            PG8_LDB(B0, 0, 0); PG8_LDB(B1, 0, 1); PG8_SCHED; PG8_LDA(At, 0, 0); PG8_STAGE(PG8_SA(1, 1), a1 + hstep, voffA);
            PG8_WAIT_V(8); PG8_WAIT_L(0); PG8_BAR; PG8_MMA(0, 0, At, B0); PG8_MMA(0, 1, At, B1); PG8_BAR; PG8_SCHED;
            PG8_LDA(At, 0, 1); PG8_STAGE(PG8_SB(0, 0), b2, voffB); PG8_STAGE(PG8_SB(0, 1), b2 + hstep, voffB); PG8_STAGE(PG8_SA(0, 0), a2, voffA);
            PG8_WAIT_V(8); PG8_WAIT_L(0); PG8_BAR; PG8_MMA(1, 0, At, B0); PG8_MMA(1, 1, At, B1); PG8_BAR; PG8_SCHED;
            PG8_LDB(B0, 1, 0); PG8_LDB(B1, 1, 1); PG8_SCHED; PG8_LDA(At, 1, 0); PG8_STAGE(PG8_SA(0, 1), a2 + hstep, voffA);
            PG8_WAIT_V(8); PG8_WAIT_L(0); PG8_BAR; PG8_MMA(0, 0, At, B0); PG8_MMA(0, 1, At, B1); PG8_BAR; PG8_SCHED;
            PG8_LDA(At, 1, 1); PG8_STAGE(PG8_SB(1, 0), b3, voffB); PG8_STAGE(PG8_SB(1, 1), b3 + hstep, voffB); PG8_STAGE(PG8_SA(1, 0), a3, voffA);
            PG8_WAIT_V(8); PG8_WAIT_L(0); PG8_BAR; PG8_MMA(1, 0, At, B0); PG8_MMA(1, 1, At, B1); PG8_BAR; PG8_SCHED;
        }
        if (wr == 0) PG8_BAR;
        epilogue(P, mode, layer, acc, cur.pm, cur.pn, cur.part, wr, wc, fr, fq);
        if (!has_next) break;
#pragma unroll
        for (int a = 0; a < 2; ++a)
#pragma unroll
            for (int b = 0; b < 2; ++b)
#pragma unroll
                for (int m = 0; m < 4; ++m)
#pragma unroll
                    for (int n = 0; n < 2; ++n) acc[a][b][m][n] = (f32x4){0.f, 0.f, 0.f, 0.f};
        cur = nxt; cA = nA; cB = nB; ++ui;
        if (wr == 1) PG8_BAR;
    }
    PG8_WAIT_V(0);
    PG8_BAR;
#undef PG8_SA
#undef PG8_SB
#undef PG8_STAGE
#undef PG8_LDA
#undef PG8_LDB
#undef PG8_MMA
#undef PG8_WAIT_V
#undef PG8_WAIT_L
#undef PG8_BAR
#undef PG8_SCHED
}

__device__ __forceinline__ void tr_tile_w(const float* src, const int ldsrc, const int scol0, const int nvalid, const int k0, bf16_t* dst, const int K, const int drow0, float* scr, const int lane) {
    const int kk = lane >> 3, c4 = (lane & 7) * 4;
    f32x4 v[8];
#pragma unroll
    for (int p = 0; p < 8; ++p) { v[p] = (f32x4){0.f, 0.f, 0.f, 0.f}; if (c4 < nvalid) v[p] = __builtin_nontemporal_load((const f32x4*)(src + (size_t)(k0 + kk + 8 * p) * ldsrc + scol0 + c4)); }
#pragma unroll
    for (int p = 0; p < 8; ++p) {
        scr[(c4 + 0) * 65 + kk + 8 * p] = v[p][0]; scr[(c4 + 1) * 65 + kk + 8 * p] = v[p][1]; scr[(c4 + 2) * 65 + kk + 8 * p] = v[p][2]; scr[(c4 + 3) * 65 + kk + 8 * p] = v[p][3];
    }
    __builtin_amdgcn_wave_barrier();
#pragma unroll
    for (int q = 0; q < 4; ++q) {
        const int id = lane + 64 * q, n = id >> 3, c = id & 7; const float* sp = scr + n * 65 + 8 * c;
        u32x4 o; o.x = pk2(sp[0], sp[1]); o.y = pk2(sp[2], sp[3]); o.z = pk2(sp[4], sp[5]); o.w = pk2(sp[6], sp[7]);
        *(u32x4*)(dst + (size_t)(drow0 + n) * K + k0 + 8 * c) = o;
    }
    __builtin_amdgcn_wave_barrier();
}
__device__ __forceinline__ void convert_weights(const KP& P, const int l, float* scr0, const int part, const int wb0, const int nwb) {
    const int tidx_ = otid(), bidx_ = obid(); (void)tidx_; (void)bidx_;
    unsigned char* ws = ows(P.ws);
    const int lane = tidx_ & 63, wv = tidx_ >> 6, gw = (bidx_ - wb0) * 8 + wv, ngw = nwb * 8;
    float* scr = scr0 + wv * (32 * 65);
    constexpr int T_WIN = (NV1 / 32) * 32, T_W1 = 64 * 16, T_WO = 64 * 32, T_WUP = (2 * DFF / 32) * 32, T_WPG = 64 * 32, T_WDN = 64 * (DFF / 64), T_WPE = 64 * 4;
    constexpr int T_ALL = T_WIN + 3 * T_W1 + T_WO + T_WUP + T_WPG + T_WDN + T_WPE;
    constexpr int T_A = T_WIN + 3 * T_W1 + T_WO, T_LATE = T_WUP + T_WPG;
    const int njobs = part ? T_LATE : T_ALL - T_LATE;
    for (int jt = gw; jt < njobs; jt += ngw) {
        const int it = part ? T_A + jt : (jt < T_A ? jt : jt + T_LATE);
        int r = it;
        if (r < T_WIN) {
            const int nj = r >> 5, kj = r & 31, nv0 = nj * 32; int sc, nv = 32;
            if (nv0 < 2048) { const int t = nv0 >> 8, hf = (nv0 >> 7) & 1, i = nv0 & 127; sc = (hf ? 2048 : 0) + 128 * t + i; }
            else if (nv0 < 3072) sc = nv0 - 1024;
            else if (nv0 < 7168) sc = nv0;
            else if (nv0 < 15360) sc = nv0 + 16;
            else if (nv0 == 15360) { sc = 7168; nv = 16; }
            else { sc = 0; nv = 0; }
            tr_tile_w(P.in[I_WIN] + (size_t)l * 2048 * NIN, NIN, sc, nv, kj * 64, (bf16_t*)(ws + W_WIN), 2048, nv0, scr, lane); continue;
        }
        r -= T_WIN;
        if (r < 3 * T_W1) {
            const int w = r / T_W1, rr = r % T_W1, nj = rr >> 4, kj = rr & 15;
            const float* src = (w == 0 ? P.in[I_WAO] : (w == 1 ? P.in[I_WBO] : P.in[I_WCO])) + (size_t)l * 1024 * 2048;
            bf16_t* dst = (bf16_t*)(ws + (w == 0 ? W_WA : (w == 1 ? W_WB : W_WC)));
            tr_tile_w(src, 2048, nj * 32, 32, kj * 64, dst, 1024, nj * 32, scr, lane); continue;
        }
        r -= 3 * T_W1;
        if (r < T_WO) { const int nj = r >> 5, kj = r & 31; tr_tile_w(P.in[I_WO] + (size_t)l * 2048 * 2048, 2048, nj * 32, 32, kj * 64, (bf16_t*)(ws + W_WO), 2048, nj * 32, scr, lane); continue; }
        r -= T_WO;
        if (r < T_WUP) { const int nj = r >> 5, kj = r & 31; tr_tile_w(P.in[I_WUP] + (size_t)l * 2048 * 2 * DFF, 2 * DFF, nj * 32, 32, kj * 64, (bf16_t*)(ws + W_WUP), 2048, nj * 32, scr, lane); continue; }
        r -= T_WUP;
        if (r < T_WPG) { const int nj = r >> 5, kj = r & 31; tr_tile_w(P.in[I_WPG] + (size_t)l * 2048 * 2048, 2048, nj * 32, 32, kj * 64, (bf16_t*)(ws + W_WUP), 2048, 2 * DFF + nj * 32, scr, lane); continue; }
        r -= T_WPG;
        if (r < T_WDN) { const int nj = r / (DFF / 64), kj = r % (DFF / 64); tr_tile_w(P.in[I_WDN] + (size_t)l * DFF * 2048, 2048, nj * 32, 32, kj * 64, (bf16_t*)(ws + W_WDN), DFF, nj * 32, scr, lane); continue; }
        r -= T_WDN;
        { const int nj = r >> 2, kj = r & 3; tr_tile_w(P.in[I_WPE] + (size_t)l * 256 * 2048, 2048, nj * 32, 32, kj * 64, (bf16_t*)(ws + W_WPE), 256, nj * 32, scr, lane); }
    }
    bf16_t* pb = (bf16_t*)(ws + W_PB);
    if (part == 0) for (int i = bidx_ * 512 + tidx_; i < MT * 32; i += gridDim.x * 512) {
        const int r = i >> 5, c8 = (i & 31) * 8;
        const float* s = (r < MP ? P.in[I_PP] + ((size_t)l * MP + r) * 256 : P.in[I_PS] + ((size_t)l * MS + (r - MP)) * 256) + c8;
        const f32x4 a = *(const f32x4*)s, b = *(const f32x4*)(s + 4);
        st8bf(pb + (size_t)r * 256 + c8, a, b);
    }
}

__device__ __forceinline__ void ln_rows(const KP& P, const int srcsel  , const float* g, const float* b, const bool to_out) {
    const int tidx_ = otid(), bidx_ = obid(); (void)tidx_; (void)bidx_;
    unsigned char* ws = ows(P.ws);
    const int lane = tidx_ & 63, gw = bidx_ * 8 + (tidx_ >> 6), ngw = gridDim.x * 8;
    f32x4 gv[8], bv[8];
#pragma unroll
    for (int j = 0; j < 8; ++j) { gv[j] = *(const f32x4*)(g + j * 256 + lane * 4); bv[j] = *(const f32x4*)(b + j * 256 + lane * 4); }
    for (int r = gw; r < MT; r += ngw) {
        const float* src = srcsel ? (const float*)(ws + W_PRE) + (size_t)r * DM : (r < MP ? P.in[I_XP] + (size_t)r * DM : P.in[I_XS] + (size_t)(r - MP) * DM);
        f32x4 v[8]; float s = 0.f;
        if (srcsel && r >= MP && gridDim.x == 256) {
            const float* pp = (const float*)(ws + W_PART) + (size_t)(r - MP) * DM + lane * 4;
#pragma unroll
            for (int j = 0; j < 8; ++j) v[j] = __builtin_nontemporal_load((const f32x4*)(pp + j * 256));
#pragma unroll 3
            for (int ks = 1; ks < 16; ++ks)
#pragma unroll
                for (int j = 0; j < 8; ++j) v[j] += __builtin_nontemporal_load((const f32x4*)(pp + (size_t)ks * (MS * DM) + j * 256));
#pragma unroll
            for (int j = 0; j < 8; ++j) s += (v[j][0] + v[j][1]) + (v[j][2] + v[j][3]);
        } else {
#pragma unroll
            for (int j = 0; j < 8; ++j) { v[j] = __builtin_nontemporal_load((const f32x4*)(src + j * 256 + lane * 4)); s += (v[j][0] + v[j][1]) + (v[j][2] + v[j][3]); }
        }
        const float mean = wave_sum(s) * (1.f / DM); float s2 = 0.f;
#pragma unroll
        for (int j = 0; j < 8; ++j) { v[j] = v[j] - mean; s2 += (v[j][0] * v[j][0] + v[j][1] * v[j][1]) + (v[j][2] * v[j][2] + v[j][3] * v[j][3]); }
        const float rstd = rsqrtf(wave_sum(s2) * (1.f / DM) + LN_EPS);
        float* d32 = to_out ? P.out + (size_t)r * DM : (float*)(ws + W_XRES) + (size_t)r * DM;
        bf16_t* db = (bf16_t*)(ws + W_XB) + (size_t)r * DM;
#pragma unroll
        for (int j = 0; j < 8; ++j) {
            const f32x4 y = v[j] * rstd * gv[j] + bv[j];
            if (to_out) __builtin_nontemporal_store(y, (f32x4*)(d32 + j * 256 + lane * 4)); else *(f32x4*)(d32 + j * 256 + lane * 4) = y;
            if (!to_out) { u32x2 w; w.x = pk2(y[0], y[1]); w.y = pk2(y[2], y[3]); *(u32x2*)(db + j * 256 + lane * 4) = w; }
        }
    }
}

__device__ __forceinline__ void phase_e(const KP& P, const int l) {
    const int tidx_ = otid(), bidx_ = obid(); (void)tidx_; (void)bidx_;
    unsigned char* ws = ows(P.ws);
    {
        const bf16_t* ch = (const bf16_t*)(ws + W_CH); const bf16_t* bg = (const bf16_t*)(ws + W_BG); bf16_t* ya = (bf16_t*)(ws + W_YA);
        const float* cw = P.in[I_CAW] + (size_t)l * 3 * 1024; const float* hist = P.in[I_SCA] + (size_t)l * 128 * 2 * 1024;
        for (int i = bidx_ * 512 + tidx_; i < (MT / 4) * 128; i += gridDim.x * 512) {
            const int q = i >> 7, c8 = (i & 127) * 8, r0 = 4 * q;
            const bool smp = r0 >= MP; const int t0 = smp ? 0 : (r0 & 2047), sb = (r0 - MP) >> 2;
            float x[6][8];
#pragma unroll
            for (int d = 0; d < 2; ++d) {
                if (t0 > 0) unpack8(*(const u32x4*)(ch + (size_t)(r0 - 2 + d) * 1024 + c8), x[d]);
                else if (smp) { const float* h = hist + ((size_t)sb * 2 + d) * 1024 + c8; const f32x4 h0 = *(const f32x4*)h, h1 = *(const f32x4*)(h + 4);
#pragma unroll
                    for (int j = 0; j < 4; ++j) { x[d][j] = h0[j]; x[d][4 + j] = h1[j]; } }
                else {
#pragma unroll
                    for (int j = 0; j < 8; ++j) x[d][j] = 0.f; }
            }
#pragma unroll
            for (int d = 0; d < 4; ++d) unpack8(*(const u32x4*)(ch + (size_t)(r0 + d) * 1024 + c8), x[2 + d]);
            float w[3][8];
#pragma unroll
            for (int d = 0; d < 3; ++d) { const f32x4 w0 = *(const f32x4*)(cw + d * 1024 + c8), w1 = *(const f32x4*)(cw + d * 1024 + c8 + 4);
#pragma unroll
                for (int j = 0; j < 4; ++j) { w[d][j] = w0[j]; w[d][4 + j] = w1[j]; } }
#pragma unroll
            for (int d = 0; d < 4; ++d) {
                float g[8], a[8]; unpack8(*(const u32x4*)(bg + (size_t)(r0 + d) * 1024 + c8), g);
#pragma unroll
                for (int j = 0; j < 8; ++j) a[j] = g[j] * (w[0][j] * x[d][j] + w[1][j] * x[d + 1][j] + w[2][j] * x[d + 2][j]);
                *(u32x4*)(ya + (size_t)(r0 + d) * 1024 + c8) = pack8(a);
            }
        }
    }
    const int lane = tidx_ & 63, gw = bidx_ * 8 + (tidx_ >> 6), ngw = gridDim.x * 8;
    {
        const bf16_t* qkv = (const bf16_t*)(ws + W_QKV); bf16_t* qn = (bf16_t*)(ws + W_QKVN); float* qns = (float*)(ws + W_QKVNS);
        const float* cw = P.in[I_CBW] + (size_t)l * 4 * 3072; const float* hist = P.in[I_SCQ] + (size_t)l * 128 * 3 * 3072;
        for (int it = gw; it < (MT / 4) * 6; it += ngw) {
            const int q = it / 6, s4 = it % 6, c = s4 * 512 + lane * 8, r0 = 4 * q;
            const bool smp = r0 >= MP; const int t0 = smp ? 0 : (r0 & 2047), sb = (r0 - MP) >> 2;
            float x[7][8];
#pragma unroll
            for (int d = 0; d < 3; ++d) {
                if (t0 > 0) unpack8(*(const u32x4*)(qkv + (size_t)(r0 - 3 + d) * 3072 + c), x[d]);
                else if (smp) { const float* hp = hist + ((size_t)sb * 3 + d) * 3072 + c; const f32x4 h0 = *(const f32x4*)hp, h1 = *(const f32x4*)(hp + 4);
#pragma unroll
                    for (int j = 0; j < 4; ++j) { x[d][j] = h0[j]; x[d][4 + j] = h1[j]; } }
                else {
#pragma unroll
                    for (int j = 0; j < 8; ++j) x[d][j] = 0.f; }
            }
#pragma unroll
            for (int d = 0; d < 4; ++d) unpack8(*(const u32x4*)(qkv + (size_t)(r0 + d) * 3072 + c), x[3 + d]);
            float w[4][8];
#pragma unroll
            for (int d = 0; d < 4; ++d) { const f32x4 w0 = *(const f32x4*)(cw + d * 3072 + c), w1 = *(const f32x4*)(cw + d * 3072 + c + 4);
#pragma unroll
                for (int j = 0; j < 4; ++j) { w[d][j] = w0[j]; w[d][4 + j] = w1[j]; } }
#pragma unroll
            for (int d = 0; d < 4; ++d) {
                float a[8]; float ss = 0.f;
#pragma unroll
                for (int j = 0; j < 8; ++j) { a[j] = silu_(w[0][j] * x[d][j] + w[1][j] * x[d + 1][j] + w[2][j] * x[d + 2][j] + w[3][j] * x[d + 3][j]); ss += a[j] * a[j]; }
                if (s4 < 4) {
                    ss += __shfl_xor(ss, 1); ss += __shfl_xor(ss, 2); ss += __shfl_xor(ss, 4); ss += __shfl_xor(ss, 8);
                    const float sc = rsqrtf(ss + RMS_EPS) * (s4 < 2 ? 0.08838834764831845f : 1.f);
#pragma unroll
                    for (int j = 0; j < 8; ++j) a[j] *= sc;
                }
                *(u32x4*)(qn + (size_t)(r0 + d) * 3072 + c) = pack8(a);
                if (smp) st8f(qns + (size_t)(r0 + d - MP) * 3072 + c, (f32x4){a[0], a[1], a[2], a[3]}, (f32x4){a[4], a[5], a[6], a[7]});
            }
        }
    }
    {
        const bf16_t* gv = (const bf16_t*)(ws + W_GV); bf16_t* vcn = (bf16_t*)(ws + W_VCN);
        const float* lg = P.in[I_LCG] + (size_t)l * 1024; const float* lb = P.in[I_LCB] + (size_t)l * 1024;
        for (int r = gw; r < MT; r += ngw) {
            float x[2][8]; float s = 0.f;
#pragma unroll
            for (int j = 0; j < 2; ++j) { unpack8(*(const u32x4*)(gv + (size_t)r * 1024 + j * 512 + lane * 8), x[j]);
#pragma unroll
                for (int e = 0; e < 8; ++e) s += x[j][e]; }
            const float mean = wave_sum(s) * (1.f / 1024.f); float s2 = 0.f;
#pragma unroll
            for (int j = 0; j < 2; ++j)
#pragma unroll
                for (int e = 0; e < 8; ++e) { x[j][e] -= mean; s2 += x[j][e] * x[j][e]; }
            const float rstd = rsqrtf(wave_sum(s2) * (1.f / 1024.f) + LN_EPS);
#pragma unroll
            for (int j = 0; j < 2; ++j) {
                const int c = j * 512 + lane * 8;
#pragma unroll
                for (int e = 0; e < 8; ++e) x[j][e] = x[j][e] * rstd * lg[c + e] + lb[c + e];
                *(u32x4*)(vcn + (size_t)r * 1024 + c) = pack8(x[j]);
                if (r >= MP) { float* d = P.out + OUT_VS + ((size_t)l * MS + (r - MP)) * 1024 + c;
                    st8f(d, (f32x4){x[j][0], x[j][1], x[j][2], x[j][3]}, (f32x4){x[j][4], x[j][5], x[j][6], x[j][7]}); }
            }
        }
    }
}

__device__ __forceinline__ void beta_gate(const KP& P, const int l) {
    const int tidx_ = otid(), bidx_ = obid(); (void)tidx_; (void)bidx_;
    unsigned char* ws = ows(P.ws);
    const int lane = tidx_ & 63, lr = lane & 15, lq = lane >> 4, gw = bidx_ * 8 + (tidx_ >> 6), ngw = gridDim.x * 8;
    const bf16_t* xb = (const bf16_t*)(ws + W_XB); const bf16_t* wt = (const bf16_t*)(ws + W_WIN) + (size_t)15360 * 2048;
    float* betab = (float*)(ws + W_BETA); float* ggb = (float*)(ws + W_GG);
    for (int it = gw; it < MT / 16; it += ngw) {
        const bf16_t* ap = xb + (size_t)(16 * it + lr) * 2048 + lq * 8; const bf16_t* bp = wt + (size_t)lr * 2048 + lq * 8;
        f32x4 acc0 = {0.f, 0.f, 0.f, 0.f}, acc1 = {0.f, 0.f, 0.f, 0.f};
#pragma unroll 8
        for (int ks = 0; ks < 64; ks += 2) {
            acc0 = __builtin_amdgcn_mfma_f32_16x16x32_bf16(*(const bf16x8*)(ap + ks * 32), *(const bf16x8*)(bp + ks * 32), acc0, 0, 0, 0);
            acc1 = __builtin_amdgcn_mfma_f32_16x16x32_bf16(*(const bf16x8*)(ap + ks * 32 + 32), *(const bf16x8*)(bp + ks * 32 + 32), acc1, 0, 0, 0);
        }
        const int h = lr & 7; const float al = -__expf(P.in[I_ALOG][l * 8 + h]), dtb = P.in[I_DTB][l * 8 + h];
#pragma unroll
        for (int j = 0; j < 4; ++j) {
            const float v = acc0[j] + acc1[j]; const int row = 16 * it + 4 * lq + j;
            if (lr < 8) betab[row * 8 + h] = sigmoid_(v); else ggb[row * 8 + h] = al * softplus_(v + dtb);
        }
    }
}
__device__ __forceinline__ void d1_prep(const KP& P, const int l, float* shm) {
    const int tidx_ = otid(), bidx_ = obid(); (void)tidx_; (void)bidx_;
    unsigned char* ws = ows(P.ws);
    const int tid = tidx_, w = tid >> 6, lane = tid & 63, lr = lane & 15, lq = lane >> 4;
    float* Am = shm;
    float* gc = Am + 64 * 68;
    float* bt = gc + 64;
    float* X = shm + 8192;
    const bf16_t* qn = (const bf16_t*)(ws + W_QKVN);
    const float* betab = (const float*)(ws + W_BETA); const float* ggb = (const float*)(ws + W_GG);
    float* DU = (float*)(ws + W_DU); bf16_t* DNW = (bf16_t*)(ws + W_DNW); bf16_t* DQD = (bf16_t*)(ws + W_DQD); bf16_t* DKDT = (bf16_t*)(ws + W_DKDT);
    bf16_t* DQK = (bf16_t*)(ws + W_DQK); float* DGL = (float*)(ws + W_DGL);
    for (int T = bidx_; T < 1024; T += gridDim.x) {
        const int chain = T >> 5, n = T & 31, b = chain >> 3, h = chain & 7, r0 = b * 2048 + n * 64;
        const bf16_t* qp = qn + (size_t)r0 * 3072 + h * 128; const bf16_t* kp = qp + 1024; const bf16_t* vp = qp + 2048;
        bf16x8 ak[4], aq[4];
        { const int rt_ = w & 3;
#pragma unroll
            for (int ks = 0; ks < 4; ++ks) { ak[ks] = *(const bf16x8*)(kp + (size_t)(16 * rt_ + lr) * 3072 + ks * 32 + lq * 8); aq[ks] = *(const bf16x8*)(qp + (size_t)(16 * rt_ + lr) * 3072 + ks * 32 + lq * 8); } }
        asm volatile("" ::: "memory");
        if (w == 0) {
            float v = ggb[(size_t)(r0 + lane) * 8 + h];
#pragma unroll
            for (int o = 1; o < 64; o <<= 1) { const float t = __shfl_up(v, o); if (lane >= o) v += t; }
            gc[lane] = v; bt[lane] = betab[(size_t)(r0 + lane) * 8 + h];
        }
        __syncthreads();
        {
            const int rt = w & 3;
#pragma unroll
            for (int c2 = 0; c2 < 2; ++c2) {
                const int nt = 2 * (w >> 2) + c2;
                f32x4 ckk = {0.f, 0.f, 0.f, 0.f}, cqk = {0.f, 0.f, 0.f, 0.f};
#pragma unroll
                for (int ks = 0; ks < 4; ++ks) {
                    const bf16x8 bb = *(const bf16x8*)(kp + (size_t)(16 * nt + lr) * 3072 + ks * 32 + lq * 8);
                    ckk = __builtin_amdgcn_mfma_f32_16x16x32_bf16(ak[ks], bb, ckk, 0, 0, 0);
                    cqk = __builtin_amdgcn_mfma_f32_16x16x32_bf16(aq[ks], bb, cqk, 0, 0, 0);
                }
                const int jj = 16 * nt + lr; const float gj = gc[jj];
#pragma unroll
                for (int j = 0; j < 4; ++j) {
                    const int i = 16 * rt + 4 * lq + j; const float dec = __expf(fminf(gc[i] - gj, 0.f));
                    Am[i * 68 + jj] = (i > jj) ? bt[i] * ckk[j] * dec : 0.f;
                    DQK[(size_t)T * 4096 + i * 64 + jj] = f2bf((i >= jj) ? cqk[j] * dec : 0.f);
                }
            }
        }
        __syncthreads();
        {
            const int c = tid & 255, hf = tid >> 8; const bool isv = c < 128; const bf16_t* colp = isv ? vp + c : kp + (c - 128);
#pragma unroll 16
            for (int i2 = 0; i2 < 32; ++i2) { const int i = hf * 32 + i2; float rhs = bf2f(colp[(size_t)i * 3072]) * bt[i]; if (!isv) rhs *= __expf(gc[i]); X[i * 256 + c] = rhs; }
            const float glast = gc[63];
#pragma unroll 8
            for (int e = tid; e < 8192; e += 512) { const int i = e >> 7, d = e & 127; DQD[(size_t)T * 8192 + e] = f2bf(bf2f(qp[(size_t)i * 3072 + d]) * __expf(gc[i])); }
#pragma unroll 8
            for (int e = tid; e < 8192; e += 512) { const int d = e >> 6, i = e & 63; DKDT[(size_t)T * 8192 + e] = f2bf(bf2f(kp[(size_t)i * 3072 + d]) * __expf(glast - gc[i])); }
            if (tid == 0) DGL[T] = __expf(glast);
        }
        __syncthreads();
#pragma unroll
        for (int I = 0; I < 4; ++I) {
            if (I > 0) {
#pragma unroll
                for (int c2 = 0; c2 < 2; ++c2) {
                    const int ct = 2 * w + c2;
                    f32x4 acc = {0.f, 0.f, 0.f, 0.f};
#pragma unroll
                    for (int kk = 0; kk < 4 * I; ++kk)
                        acc = __builtin_amdgcn_mfma_f32_16x16x4f32(Am[(16 * I + lr) * 68 + 4 * kk + lq], X[(4 * kk + lq) * 256 + 16 * ct + lr], acc, 0, 0, 0);
#pragma unroll
                    for (int j = 0; j < 4; ++j) X[(16 * I + 4 * lq + j) * 256 + 16 * ct + lr] -= acc[j];
                }
                __syncthreads();
            }
            if (tid < 256) {
                float x[16];
#pragma unroll
                for (int r = 0; r < 16; ++r) x[r] = X[(16 * I + r) * 256 + tid];
#pragma unroll
                for (int r = 1; r < 16; ++r) {
                    float sacc = 0.f;
#pragma unroll
                    for (int j = 0; j < r; ++j) sacc += Am[(16 * I + r) * 68 + 16 * I + j] * x[j];
                    x[r] -= sacc;
                }
#pragma unroll
                for (int r = 1; r < 16; ++r) X[(16 * I + r) * 256 + tid] = x[r];
            }
            __syncthreads();
        }
        {
            const int c = tid & 255, hf = tid >> 8;
            if (c < 128) {
#pragma unroll 8
                for (int i2 = 0; i2 < 32; ++i2) { const int i = hf * 32 + i2; DU[(size_t)T * 8192 + i * 128 + c] = X[i * 256 + c]; }
            } else {
#pragma unroll 8
                for (int i2 = 0; i2 < 32; ++i2) { const int i = hf * 32 + i2; DNW[(size_t)T * 8192 + i * 128 + (c - 128)] = f2bf(-X[i * 256 + c]); }
            }
        }
        __syncthreads();
    }
}
__device__ __forceinline__ void d1_mix(const KP& P, const int l) {
    const int tidx_ = otid(), bidx_ = obid(); (void)tidx_; (void)bidx_;
    unsigned char* ws = ows(P.ws);
    const int tid = tidx_, w = tid >> 6, lane = tid & 63, lr = lane & 15, lq = lane >> 4;
    const bf16_t* vcn = (const bf16_t*)(ws + W_VCN); const bf16_t* gu = (const bf16_t*)(ws + W_GU); bf16_t* yc = (bf16_t*)(ws + W_YC);
    for (int it = bidx_ - 128; it < 512; it += gridDim.x - 128) {
        const int g = it & 7, cn = (it >> 3) & 15, b = it >> 7, r0 = b * 2048 + cn * 128;
        const float* wsg = P.in[I_WS] + ((size_t)l * 8 + g) * 128 * 128; const float* bsg = P.in[I_BS] + ((size_t)l * 8 + g) * 128;
        bf16x8 xv[4];
#pragma unroll
        for (int ks = 0; ks < 4; ++ks)
#pragma unroll
            for (int e = 0; e < 8; ++e) xv[ks][e] = (short)vcn[(size_t)(r0 + 32 * ks + 8 * lq + e) * 1024 + g * 128 + 16 * w + lr];
        float biasv[8]; u32x2 gq[8];
#pragma unroll
        for (int mt = 0; mt < 8; ++mt) { biasv[mt] = bsg[16 * mt + lr]; gq[mt] = *(const u32x2*)(gu + (size_t)(r0 + 16 * mt + lr) * 1024 + g * 128 + 16 * w + 4 * lq); }
        asm volatile("" ::: "memory");
#pragma unroll
        for (int mt = 0; mt < 8; ++mt) {
            const int t = 16 * mt + lr;
            f32x4 acc = {0.f, 0.f, 0.f, 0.f};
#pragma unroll
            for (int ks = 0; ks < 4; ++ks) {
                if (32 * ks <= 16 * mt + 15) {
                    const float* wp = wsg + (size_t)t * 128 + 32 * ks + 8 * lq; const f32x4 w0 = *(const f32x4*)wp, w1 = *(const f32x4*)(wp + 4);
                    float wv[8] = {w0[0], w0[1], w0[2], w0[3], w1[0], w1[1], w1[2], w1[3]};
                    bf16x8 yw;
#pragma unroll
                    for (int e = 0; e < 8; ++e) yw[e] = (short)f2bf((32 * ks + 8 * lq + e <= t) ? wv[e] : 0.f);
                    acc = __builtin_amdgcn_mfma_f32_16x16x32_bf16(xv[ks], yw, acc, 0, 0, 0);
                }
            }
            const float bias = biasv[mt]; const size_t o = (size_t)(r0 + t) * 1024 + g * 128 + 16 * w + 4 * lq;
            const u32x2 gw2 = gq[mt];
            u32x2 r; r.x = pk2(lo16(gw2.x) * (acc[0] + bias), hi16(gw2.x) * (acc[1] + bias)); r.y = pk2(lo16(gw2.y) * (acc[2] + bias), hi16(gw2.y) * (acc[3] + bias));
            *(u32x2*)(yc + o) = r;
        }
    }
    for (int i = (bidx_ - 128) * 512 + tidx_; i < MS * 128; i += (gridDim.x - 128) * 512) {
        const int rs = i >> 7, c8 = (i & 127) * 8, t = rs & 3, g = c8 >> 7, r = MP + rs;
        const float* wsg = P.in[I_WS] + (((size_t)l * 8 + g) * 128 + t) * 128; const float bias = P.in[I_BS][((size_t)l * 8 + g) * 128 + t];
        float a[8];
#pragma unroll
        for (int e = 0; e < 8; ++e) a[e] = bias;
#pragma unroll
        for (int s = 0; s < 4; ++s) if (s <= t) { float x[8]; unpack8(*(const u32x4*)(vcn + (size_t)(r - t + s) * 1024 + c8), x); const float wv = wsg[s];
#pragma unroll
            for (int e = 0; e < 8; ++e) a[e] += wv * x[e]; }
        float gq[8]; unpack8(*(const u32x4*)(gu + (size_t)r * 1024 + c8), gq);
#pragma unroll
        for (int e = 0; e < 8; ++e) a[e] *= gq[e];
        *(u32x4*)(yc + (size_t)r * 1024 + c8) = pack8(a);
    }
}
__device__ __forceinline__ void d1_sample_delta(const KP& P, const int l, float* shm) {
    const int tidx_ = otid(), bidx_ = obid(); (void)tidx_; (void)bidx_;
    unsigned char* ws = ows(P.ws);
    const int tid = tidx_, dvq = tid & 31, dkg = tid >> 5, lane = tid & 63;
    float* part = shm;
    float* part2 = shm + 2048;
    float* qs = shm + 4096;
    float* ks = qs + 512; float* vs = ks + 512; float* ab = vs + 512; float* zs = ab + 8;
    const float* qns = (const float*)(ws + W_QKVNS); const float* betab = (const float*)(ws + W_BETA); const float* ggb = (const float*)(ws + W_GG);
    const bf16_t* zb = (const bf16_t*)(ws + W_Z); bf16_t* yb = (bf16_t*)(ws + W_YB);
    for (int it = bidx_ - 128; it < 1024; it += gridDim.x - 128) {
        const int b = it >> 3, h = it & 7;
        const size_t so = ((size_t)(l * 128 + b) * 8 + h) * 16384;
        const float* s0 = P.in[I_SD] + so; float* sout = P.out + OUT_DS + so;
        f32x4 S[8];
#pragma unroll
        for (int i = 0; i < 8; ++i) S[i] = __builtin_nontemporal_load((const f32x4*)(s0 + (size_t)(8 * dkg + i) * 128 + 4 * dvq));
        __syncthreads();
        for (int e = tid; e < 1536; e += 512) { const int t = (e >> 7) & 3, d = e & 127, wh = e >> 9; qs[e] = qns[(size_t)(b * 4 + t) * 3072 + wh * 1024 + h * 128 + d]; }
        { const int t = tid >> 7, d = tid & 127; zs[tid] = silu_(bf2f(zb[(size_t)(MP + b * 4 + t) * 1024 + h * 128 + d])) * P.in[I_NBG][(size_t)l * 128 + d]; }
        if (tid < 4) { const int row = MP + b * 4 + tid; ab[tid] = __expf(ggb[(size_t)row * 8 + h]); ab[4 + tid] = betab[(size_t)row * 8 + h]; }
        __syncthreads();
#pragma unroll 1
        for (int t = 0; t < 4; ++t) {
            const int row = MP + b * 4 + t;
            const float a = ab[t], be = ab[4 + t];
            f32x4 p = {0.f, 0.f, 0.f, 0.f};
#pragma unroll
            for (int i = 0; i < 8; ++i) p += ks[t * 128 + 8 * dkg + i] * S[i];
            *(f32x4*)(part + dkg * 128 + 4 * dvq) = p;
            __syncthreads();
            f32x4 kS = {0.f, 0.f, 0.f, 0.f};
#pragma unroll
            for (int j = 0; j < 16; ++j) kS += *(const f32x4*)(part + j * 128 + 4 * dvq);
            const f32x4 vv = *(const f32x4*)(vs + t * 128 + 4 * dvq);
            const f32x4 vn = be * (vv - a * kS);
            f32x4 po = {0.f, 0.f, 0.f, 0.f};
#pragma unroll
            for (int i = 0; i < 8; ++i) { S[i] = a * S[i] + ks[t * 128 + 8 * dkg + i] * vn; po += qs[t * 128 + 8 * dkg + i] * S[i]; }
            *(f32x4*)(part2 + dkg * 128 + 4 * dvq) = po;
            __syncthreads();
            if (tid < 64) {
                float o0 = 0.f, o1 = 0.f;
#pragma unroll
                for (int j = 0; j < 16; ++j) { o0 += part2[j * 128 + lane]; o1 += part2[j * 128 + 64 + lane]; }
                const float rstd = rsqrtf(wave_sum(o0 * o0 + o1 * o1) * (1.f / 128.f) + RMS_EPS);
                const size_t o = (size_t)row * 1024 + h * 128;
                yb[o + lane] = f2bf(o0 * rstd * zs[t * 128 + lane]);
                yb[o + 64 + lane] = f2bf(o1 * rstd * zs[t * 128 + 64 + lane]);
            }
        }
#pragma unroll
        for (int i = 0; i < 8; ++i) __builtin_nontemporal_store(S[i], (f32x4*)(sout + (size_t)(8 * dkg + i) * 128 + 4 * dvq));
    }
}

struct D2Frags { bf16x8 nwh[4], qd[4], qk[2], kd[2][2]; float u[4]; float gl; };
__device__ __forceinline__ void d2_load(D2Frags& f, const unsigned char* ws, const int T, const int rg, const int lr, const int lq, const int dvc) {
    const bf16_t* DNW = (const bf16_t*)(ws + W_DNW); const bf16_t* DQD = (const bf16_t*)(ws + W_DQD);
    const bf16_t* DKDT = (const bf16_t*)(ws + W_DKDT); const bf16_t* DQK = (const bf16_t*)(ws + W_DQK);
    const unsigned o8 = (unsigned)T * 8192u + (unsigned)(16 * rg + lr) * 128u + lq * 8;
#pragma unroll
    for (int ks = 0; ks < 4; ++ks) { f.nwh[ks] = *(const bf16x8*)(DNW + o8 + ks * 32); f.qd[ks] = *(const bf16x8*)(DQD + o8 + ks * 32); }
#pragma unroll
    for (int k2 = 0; k2 < 2; ++k2) {
        f.qk[k2] = *(const bf16x8*)(DQK + (unsigned)T * 4096u + (unsigned)(16 * rg + lr) * 64u + k2 * 32 + lq * 8);
#pragma unroll
        for (int t2 = 0; t2 < 2; ++t2) f.kd[t2][k2] = *(const bf16x8*)(DKDT + (unsigned)T * 8192u + (unsigned)(32 * rg + 16 * t2 + lr) * 64u + k2 * 32 + lq * 8);
    }
#pragma unroll
    for (int j = 0; j < 4; ++j) f.u[j] = ((const float*)(ws + W_DU))[(unsigned)T * 8192u + (unsigned)(16 * rg + 4 * lq + j) * 128u + dvc];
    f.gl = ((const float*)(ws + W_DGL))[T];
}
#define MF(a_, b_, c_) c_ = __builtin_amdgcn_mfma_f32_16x16x32_bf16(a_, b_, c_, 0, 0, 0)
__device__ __forceinline__ void d2_step(const D2Frags& cur, D2Frags& nxt, const unsigned char* ws, const int Tn, const int r0, const int h, const int rg, const int lr, const int lq, const int dvc,
                                        bf16_t* StH, bf16_t* StL, bf16_t* vnT, float* ob, f32x4 (&S)[2]) {
    d2_load(nxt, ws, Tn, rg, lr, lq, dvc);
    asm volatile("" ::: "memory");
    bf16x8 bSh[4], bSl[4];
#pragma unroll
    for (int ks = 0; ks < 4; ++ks) { bSh[ks] = *(const bf16x8*)(StH + lr * 136 + ks * 32 + lq * 8); bSl[ks] = *(const bf16x8*)(StL + lr * 136 + ks * 32 + lq * 8); }
    f32x4 av = {cur.u[0], cur.u[1], cur.u[2], cur.u[3]};
#pragma unroll
    for (int ks = 0; ks < 4; ++ks) { MF(cur.nwh[ks], bSh[ks], av); MF(cur.nwh[ks], bSl[ks], av); }
    { u32x2 q; q.x = pk2(av[0], av[1]); q.y = pk2(av[2], av[3]); *(u32x2*)(vnT + lr * 72 + 16 * rg + 4 * lq) = q; }
    f32x4 ao = {0.f, 0.f, 0.f, 0.f};
#pragma unroll
    for (int ks = 0; ks < 4; ++ks) MF(cur.qd[ks], bSh[ks], ao);
    __syncthreads();
    bf16x8 bV[2];
#pragma unroll
    for (int k2 = 0; k2 < 2; ++k2) bV[k2] = *(const bf16x8*)(vnT + lr * 72 + k2 * 32 + lq * 8);
#pragma unroll
    for (int k2 = 0; k2 < 2; ++k2) MF(cur.qk[k2], bV[k2], ao);
#pragma unroll
    for (int t2 = 0; t2 < 2; ++t2) {
        S[t2] *= cur.gl;
#pragma unroll
        for (int k2 = 0; k2 < 2; ++k2) MF(cur.kd[t2][k2], bV[k2], S[t2]);
        float hf[4], lf[4];
#pragma unroll
        for (int j = 0; j < 4; ++j) { hf[j] = bf2f(f2bf(S[t2][j])); lf[j] = S[t2][j] - hf[j]; }
        u32x2 q; q.x = pk2(hf[0], hf[1]); q.y = pk2(hf[2], hf[3]); *(u32x2*)(StH + lr * 136 + 32 * rg + 16 * t2 + 4 * lq) = q;
        q.x = pk2(lf[0], lf[1]); q.y = pk2(lf[2], lf[3]); *(u32x2*)(StL + lr * 136 + 32 * rg + 16 * t2 + 4 * lq) = q;
    }
#pragma unroll
    for (int j = 0; j < 4; ++j) ob[(unsigned)(r0 + 16 * rg + 4 * lq + j) * 1024u + h * 128 + dvc] = ao[j];
    __syncthreads();
}
__device__ __forceinline__ void d2_scan(const KP& P, const int l, unsigned char* shmb) {
    const int tidx_ = otid(), bidx_ = obid(); (void)tidx_; (void)bidx_;
    unsigned char* ws = ows(P.ws);
    const int tid = tidx_, w = tid >> 6, lane = tid & 63, lr = lane & 15, lq = lane >> 4, sl = w >> 2, rg = w & 3;
    bf16_t* StH = (bf16_t*)(shmb + sl * 11008); bf16_t* StL = StH + 16 * 136; bf16_t* vnT = StL + 16 * 136;
    float* ob = (float*)(ws + W_OB);
    for (int item = bidx_; item < 128; item += gridDim.x) {
        const int chain = item >> 2, dq = item & 3, b = chain >> 3, h = chain & 7, dv0 = 32 * dq + 16 * sl, dvc = dv0 + lr;
        f32x4 S[2];
        S[0] = (f32x4){0.f, 0.f, 0.f, 0.f}; S[1] = (f32x4){0.f, 0.f, 0.f, 0.f};
        __syncthreads();
        for (int e = tid; e < 2 * 11008 / 4; e += 512) ((unsigned*)shmb)[e] = 0u;
        __syncthreads();
        D2Frags fa, fb; d2_load(fa, ws, chain * 32, rg, lr, lq, dvc);
#pragma unroll 1
        for (int n = 0; n < 32; n += 2) {
            const int T = chain * 32 + n, r0 = b * 2048 + n * 64;
            d2_step(fa, fb, ws, T + 1, r0, h, rg, lr, lq, dvc, StH, StL, vnT, ob, S);
            d2_step(fb, fa, ws, (n < 30) ? T + 2 : T + 1, r0 + 64, h, rg, lr, lq, dvc, StH, StL, vnT, ob, S);
        }
        float* sout = P.out + OUT_DP + ((size_t)(l * 4 + b) * 8 + h) * 16384;
#pragma unroll
        for (int t2 = 0; t2 < 2; ++t2)
#pragma unroll
            for (int j = 0; j < 4; ++j) sout[(unsigned)(32 * rg + 16 * t2 + 4 * lq + j) * 128u + dvc] = S[t2][j];
    }
}
#undef MF
__device__ __forceinline__ void onorm(const KP& P, const int l) {
    const int tidx_ = otid(), bidx_ = obid(); (void)tidx_; (void)bidx_;
    unsigned char* ws = ows(P.ws);
    const int lane = tidx_ & 63, gw = bidx_ * 8 + (tidx_ >> 6), ngw = gridDim.x * 8;
    const float* ob = (const float*)(ws + W_OB); const bf16_t* zb = (const bf16_t*)(ws + W_Z); bf16_t* yb = (bf16_t*)(ws + W_YB);
    const float* ng = P.in[I_NBG] + (size_t)l * 128 + (lane & 7) * 16;
    for (int r = gw; r < MP; r += ngw) {
        const unsigned o = (unsigned)r * 1024u + lane * 16;
        float x[16]; float ss = 0.f;
#pragma unroll
        for (int q = 0; q < 4; ++q) { const f32x4 v = *(const f32x4*)(ob + o + 4 * q); x[4 * q] = v[0]; x[4 * q + 1] = v[1]; x[4 * q + 2] = v[2]; x[4 * q + 3] = v[3]; ss += (v[0] * v[0] + v[1] * v[1]) + (v[2] * v[2] + v[3] * v[3]); }
        ss += __shfl_xor(ss, 1); ss += __shfl_xor(ss, 2); ss += __shfl_xor(ss, 4);
        const float rstd = rsqrtf(ss * (1.f / 128.f) + RMS_EPS);
        float z0[8], z1[8]; unpack8(*(const u32x4*)(zb + o), z0); unpack8(*(const u32x4*)(zb + o + 8), z1);
        float y0[8], y1[8];
#pragma unroll
        for (int e = 0; e < 8; ++e) { y0[e] = x[e] * rstd * ng[e] * silu_(z0[e]); y1[e] = x[8 + e] * rstd * ng[8 + e] * silu_(z1[e]); }
        *(u32x4*)(yb + o) = pack8(y0); *(u32x4*)(yb + o + 8) = pack8(y1);
    }
}

__device__ __forceinline__ void phase_f(const KP& P, const int l) {
    const int tidx_ = otid(), bidx_ = obid(); (void)tidx_; (void)bidx_;
    unsigned char* ws = ows(P.ws);
    const bf16_t* hg = (const bf16_t*)(ws + W_HG); const bf16_t* hu = (const bf16_t*)(ws + W_HU); bf16_t* hh = (bf16_t*)(ws + W_H);
    const float* cw = P.in[I_CFW] + (size_t)l * 3 * DFF; const float* hist = P.in[I_SCF] + (size_t)l * 128 * 2 * DFF;
    constexpr int C8 = DFF / 8;
    for (int i = bidx_ * 512 + tidx_; i < (MT / 4) * C8; i += gridDim.x * 512) {
        const int q = i / C8, c8 = (i % C8) * 8, r0 = 4 * q;
        const bool smp = r0 >= MP; const int t0 = smp ? 0 : (r0 & 2047), sb = (r0 - MP) >> 2;
        float x[6][8];
#pragma unroll
        for (int d = 0; d < 2; ++d) {
            if (t0 > 0) unpack8(*(const u32x4*)(hg + (size_t)(r0 - 2 + d) * DFF + c8), x[d]);
            else if (smp) { const float* hp = hist + ((size_t)sb * 2 + d) * DFF + c8; const f32x4 h0 = *(const f32x4*)hp, h1 = *(const f32x4*)(hp + 4);
#pragma unroll
                for (int j = 0; j < 4; ++j) { x[d][j] = h0[j]; x[d][4 + j] = h1[j]; } }
            else {
#pragma unroll
                for (int j = 0; j < 8; ++j) x[d][j] = 0.f; }
        }
#pragma unroll
        for (int d = 0; d < 4; ++d) unpack8(*(const u32x4*)(hg + (size_t)(r0 + d) * DFF + c8), x[2 + d]);
        float w[3][8];
#pragma unroll
        for (int d = 0; d < 3; ++d) { const f32x4 w0 = *(const f32x4*)(cw + d * DFF + c8), w1 = *(const f32x4*)(cw + d * DFF + c8 + 4);
#pragma unroll
            for (int j = 0; j < 4; ++j) { w[d][j] = w0[j]; w[d][4 + j] = w1[j]; } }
#pragma unroll
        for (int d = 0; d < 4; ++d) {
            float u[8], a[8]; unpack8(*(const u32x4*)(hu + (size_t)(r0 + d) * DFF + c8), u);
#pragma unroll
            for (int j = 0; j < 8; ++j) a[j] = silu_(w[0][j] * x[d][j] + w[1][j] * x[d + 1][j] + w[2][j] * x[d + 2][j]) * u[j];
            *(u32x4*)(hh + (size_t)(r0 + d) * DFF + c8) = pack8(a);
        }
    }
}

#define XB_TMO      128
#define XB_XCNT(j)  (256  + 64 * (j))
#define XB_XSUB(j)  (1280 + 64 * (j))
#define XB_XGEN(j)  (2304 + 64 * (j))
#define XB_TOP      3328
#define XB_TOPGEN   3392
#define XCD_BAR_WORDS 3456
#define XB_SPIN_CAP (1u << 18)

__device__ __forceinline__ unsigned xb_ld(unsigned* p)              { return __hip_atomic_load(p, __ATOMIC_RELAXED, __HIP_MEMORY_SCOPE_AGENT); }
__device__ __forceinline__ unsigned xb_add(unsigned* p, unsigned v) { return __hip_atomic_fetch_add(p, v, __ATOMIC_RELAXED, __HIP_MEMORY_SCOPE_AGENT); }
__device__ __forceinline__ unsigned xb_xcc_id() { return (unsigned)__builtin_amdgcn_s_getreg((3 << 11) | 20) & 0xFu; }
#define XB_SPIN(cond, bar) do { unsigned _sp = 0; while (cond) { __builtin_amdgcn_s_sleep(1); \
    if ((++_sp & 255u) == 0u) { if (xb_ld(&(bar)[XB_TMO])) break; if (_sp > XB_SPIN_CAP) { atomicAdd(&(bar)[XB_TMO], 1u); break; } } } } while (0)

struct XcdBarrier {
    unsigned* bar; unsigned x;
    volatile LAS unsigned* st;
};

__device__ __forceinline__ XcdBarrier xcd_barrier_post(unsigned* bar, volatile LAS unsigned* st) {
    XcdBarrier b; b.bar = bar; b.x = xb_xcc_id(); b.st = st;
    if (threadIdx.x == 0) (void)xb_add(&bar[XB_XCNT(b.x)], 1u);
    return b;
}
__device__ __forceinline__ void xcd_barrier_complete(unsigned* bar, unsigned x, unsigned& nloc, unsigned& nx) {
    const unsigned G = gridDim.x * gridDim.y * gridDim.z;
    unsigned sum, cnt, mine, sp = 0u;
    for (;;) {
        sum = 0u; cnt = 0u; mine = 0u;
#pragma unroll
        for (unsigned j = 0; j < 16; ++j) { const unsigned c = xb_ld(&bar[XB_XCNT(j)]); sum += c; cnt += (c > 0u) ? 1u : 0u; mine = (j == x) ? c : mine; }
        if (sum == G) break;
        __builtin_amdgcn_s_sleep(1);
        if ((++sp & 255u) == 0u) { if (xb_ld(&bar[XB_TMO])) break; if (sp > XB_SPIN_CAP) { atomicAdd(&bar[XB_TMO], 1u); break; } }
    }
    nloc = mine > 0u ? mine : 1u; nx = cnt > 0u ? cnt : 1u;
}

__device__ __forceinline__ void xcd_barrier(const XcdBarrier& b) {
    asm volatile("s_waitcnt vmcnt(0)" ::: "memory");
    __syncthreads();
    if (threadIdx.x == 0) {
        unsigned* bar = b.bar;
        __builtin_amdgcn_s_waitcnt(0);
        unsigned nloc = b.st[0], nx = b.st[1];
        if (nloc == 0u) { xcd_barrier_complete(bar, b.x, nloc, nx); b.st[0] = nloc; b.st[1] = nx; }
        const unsigned old = xb_add(&bar[XB_XSUB(b.x)], 1u);
        const unsigned gen = old / nloc;
        if (old + 1u == (gen + 1u) * nloc) {
            __builtin_amdgcn_fence(__ATOMIC_RELEASE, "agent");
            asm volatile("s_waitcnt vmcnt(0)" ::: "memory");
            const unsigned og = xb_add(&bar[XB_TOP], 1u);
            const unsigned tg = og / nx;
            if (og + 1u == (tg + 1u) * nx) xb_add(&bar[XB_TOPGEN], 1u);
            else XB_SPIN(xb_ld(&bar[XB_TOPGEN]) == tg, bar);
            __builtin_amdgcn_fence(__ATOMIC_ACQUIRE, "agent");
            xb_add(&bar[XB_XGEN(b.x)], 1u);
            asm volatile("s_waitcnt vmcnt(0)" ::: "memory");
        } else {
            XB_SPIN(xb_ld(&bar[XB_XGEN(b.x)]) == gen, bar);
            __builtin_amdgcn_fence(__ATOMIC_ACQUIRE, "agent");
            asm volatile("s_waitcnt vmcnt(0)" ::: "memory");
        }
    }
    __syncthreads();
}

enum { K_G1 = 0, K_E, K_D1, K_D2, K_G2A, K_G2B, K_G3, K_LN1, K_G4, K_F, K_G5, K_LN2, K_PER_LAYER };
constexpr int N_PHASES = 1 + 2 * K_PER_LAYER;

__global__ void __launch_bounds__(512, 2) mega(const KP P, const int ph_lo, const int ph_hi) {
    extern __shared__ __attribute__((aligned(16))) unsigned char shm[];
    cg::grid_group grid = cg::this_grid();
    unsigned char* const ws = P.ws;
    volatile LAS unsigned* xst = (volatile LAS unsigned*)((LAS unsigned char*)shm + STAGE_BYTES);
    if (threadIdx.x == 0) { xst[0] = 0u; xst[1] = 0u; xst[2] = 0u; xst[3] = 0u; }
    __syncthreads();
    (void)xcd_barrier_post((unsigned*)(ws + W_BAR), xst);
    int again = 0;
#pragma unroll 1
    for (int ph = ph_lo; ph < ph_hi;) {
        if (ph == 0) {
#if !defined(PHSEL) || PHSEL == 0
            ln_rows(P, 0, P.in[I_LNG], P.in[I_LNB], false);
#endif
#if !defined(PHSEL) || PHSEL == 1
#endif
        } else {
            const int l = (ph - 1) / K_PER_LAYER, k = (ph - 1) % K_PER_LAYER;
            Gemm g; g.A = nullptr; g.Bt = nullptr; g.M = MT; g.N = 0; g.K = 0; int mode = -1;
            switch (k) {
                case K_G1: g.A = (const bf16_t*)(ws + W_XB); g.Bt = (const bf16_t*)(ws + W_WIN); g.N = NV1 - 256; g.K = 2048; mode = M_G1; break;
                case K_G2A: g.A = (const bf16_t*)(ws + W_YA); g.Bt = (const bf16_t*)(ws + W_WA); g.N = 2048; g.K = 1024; mode = M_G2A; break;
                case K_G2B: g.A = (const bf16_t*)(ws + W_YB); g.Bt = (const bf16_t*)(ws + W_WB); g.N = 2048; g.K = 1024; mode = M_G2B; break;
                case K_G3: g.A = (const bf16_t*)(ws + W_MGB); g.Bt = (const bf16_t*)(ws + W_WO); g.N = 2048; g.K = 2048; mode = M_G3; break;
                case K_G4: g.A = (const bf16_t*)(ws + W_XB); g.Bt = (const bf16_t*)(ws + W_WUP); g.N = NV4; g.K = 2048; mode = M_G4; break;
                case K_G5: g.A = (const bf16_t*)(ws + W_H); g.Bt = (const bf16_t*)(ws + W_WDN); g.N = 2048; g.K = DFF; mode = M_G5; break;
                default: break;
            }
            if (mode >= 0) {
#if !defined(PHSEL) || PHSEL == 2
                const int npass = (k == K_G2A) ? 3 : 1;
#pragma unroll 1
                for (int pass = 0; pass < npass; ++pass) {
                    int cblk = (int)blockIdx.x, G = (int)gridDim.x; bool skip = false;
                    if (pass == 1) {
                        g.A = (const bf16_t*)(ws + W_YC); g.Bt = (const bf16_t*)(ws + W_WC); mode = M_G2C; cblk = (cblk + G / 2) % G;
                    } else if (pass == 2) {
                        g.A = (const bf16_t*)(ws + W_PB); g.Bt = (const bf16_t*)(ws + W_WPE); g.K = 256; mode = M_PE;
                        skip = (cblk < 16) || (cblk >= 128 && cblk < 144); cblk -= (cblk < 128) ? 16 : 32; G -= 32;
                    }
                    if (!skip) {
                        const int split = ((mode == M_G3 || mode == M_G5) && gridDim.x == 256) ? 1 : 0;
                        StaticOrder S; S.init(split ? MP : g.M, g.N, g.K, G, cblk, split);
                        gemm_phase((LAS unsigned char*)shm, g, S, P, mode, l);
                    }
                }
#endif
                if (k == K_G2A) onorm(P, l);
            } else if (k == K_E) {
#if !defined(PHSEL) || PHSEL == 3
                beta_gate(P, l);
                phase_e(P, l);
#endif
            } else if (k == K_D1) {
#if !defined(PHSEL) || PHSEL == 4
                d1_prep(P, l, (float*)shm);
#endif

            } else if (k == K_D2) {
#if !defined(PHSEL) || PHSEL == 7
                if (blockIdx.x < 128) d2_scan(P, l, shm);
                else { d1_sample_delta(P, l, (float*)shm); d1_mix(P, l); }
#endif
            } else if (k == K_LN1) {
                ln_rows(P, 1, P.in[I_L1G] + (size_t)l * DM, P.in[I_L1B] + (size_t)l * DM, false);
            } else if (k == K_F) {
#if !defined(PHSEL) || PHSEL == 8
                phase_f(P, l);
#endif
            } else if (k == K_LN2) {
                ln_rows(P, 1, P.in[I_L2G] + (size_t)l * DM, P.in[I_L2B] + (size_t)l * DM, l == 1);
            }
        }
        {
            int cl = -1, cpart = 0, cb0 = 0, cnb = (int)gridDim.x;
            if (ph == 0) cl = 0;
            else { const int l2 = (ph - 1) / K_PER_LAYER, k2 = (ph - 1) % K_PER_LAYER;
                if (k2 == K_LN2 && l2 == 0) cl = 1;
                else if (k2 == K_G2B && blockIdx.x >= 16) { cl = l2; cpart = 1; cb0 = 16; cnb -= 16; } }
            if (cl >= 0) convert_weights(P, cl, (float*)shm, cpart, cb0, cnb);
        }
#ifdef REPMASK
        {
            const int k = ph == 0 ? -1 : (ph - 1) % K_PER_LAYER; int bit = -1;
            if (ph == 0 || k == K_LN2) bit = 0; else if (k == K_E || k == K_F) bit = 1; else if (k == K_D1) bit = 2; else if (k == K_D2) bit = 3;
            else if (k == K_G1 || k == K_G5) bit = 4; else if (k == K_G3) bit = 5; else if (k == K_LN1) bit = 6;
            if (!again && bit >= 0 && ((REPMASK >> bit) & 1)) again = 1; else { again = 0; ++ph; }
        }
#else
        ++ph; (void)again;
#endif
        if (ph < ph_hi) { if (ph_hi < 0) grid.sync();   { XcdBarrier xb; xb.bar = (unsigned*)(ows(P.ws) + W_BAR); xb.x = xb_xcc_id(); xb.st = (volatile LAS unsigned*)((LAS unsigned char*)shm + STAGE_BYTES); xcd_barrier(xb); } }
    }
}

extern "C" void kernel_launch(void* const* d_in, const int* in_sizes, int n_in, void* d_out, int out_size, void* d_ws, size_t ws_size, hipStream_t stream) {
    static int grid_blocks = 0;
    constexpr int LDS_BYTES = STAGE_BYTES + 256;
    if (grid_blocks == 0) {
        if (n_in != 33 || (size_t)out_size != OUT_END || ws_size < WS_TOTAL) {
            fprintf(stderr, "kernel_launch: unexpected problem (n_in %d, out %d vs %zu, ws %zu vs %zu)\n", n_in, out_size, (size_t)OUT_END, ws_size, (size_t)WS_TOTAL);
            grid_blocks = -1; return;
        }
        int dev = 0, cus = 0, per_cu = 0;
        hipGetDevice(&dev);
        hipDeviceGetAttribute(&cus, hipDeviceAttributeMultiprocessorCount, dev);
        hipFuncSetAttribute((const void*)mega, hipFuncAttributeMaxDynamicSharedMemorySize, LDS_BYTES);
        hipOccupancyMaxActiveBlocksPerMultiprocessor(&per_cu, (const void*)mega, 512, LDS_BYTES);
        if (per_cu < 1) per_cu = 1;
        grid_blocks = cus * 1;
        (void)hipGetLastError();
    }
    if (grid_blocks < 0) return;
    if (hipMemsetAsync((unsigned char*)d_ws + W_BAR, 0, XCD_BAR_WORDS * sizeof(unsigned), stream) != hipSuccess) { fprintf(stderr, "kernel_launch: memset of the barrier words failed\n"); return; }
    KP p{};
    for (int i = 0; i < 33; ++i) p.in[i] = (const float*)d_in[i];
    p.out = (float*)d_out; p.ws = (unsigned char*)d_ws;
    int lo = 0, hi = N_PHASES;
    void* args[] = {&p, &lo, &hi};
    hipError_t e = hipLaunchCooperativeKernel((const void*)mega, dim3(grid_blocks), dim3(512), args, LDS_BYTES, stream);
    if (e != hipSuccess) fprintf(stderr, "cooperative launch failed: %s (grid %d)\n", hipGetErrorString(e), grid_blocks);
}
```

```cpp
#include <hip/hip_runtime.h>
#include <hip/hip_cooperative_groups.h>
#include <cstdio>
#include <cstdint>
namespace cg = cooperative_groups;

#define LAS __attribute__((address_space(3)))
typedef unsigned short bf16_t;
typedef short bf16x8 __attribute__((ext_vector_type(8)));
typedef float f32x4 __attribute__((ext_vector_type(4)));
typedef unsigned u32x4 __attribute__((ext_vector_type(4)));
typedef unsigned u32x2 __attribute__((ext_vector_type(2)));

constexpr int DM = 2048, NBP = 4, SEQ = 2048, NBS = 128, DSQ = 4;
constexpr int MP = NBP * SEQ, MS = NBS * DSQ, MT = MP + MS;
constexpr int DPLE = 256, DA = 1024, HB = 8, DB = 1024, DC = 1024, DFF = 5504, NIN = 15376;
constexpr int NV1 = 61 * 256, NV4 = 2 * DFF + DM;
constexpr float ALPHA = 1.41421356237f, LN_EPS = 1e-5f, RMS_EPS = 1e-6f;

constexpr size_t OUT_YP = 0, OUT_YS = OUT_YP + (size_t)MP * DM, OUT_CAP = OUT_YS + (size_t)MS * DM, OUT_CQP = OUT_CAP + 2 * 4 * 2 * 1024,
                 OUT_DP = OUT_CQP + 2 * 4 * 3 * 3072, OUT_CFP = OUT_DP + 2 * 4 * 8 * 16384, OUT_CAS = OUT_CFP + 2 * 4 * 2 * 5504,
                 OUT_CQS = OUT_CAS + 2 * 128 * 2 * 1024, OUT_DS = OUT_CQS + 2 * 128 * 3 * 3072, OUT_CFS = OUT_DS + (size_t)2 * 128 * 8 * 16384,
                 OUT_VS = OUT_CFS + 2 * 128 * 2 * 5504, OUT_END = OUT_VS + 2 * 128 * 4 * 1024;

constexpr size_t al256(size_t x) { return (x + 255) & ~(size_t)255; }
constexpr size_t W_WIN = 0, W_WA = W_WIN + (size_t)NV1 * 2048 * 2, W_WB = W_WA + (size_t)2048 * 1024 * 2, W_WC = W_WB + (size_t)2048 * 1024 * 2,
                 W_WO = W_WC + (size_t)2048 * 1024 * 2, W_WUP = W_WO + (size_t)2048 * 2048 * 2, W_WDN = W_WUP + (size_t)NV4 * 2048 * 2,
                 W_WPE = W_WDN + (size_t)2048 * DFF * 2, W_XRES = W_WPE + (size_t)2048 * 256 * 2, W_XB = W_XRES + (size_t)MT * DM * 4,
                 W_PRE = W_XB + (size_t)MT * DM * 2, W_PB = W_PRE + (size_t)MT * DM * 4, W_R = W_PB + (size_t)MT * DPLE * 2;
constexpr size_t W_CH = W_R, W_BG = W_CH + (size_t)MT * 1024 * 2, W_QKV = W_BG + (size_t)MT * 1024 * 2, W_Z = W_QKV + (size_t)MT * 3072 * 2,
                 W_GU = W_Z + (size_t)MT * 1024 * 2, W_GV = W_GU + (size_t)MT * 1024 * 2, W_GTS = W_GV + (size_t)MT * 1024 * 2,
                 W_BETA = W_GTS + (size_t)MT * 6144 * 2, W_GG = W_BETA + al256((size_t)MT * 8 * 4), W_YA = W_GG + al256((size_t)MT * 8 * 4),
                 W_YB = W_YA + (size_t)MT * 1024 * 2, W_YC = W_YB + (size_t)MT * 1024 * 2, W_QKVN = W_YC + (size_t)MT * 1024 * 2,
                 W_QKVNS = W_QKVN + (size_t)MT * 3072 * 2, W_VCN = W_QKVNS + (size_t)MS * 3072 * 4, W_DU = W_VCN + (size_t)MT * 1024 * 2,
                 W_DNW = W_DU + (size_t)1024 * 8192 * 4, W_DQD = W_DNW + (size_t)1024 * 8192 * 2, W_DKDT = W_DQD + (size_t)1024 * 8192 * 2,
                 W_DQK = W_DKDT + (size_t)1024 * 8192 * 2, W_DNW2 = W_DQK + (size_t)1024 * 4096 * 2, W_OB = W_DNW2 + (size_t)1024 * 8192 * 2,
                 W_DGL = W_OB + (size_t)MP * 1024 * 4, W_MG32 = W_DGL + 4096,
                 W_MGB = W_MG32 + (size_t)MT * DM * 4, W_REND = W_MGB + (size_t)MT * DM * 2;
constexpr size_t W_PE = W_R, W_HG = W_PE + (size_t)MT * DM * 4, W_HU = W_HG + (size_t)MT * DFF * 2, W_H = W_HU + (size_t)MT * DFF * 2,
                 W_FEND = W_H + (size_t)MT * DFF * 2;
constexpr size_t W_MG32C = W_VCN;
static_assert(W_MG32C + (size_t)MT * DM * 4 <= W_DKDT, "MG32C overlay");
constexpr size_t W_PART = W_VCN;
static_assert(W_PART >= W_FEND && W_PART + (size_t)16 * MS * DM * 4 <= W_OB, "partial buffer overlay");
constexpr size_t WS_NEED = W_REND > W_FEND ? W_REND : W_FEND;
constexpr size_t W_BAR = WS_NEED;
constexpr size_t WS_TOTAL = W_BAR + 16384;
static_assert(WS_TOTAL <= (size_t)1007681536, "workspace too large");

struct KP { const float* in[33]; float* out; unsigned char* ws; };
enum { I_XP = 0, I_XS, I_SCA, I_SCQ, I_SD, I_SCF, I_PP, I_PS, I_LNG, I_LNB, I_WIN, I_CAW, I_WAO, I_CBW, I_ALOG, I_DTB, I_NBG, I_WBO, I_LCG, I_LCB, I_WS, I_BS,
       I_WCO, I_WO, I_L1G, I_L1B, I_WUP, I_CFW, I_WDN, I_WPE, I_WPG, I_L2G, I_L2B };

__device__ __forceinline__ float bf2f(bf16_t h) { return __uint_as_float(((unsigned)h) << 16); }
__device__ __forceinline__ bf16_t f2bf(float f) { unsigned u = __float_as_uint(f); u += 0x7FFFu + ((u >> 16) & 1u); return (bf16_t)(u >> 16); }
typedef __bf16 bf16x2_t __attribute__((ext_vector_type(2)));
typedef float f32x2_t __attribute__((ext_vector_type(2)));
__device__ __forceinline__ unsigned pk2(float lo, float hi) { const bf16x2_t r = __builtin_convertvector((f32x2_t){lo, hi}, bf16x2_t); return __builtin_bit_cast(unsigned, r); }
__device__ __forceinline__ void split_bf(float x, bf16_t& hi, bf16_t& lo) { hi = f2bf(x); lo = f2bf(x - bf2f(hi)); }
__device__ __forceinline__ float lo16(unsigned w) { return __uint_as_float(w << 16); }
__device__ __forceinline__ float hi16(unsigned w) { return __uint_as_float(w & 0xffff0000u); }
__device__ __forceinline__ void unpack8(u32x4 w, float (&f)[8]) { f[0] = lo16(w.x); f[1] = hi16(w.x); f[2] = lo16(w.y); f[3] = hi16(w.y); f[4] = lo16(w.z); f[5] = hi16(w.z); f[6] = lo16(w.w); f[7] = hi16(w.w); }
__device__ __forceinline__ u32x4 pack8(const float (&f)[8]) { u32x4 w; w.x = pk2(f[0], f[1]); w.y = pk2(f[2], f[3]); w.z = pk2(f[4], f[5]); w.w = pk2(f[6], f[7]); return w; }
__device__ __forceinline__ float sigmoid_(float x) { return __builtin_amdgcn_rcpf(1.f + __expf(-x)); }
__device__ __forceinline__ float silu_(float x) { return x * __builtin_amdgcn_rcpf(1.f + __expf(-x)); }
__device__ __forceinline__ float gelu_(float x) { const float y = 1.5957691216f * (x + 0.044715f * x * x * x); return x * __builtin_amdgcn_rcpf(1.f + __expf(-y)); }
__device__ __forceinline__ float softplus_(float x) { return x > 20.f ? x : log1pf(__expf(x)); }
__device__ __forceinline__ float wave_sum(float v) {
#pragma unroll
    for (int o = 1; o < 64; o <<= 1) v += __shfl_xor(v, o);
    return v;
}

__device__ __forceinline__ int otid() { int t = (int)threadIdx.x; asm volatile("" : "+v"(t)); return t; }
__device__ __forceinline__ int obid() { int t = (int)blockIdx.x; asm volatile("" : "+s"(t)); return t; }
__device__ __forceinline__ unsigned char* ows(const unsigned char* p) { unsigned long long v = (unsigned long long)p; asm volatile("" : "+s"(v)); return (unsigned char*)(__attribute__((address_space(1))) unsigned char*)v; }
constexpr int BM = 256, BK = 64, HALF = 128, HTB = HALF * BK * 2, STAGE_BYTES = 8 * HTB, NXCD = 8, WGM = 8;
__device__ __forceinline__ int lds_byte(int r, int c) { const int st = (r >> 4) * 2 + (c >> 5), rr = r & 15, cc = c & 31, ob = rr * 64 + cc * 2; return st * 1024 + (ob ^ (((ob >> 9) & 1) << 5)); }
__device__ __forceinline__ void stage_rc(int b, int& R, int& C) { const int st = b / 1024, sb = b % 1024, swz = sb ^ (((sb >> 9) & 1) << 5); R = (st >> 1) * 16 + swz / 64; C = (st & 1) * 32 + (swz % 64) / 2; }
__device__ __forceinline__ int perm32(int rho) { const int n = rho >> 4, i = rho & 15; return 8 * (i >> 2) + 4 * n + (i & 3); }
struct Unit { int pm, pn, k0, nt, part; };
struct Gemm { const bf16_t* A; const bf16_t* Bt; int M, N, K; };
struct StaticOrder {
    int nM, nN, nwg, G, c, ntf, split;
    __device__ __forceinline__ void init(int M, int N, int K, int G_, int c_, int split_) { nM = M / BM; nN = N / BM; nwg = nM * nN; G = G_; c = c_; ntf = K / BK; split = split_; }
    __device__ __forceinline__ bool next(int i, Unit& u) const {
        u.k0 = 0; u.nt = ntf; u.part = -1;
        if (split) {
            if (i >= 2) return false;
            if (i == 0) { const int su = c >> 4, ks = c & 15, np = ntf >> 1, p0 = (np * ks) >> 4, p1 = (np * (ks + 1)) >> 4;
                u.pm = 32 + (su >> 3); u.pn = su & 7; u.k0 = 2 * p0; u.nt = 2 * (p1 - p0); u.part = ks; return true; }
        }
        const long L = split ? (long)c : (long)i * G + c; if (L >= nwg) return false;
        int wgid = (int)L; { const int q = nwg / NXCD, r = nwg % NXCD, xcd = wgid % NXCD, off = wgid / NXCD; wgid = (xcd < r ? xcd * (q + 1) : r * (q + 1) + (xcd - r) * q) + off; }
        const int nig = WGM * nN, gid = wgid / nig, fm = gid * WGM, gsz = (nM - fm) < WGM ? (nM - fm) : WGM;
        u.pm = fm + ((wgid % nig) % gsz); u.pn = (wgid % nig) / gsz; return true;
    }
};

enum { M_G1 = 0, M_G2A, M_G2B, M_G2C, M_G3, M_PE, M_G4, M_G5 };

__device__ __forceinline__ void st8bf(bf16_t* p, f32x4 a, f32x4 b) { u32x4 w; w.x = pk2(a[0], a[1]); w.y = pk2(a[2], a[3]); w.z = pk2(b[0], b[1]); w.w = pk2(b[2], b[3]); *(u32x4*)p = w; }
__device__ __forceinline__ void st8f(float* p, f32x4 a, f32x4 b) { *(f32x4*)p = a; *(f32x4*)(p + 4) = b; }
__device__ __forceinline__ bool tail_row(int r, int nk, int& seq, int& i, bool& smp) {
    if (r < MP) { seq = r >> 11; smp = false; i = (r & 2047) - (2048 - nk); return i >= 0; }
    const int rs = r - MP; seq = rs >> 2; smp = true; i = (rs & 3) - (4 - nk); return i >= 0;
}

__device__ __forceinline__ void epilogue(const KP& P, const int mode, const int l, const f32x4 (&acc)[2][2][4][2], const int pm, const int pn, const int part, const int wr, const int wc, const int fr_, const int fq_) {
    unsigned char* const ws = ows(P.ws); float* const out = (float*)ows((const unsigned char*)P.out);
    int fr = fr_, fq = fq_; asm volatile("" : "+v"(fr), "+v"(fq));
    const int rbase = pm * 256 + wr * 64 + fr, cl = wc * 32 + 8 * fq;
    if (mode == M_G1) {
        if (pn < 8) {
            bf16_t* ch = (bf16_t*)(ws + W_CH);
#pragma unroll
            for (int ai = 0; ai < 2; ++ai)
#pragma unroll
                for (int m = 0; m < 4; ++m) {
                    __builtin_amdgcn_sched_barrier(0); const int row = rbase + ai * 128 + m * 16, col = pn * 128 + cl;
                    const f32x4 a = acc[ai][0][m][0] * acc[ai][1][m][0], b = acc[ai][0][m][1] * acc[ai][1][m][1];
                    st8bf(ch + (unsigned)(row * 1024 + col), a, b);
                    int seq, i; bool smp;
                    if (tail_row(row, 2, seq, i, smp)) {
                        float* d = out + (smp ? OUT_CAS + ((size_t)(l * 128 + seq) * 2 + i) * 1024 : OUT_CAP + ((size_t)(l * 4 + seq) * 2 + i) * 1024) + col;
                        st8f(d, a, b);
                    }
                }
        } else if (pn == 60) {
            if (wc == 0 && fq < 2) {
                float* dst = (float*)(ws + (fq == 0 ? W_BETA : W_GG));
#pragma unroll
                for (int ai = 0; ai < 2; ++ai)
#pragma unroll
                    for (int m = 0; m < 4; ++m) {
                        __builtin_amdgcn_sched_barrier(0); const int row = rbase + ai * 128 + m * 16;
                        float v[8];
#pragma unroll
                        for (int j = 0; j < 4; ++j) { v[j] = acc[ai][0][m][0][j]; v[4 + j] = acc[ai][0][m][1][j]; }
#pragma unroll
                        for (int h = 0; h < 8; ++h) {
                            if (fq == 0) v[h] = sigmoid_(v[h]);
                            else v[h] = -__expf(P.in[I_ALOG][l * 8 + h]) * softplus_(v[h] + P.in[I_DTB][l * 8 + h]);
                        }
                        st8f(dst + (unsigned)(row * 8), (f32x4){v[0], v[1], v[2], v[3]}, (f32x4){v[4], v[5], v[6], v[7]});
                    }
            }
        } else {
            bf16_t* dstb; int ld, c0, act = 0; bool isq = false;
            if (pn < 12) { dstb = (bf16_t*)(ws + W_BG); ld = 1024; c0 = (pn - 8) * 256; }
            else if (pn < 24) { dstb = (bf16_t*)(ws + W_QKV); ld = 3072; c0 = (pn - 12) * 256; isq = true; }
            else if (pn < 28) { dstb = (bf16_t*)(ws + W_Z); ld = 1024; c0 = (pn - 24) * 256; }
            else if (pn < 32) { dstb = (bf16_t*)(ws + W_GU); ld = 1024; c0 = (pn - 28) * 256; act = 1; }
            else if (pn < 36) { dstb = (bf16_t*)(ws + W_GV); ld = 1024; c0 = (pn - 32) * 256; act = 1; }
            else { dstb = (bf16_t*)(ws + W_GTS); ld = 6144; c0 = (pn - 36) * 256; act = 2; }
#pragma unroll
            for (int ai = 0; ai < 2; ++ai)
#pragma unroll
                for (int m = 0; m < 4; ++m) {
                    __builtin_amdgcn_sched_barrier(0); const int row = rbase + ai * 128 + m * 16;
#pragma unroll
                    for (int bj = 0; bj < 2; ++bj) {
                        const int col = c0 + bj * 128 + cl;
                        f32x4 a = acc[ai][bj][m][0], b = acc[ai][bj][m][1];
                        if (act == 1) {
#pragma unroll
                            for (int j = 0; j < 4; ++j) { a[j] = gelu_(a[j]); b[j] = gelu_(b[j]); }
                        } else if (act == 2) {
#pragma unroll
                            for (int j = 0; j < 4; ++j) { a[j] = sigmoid_(a[j]); b[j] = sigmoid_(b[j]); }
                        }
                        st8bf(dstb + (unsigned)(row * ld + col), a, b);
                        if (isq) {
                            int seq, i; bool smp;
                            if (tail_row(row, 3, seq, i, smp)) {
                                float* d = out + (smp ? OUT_CQS + ((size_t)(l * 128 + seq) * 3 + i) * 3072 : OUT_CQP + ((size_t)(l * 4 + seq) * 3 + i) * 3072) + col;
                                st8f(d, a, b);
                            }
                        }
                    }
                }
        }
    } else if (mode == M_G2A || mode == M_G2B || mode == M_G2C) {
        const int which = mode - M_G2A;
        float* mg = (float*)(ws + W_MG32); const bf16_t* gts = (const bf16_t*)(ws + W_GTS); bf16_t* mgb = (bf16_t*)(ws + W_MGB);
#pragma unroll
        for (int ai = 0; ai < 2; ++ai)
#pragma unroll
            for (int m = 0; m < 4; ++m) {
                __builtin_amdgcn_sched_barrier(0); const int row = rbase + ai * 128 + m * 16;
#pragma unroll
                for (int bj = 0; bj < 2; ++bj) {
                    const int col = pn * 256 + bj * 128 + cl;
                    float g[8]; unpack8(*(const u32x4*)(gts + (unsigned)(row * 6144 + which * 2048 + col)), g);
                    f32x4 a = acc[ai][bj][m][0], b = acc[ai][bj][m][1];
#pragma unroll
                    for (int j = 0; j < 4; ++j) { a[j] *= g[j]; b[j] *= g[4 + j]; }
                    const unsigned mo = (unsigned)(row * DM + col);
                    if (which == 0) st8f(mg + mo, a, b);
                    else if (which == 2) st8f((float*)(ws + W_MG32C) + mo, a, b);
                    else { const float* mc = (const float*)(ws + W_MG32C) + mo;
                        a += *(const f32x4*)(mg + mo) + *(const f32x4*)mc; b += *(const f32x4*)(mg + mo + 4) + *(const f32x4*)(mc + 4);
                        st8bf(mgb + mo, a, b); }
                }
            }
    } else if (mode == M_G3 || mode == M_G5 || mode == M_PE) {
        const float* xr = (const float*)(ws + W_XRES); const float* pe = (const float*)(ws + W_PE);
        float* dst = (float*)(ws + (mode == M_PE ? W_PE : W_PRE));
#pragma unroll
        for (int ai = 0; ai < 2; ++ai)
#pragma unroll
            for (int m = 0; m < 4; ++m) {
                __builtin_amdgcn_sched_barrier(0); const int row = rbase + ai * 128 + m * 16;
#pragma unroll
                for (int bj = 0; bj < 2; ++bj) {
                    const unsigned o = (unsigned)(row * DM + pn * 256 + bj * 128 + cl);
                    f32x4 a = acc[ai][bj][m][0], b = acc[ai][bj][m][1];
                    if (part <= 0) {
                        if (mode == M_G3) { a += ALPHA * *(const f32x4*)(xr + o); b += ALPHA * *(const f32x4*)(xr + o + 4); }
                        if (mode == M_G5) { a += *(const f32x4*)(pe + o); b += *(const f32x4*)(pe + o + 4); }
                    }
                    if (part < 0) st8f(dst + o, a, b);
                    else st8f((float*)(ws + W_PART) + (unsigned)(part * (MS * DM)) + (o - (unsigned)(MP * DM)), a, b);
                }
            }
    } else {
        if (pn < 43) {
            bf16_t* hg = (bf16_t*)(ws + W_HG); bf16_t* hu = (bf16_t*)(ws + W_HU);
#pragma unroll
            for (int ai = 0; ai < 2; ++ai)
#pragma unroll
                for (int m = 0; m < 4; ++m) {
                    __builtin_amdgcn_sched_barrier(0); const int row = rbase + ai * 128 + m * 16;
#pragma unroll
                    for (int bj = 0; bj < 2; ++bj) {
                        const int c = pn * 256 + bj * 128 + cl;
                        const f32x4 a = acc[ai][bj][m][0], b = acc[ai][bj][m][1];
                        if (c < DFF) {
                            st8bf(hg + (unsigned)(row * DFF + c), a, b);
                            int seq, i; bool smp;
                            if (tail_row(row, 2, seq, i, smp)) {
                                float* d = out + (smp ? OUT_CFS + ((size_t)(l * 128 + seq) * 2 + i) * DFF : OUT_CFP + ((size_t)(l * 4 + seq) * 2 + i) * DFF) + c;
                                st8f(d, a, b);
                            }
                        } else st8bf(hu + (unsigned)(row * DFF + (c - DFF)), a, b);
                    }
                }
        } else {
            float* pe = (float*)(ws + W_PE);
#pragma unroll
            for (int ai = 0; ai < 2; ++ai)
#pragma unroll
                for (int m = 0; m < 4; ++m) {
                    __builtin_amdgcn_sched_barrier(0); const int row = rbase + ai * 128 + m * 16;
#pragma unroll
                    for (int bj = 0; bj < 2; ++bj) {
                        float* p = pe + (unsigned)(row * DM + (pn - 43) * 256 + bj * 128 + cl);
                        f32x4 a = acc[ai][bj][m][0], b = acc[ai][bj][m][1];
                        const f32x4 pa = *(const f32x4*)p, pb = *(const f32x4*)(p + 4);
                        const float* xq = (const float*)(ws + W_XRES) + (unsigned)(row * DM + (pn - 43) * 256 + bj * 128 + cl);
                        const f32x4 xa = *(const f32x4*)xq, xb4 = *(const f32x4*)(xq + 4);
#pragma unroll
                        for (int j = 0; j < 4; ++j) { a[j] = sigmoid_(a[j]) * pa[j] + ALPHA * xa[j]; b[j] = sigmoid_(b[j]) * pb[j] + ALPHA * xb4[j]; }
                        st8f(p, a, b);
                    }
                }
        }
    }
}

__device__ __forceinline__ void gemm_phase(LAS unsigned char* lds, const Gemm g, const StaticOrder& S, const KP& P, const int mode, const int layer) {
    const int tidx_ = otid(), bidx_ = obid(); (void)tidx_; (void)bidx_;
    const int tid = tidx_, wid = __builtin_amdgcn_readfirstlane(tid >> 6), lane = tid & 63, wr = wid >> 2, wc = wid & 3, fr = lane & 15, fq = lane >> 4;
    const int K = g.K;
    unsigned voffA[2], voffB[2];
#pragma unroll
    for (int i = 0; i < 2; ++i) { int R, C; stage_rc(tid * 16 + i * 8192, R, C); const int Rb = (R & ~31) + perm32(R & 31);
        voffA[i] = (unsigned)(R * K + C) * 2u; voffB[i] = (unsigned)(Rb * K + C) * 2u; }
    const size_t kstep = (size_t)(BK * 2);
    const size_t hstep = (size_t)HALF * K * 2;
    const size_t tstep = 2 * hstep;
    const unsigned ldsw = (unsigned)wid * 1024u;
    const int aoff = lds_byte(wr * 64 + fr, fq * 8), boff = lds_byte(wc * 32 + fr, fq * 8);
#define PG8_SA(b, h) (((b) * 2 + (h)) * HTB)
#define PG8_SB(b, h) ((4 + (b) * 2 + (h)) * HTB)
#define PG8_STAGE(bufoff, gbase, voff) do { _Pragma("unroll") for (int _i = 0; _i < 2; ++_i) \
        __builtin_amdgcn_global_load_lds((const unsigned*)((const char*)(gbase) + (voff)[_i]), (LAS unsigned*)(lds + (bufoff) + ldsw + _i * 8192), 16, 0, 0); } while (0)
#define PG8_LDA(dst, b, h) do { _Pragma("unroll") for (int m = 0; m < 4; ++m) _Pragma("unroll") for (int k = 0; k < 2; ++k) dst[m][k] = *(const LAS bf16x8*)(lds + PG8_SA(b, h) + aoff + m * 2048 + k * 1024); } while (0)
#define PG8_LDB(dst, b, h) do { _Pragma("unroll") for (int n = 0; n < 2; ++n) _Pragma("unroll") for (int k = 0; k < 2; ++k) dst[n][k] = *(const LAS bf16x8*)(lds + PG8_SB(b, h) + boff + n * 2048 + k * 1024); } while (0)
#define PG8_MMA(ai, bj, At, Bt) do { __builtin_amdgcn_s_setprio(1); _Pragma("unroll") for (int m = 0; m < 4; ++m) _Pragma("unroll") for (int n = 0; n < 2; ++n) _Pragma("unroll") for (int k = 0; k < 2; ++k) \
        acc[ai][bj][m][n] = __builtin_amdgcn_mfma_f32_16x16x32_bf16(Bt[n][k], At[m][k], acc[ai][bj][m][n], 0, 0, 0); __builtin_amdgcn_s_setprio(0); } while (0)
#define PG8_WAIT_V(n) asm volatile("s_waitcnt vmcnt(" #n ")" ::: "memory")
#define PG8_WAIT_L(n) asm volatile("s_waitcnt lgkmcnt(" #n ")" ::: "memory")
#define PG8_BAR __builtin_amdgcn_s_barrier()
#define PG8_SCHED __builtin_amdgcn_sched_barrier(0)
    Unit cur, nxt; int ui = 0;
    if (!S.next(0, cur)) return;
    f32x4 acc[2][2][4][2];
#pragma unroll
    for (int a = 0; a < 2; ++a)
#pragma unroll
        for (int b = 0; b < 2; ++b)
#pragma unroll
            for (int m = 0; m < 4; ++m)
#pragma unroll
                for (int n = 0; n < 2; ++n) acc[a][b][m][n] = (f32x4){0.f, 0.f, 0.f, 0.f};
    bf16x8 At[4][2], B0[2][2], B1[2][2];
    const char* cA = (const char*)g.A + (size_t)cur.pm * tstep + (size_t)cur.k0 * kstep; const char* cB = (const char*)g.Bt + (size_t)cur.pn * tstep + (size_t)cur.k0 * kstep;
    PG8_STAGE(PG8_SB(0, 0), cB, voffB); PG8_STAGE(PG8_SB(0, 1), cB + hstep, voffB); PG8_STAGE(PG8_SA(0, 0), cA, voffA); PG8_STAGE(PG8_SA(0, 1), cA + hstep, voffA);
    if (wr == 1) PG8_BAR;
    PG8_WAIT_V(2); PG8_BAR;
    PG8_STAGE(PG8_SB(1, 0), cB + kstep, voffB); PG8_STAGE(PG8_SA(1, 0), cA + kstep, voffA); PG8_STAGE(PG8_SB(1, 1), cB + hstep + kstep, voffB);
    PG8_WAIT_V(6); PG8_BAR;
    for (;;) {
        const bool has_next = S.next(ui + 1, nxt);
        const char* nA = has_next ? (const char*)g.A + (size_t)nxt.pm * tstep + (size_t)nxt.k0 * kstep : cA; const char* nB = has_next ? (const char*)g.Bt + (size_t)nxt.pn * tstep + (size_t)nxt.k0 * kstep : cB;
        const int nt = cur.nt;
        for (int t = 0; t < nt; t += 2) {
            const bool last = (t == nt - 2);
            const char* a1 = cA + (size_t)(t + 1) * kstep;
            const char* a2 = last ? nA : cA + (size_t)(t + 2) * kstep; const char* b2 = last ? nB : cB + (size_t)(t + 2) * kstep;
            const char* a3 = a2 + kstep; const char* b3 = b2 + kstep;
            PG8_LDB(B0, 0, 0); PG8_LDB(B1, 0, 1); PG8_SCHED; PG8_LDA(At, 0, 0); PG8_STAGE(PG8_SA(1, 1), a1 + hstep, voffA);
            PG8_WAIT_V(8); PG8_WAIT_L(0); PG8_BAR; PG8_MMA(0, 0, At, B0); PG8_MMA(0, 1, At, B1); PG8_BAR; PG8_SCHED;
            PG8_LDA(At, 0, 1); PG8_STAGE(PG8_SB(0, 0), b2, voffB); PG8_STAGE(PG8_SB(0, 1), b2 + hstep, voffB); PG8_STAGE(PG8_SA(0, 0), a2, voffA);
            PG8_WAIT_V(8); PG8_WAIT_L(0); PG8_BAR; PG8_MMA(1, 0, At, B0); PG8_MMA(1, 1, At, B1); PG8_BAR; PG8_SCHED;
            PG8_LDB(B0, 1, 0); PG8_LDB(B1, 1, 1); PG8_SCHED; PG8_LDA(At, 1, 0); PG8_STAGE(PG8_SA(0, 1), a2 + hstep, voffA);
            PG8_WAIT_V(8); PG8_WAIT_L(0); PG8_BAR; PG8_MMA(0, 0, At, B0); PG8_MMA(0, 1, At, B1); PG8_BAR; PG8_SCHED;
            PG8_LDA(At, 1, 1); PG8_STAGE(PG8_SB(1, 0), b3, voffB); PG8_STAGE(PG8_SB(1, 1), b3 + hstep, voffB); PG8_STAGE(PG8_SA(1, 0), a3, voffA);
            PG8_WAIT_V(8); PG8_WAIT_L(0); PG8_BAR; PG8_MMA(1, 0, At, B0); PG8_MMA(1, 1, At, B1); PG8_BAR; PG8_SCHED;
        }
        if (wr == 0) PG8_BAR;
        epilogue(P, mode, layer, acc, cur.pm, cur.pn, cur.part, wr, wc, fr, fq);
        if (!has_next) break;
#pragma unroll
        for (int a = 0; a < 2; ++a)
#pragma unroll
            for (int b = 0; b < 2; ++b)
#pragma unroll
                for (int m = 0; m < 4; ++m)
#pragma unroll
                    for (int n = 0; n < 2; ++n) acc[a][b][m][n] = (f32x4){0.f, 0.f, 0.f, 0.f};
        cur = nxt; cA = nA; cB = nB; ++ui;
        if (wr == 1) PG8_BAR;
    }
    PG8_WAIT_V(0);
    PG8_BAR;
#undef PG8_SA
#undef PG8_SB
#undef PG8_STAGE
#undef PG8_LDA
#undef PG8_LDB
#undef PG8_MMA
#undef PG8_WAIT_V
#undef PG8_WAIT_L
#undef PG8_BAR
#undef PG8_SCHED
}

__device__ __forceinline__ void tr_tile_w(const float* src, const int ldsrc, const int scol0, const int nvalid, const int k0, bf16_t* dst, const int K, const int drow0, float* scr, const int lane) {
    const int kk = lane >> 3, c4 = (lane & 7) * 4;
    f32x4 v[8];
#pragma unroll
    for (int p = 0; p < 8; ++p) { v[p] = (f32x4){0.f, 0.f, 0.f, 0.f}; if (c4 < nvalid) v[p] = __builtin_nontemporal_load((const f32x4*)(src + (size_t)(k0 + kk + 8 * p) * ldsrc + scol0 + c4)); }
#pragma unroll
    for (int p = 0; p < 8; ++p) {
        scr[(c4 + 0) * 65 + kk + 8 * p] = v[p][0]; scr[(c4 + 1) * 65 + kk + 8 * p] = v[p][1]; scr[(c4 + 2) * 65 + kk + 8 * p] = v[p][2]; scr[(c4 + 3) * 65 + kk + 8 * p] = v[p][3];
    }
    __builtin_amdgcn_wave_barrier();
#pragma unroll
    for (int q = 0; q < 4; ++q) {
        const int id = lane + 64 * q, n = id >> 3, c = id & 7; const float* sp = scr + n * 65 + 8 * c;
        u32x4 o; o.x = pk2(sp[0], sp[1]); o.y = pk2(sp[2], sp[3]); o.z = pk2(sp[4], sp[5]); o.w = pk2(sp[6], sp[7]);
        *(u32x4*)(dst + (size_t)(drow0 + n) * K + k0 + 8 * c) = o;
    }
    __builtin_amdgcn_wave_barrier();
}
__device__ __forceinline__ void convert_weights(const KP& P, const int l, float* scr0, const int part, const int wb0, const int nwb) {
    const int tidx_ = otid(), bidx_ = obid(); (void)tidx_; (void)bidx_;
    unsigned char* ws = ows(P.ws);
    const int lane = tidx_ & 63, wv = tidx_ >> 6, gw = (bidx_ - wb0) * 8 + wv, ngw = nwb * 8;
    float* scr = scr0 + wv * (32 * 65);
    constexpr int T_WIN = (NV1 / 32) * 32, T_W1 = 64 * 16, T_WO = 64 * 32, T_WUP = (2 * DFF / 32) * 32, T_WPG = 64 * 32, T_WDN = 64 * (DFF / 64), T_WPE = 64 * 4;
    constexpr int T_ALL = T_WIN + 3 * T_W1 + T_WO + T_WUP + T_WPG + T_WDN + T_WPE;
    constexpr int T_A = T_WIN + 3 * T_W1 + T_WO, T_LATE = T_WUP + T_WPG;
    const int njobs = part ? T_LATE : T_ALL - T_LATE;
    for (int jt = gw; jt < njobs; jt += ngw) {
        const int it = part ? T_A + jt : (jt < T_A ? jt : jt + T_LATE);
        int r = it;
        if (r < T_WIN) {
            const int nj = r >> 5, kj = r & 31, nv0 = nj * 32; int sc, nv = 32;
            if (nv0 < 2048) { const int t = nv0 >> 8, hf = (nv0 >> 7) & 1, i = nv0 & 127; sc = (hf ? 2048 : 0) + 128 * t + i; }
            else if (nv0 < 3072) sc = nv0 - 1024;
            else if (nv0 < 7168) sc = nv0;
            else if (nv0 < 15360) sc = nv0 + 16;
            else if (nv0 == 15360) { sc = 7168; nv = 16; }
            else { sc = 0; nv = 0; }
            tr_tile_w(P.in[I_WIN] + (size_t)l * 2048 * NIN, NIN, sc, nv, kj * 64, (bf16_t*)(ws + W_WIN), 2048, nv0, scr, lane); continue;
        }
        r -= T_WIN;
        if (r < 3 * T_W1) {
            const int w = r / T_W1, rr = r % T_W1, nj = rr >> 4, kj = rr & 15;
            const float* src = (w == 0 ? P.in[I_WAO] : (w == 1 ? P.in[I_WBO] : P.in[I_WCO])) + (size_t)l * 1024 * 2048;
            bf16_t* dst = (bf16_t*)(ws + (w == 0 ? W_WA : (w == 1 ? W_WB : W_WC)));
            tr_tile_w(src, 2048, nj * 32, 32, kj * 64, dst, 1024, nj * 32, scr, lane); continue;
        }
        r -= 3 * T_W1;
        if (r < T_WO) { const int nj = r >> 5, kj = r & 31; tr_tile_w(P.in[I_WO] + (size_t)l * 2048 * 2048, 2048, nj * 32, 32, kj * 64, (bf16_t*)(ws + W_WO), 2048, nj * 32, scr, lane); continue; }
        r -= T_WO;
        if (r < T_WUP) { const int nj = r >> 5, kj = r & 31; tr_tile_w(P.in[I_WUP] + (size_t)l * 2048 * 2 * DFF, 2 * DFF, nj * 32, 32, kj * 64, (bf16_t*)(ws + W_WUP), 2048, nj * 32, scr, lane); continue; }
        r -= T_WUP;
        if (r < T_WPG) { const int nj = r >> 5, kj = r & 31; tr_tile_w(P.in[I_WPG] + (size_t)l * 2048 * 2048, 2048, nj * 32, 32, kj * 64, (bf16_t*)(ws + W_WUP), 2048, 2 * DFF + nj * 32, scr, lane); continue; }
        r -= T_WPG;
        if (r < T_WDN) { const int nj = r / (DFF / 64), kj = r % (DFF / 64); tr_tile_w(P.in[I_WDN] + (size_t)l * DFF * 2048, 2048, nj * 32, 32, kj * 64, (bf16_t*)(ws + W_WDN), DFF, nj * 32, scr, lane); continue; }
        r -= T_WDN;
        { const int nj = r >> 2, kj = r & 3; tr_tile_w(P.in[I_WPE] + (size_t)l * 256 * 2048, 2048, nj * 32, 32, kj * 64, (bf16_t*)(ws + W_WPE), 256, nj * 32, scr, lane); }
    }
    bf16_t* pb = (bf16_t*)(ws + W_PB);
    if (part == 0) for (int i = bidx_ * 512 + tidx_; i < MT * 32; i += gridDim.x * 512) {
        const int r = i >> 5, c8 = (i & 31) * 8;
        const float* s = (r < MP ? P.in[I_PP] + ((size_t)l * MP + r) * 256 : P.in[I_PS] + ((size_t)l * MS + (r - MP)) * 256) + c8;
        const f32x4 a = *(const f32x4*)s, b = *(const f32x4*)(s + 4);
        st8bf(pb + (size_t)r * 256 + c8, a, b);
    }
}

__device__ __forceinline__ void ln_rows(const KP& P, const int srcsel  , const float* g, const float* b, const bool to_out) {
    const int tidx_ = otid(), bidx_ = obid(); (void)tidx_; (void)bidx_;
    unsigned char* ws = ows(P.ws);
    const int lane = tidx_ & 63, gw = bidx_ * 8 + (tidx_ >> 6), ngw = gridDim.x * 8;
    f32x4 gv[8], bv[8];
#pragma unroll
    for (int j = 0; j < 8; ++j) { gv[j] = *(const f32x4*)(g + j * 256 + lane * 4); bv[j] = *(const f32x4*)(b + j * 256 + lane * 4); }
    for (int r = gw; r < MT; r += ngw) {
        const float* src = srcsel ? (const float*)(ws + W_PRE) + (size_t)r * DM : (r < MP ? P.in[I_XP] + (size_t)r * DM : P.in[I_XS] + (size_t)(r - MP) * DM);
        f32x4 v[8]; float s = 0.f;
        if (srcsel && r >= MP && gridDim.x == 256) {
            const float* pp = (const float*)(ws + W_PART) + (size_t)(r - MP) * DM + lane * 4;
#pragma unroll
            for (int j = 0; j < 8; ++j) v[j] = __builtin_nontemporal_load((const f32x4*)(pp + j * 256));
#pragma unroll 3
            for (int ks = 1; ks < 16; ++ks)
#pragma unroll
                for (int j = 0; j < 8; ++j) v[j] += __builtin_nontemporal_load((const f32x4*)(pp + (size_t)ks * (MS * DM) + j * 256));
#pragma unroll
            for (int j = 0; j < 8; ++j) s += (v[j][0] + v[j][1]) + (v[j][2] + v[j][3]);
        } else {
#pragma unroll
            for (int j = 0; j < 8; ++j) { v[j] = __builtin_nontemporal_load((const f32x4*)(src + j * 256 + lane * 4)); s += (v[j][0] + v[j][1]) + (v[j][2] + v[j][3]); }
        }
        const float mean = wave_sum(s) * (1.f / DM); float s2 = 0.f;
#pragma unroll
        for (int j = 0; j < 8; ++j) { v[j] = v[j] - mean; s2 += (v[j][0] * v[j][0] + v[j][1] * v[j][1]) + (v[j][2] * v[j][2] + v[j][3] * v[j][3]); }
        const float rstd = rsqrtf(wave_sum(s2) * (1.f / DM) + LN_EPS);
        float* d32 = to_out ? P.out + (size_t)r * DM : (float*)(ws + W_XRES) + (size_t)r * DM;
        bf16_t* db = (bf16_t*)(ws + W_XB) + (size_t)r * DM;
#pragma unroll
        for (int j = 0; j < 8; ++j) {
            const f32x4 y = v[j] * rstd * gv[j] + bv[j];
            if (to_out) __builtin_nontemporal_store(y, (f32x4*)(d32 + j * 256 + lane * 4)); else *(f32x4*)(d32 + j * 256 + lane * 4) = y;
            if (!to_out) { u32x2 w; w.x = pk2(y[0], y[1]); w.y = pk2(y[2], y[3]); *(u32x2*)(db + j * 256 + lane * 4) = w; }
        }
    }
}

__device__ __forceinline__ void phase_e(const KP& P, const int l) {
    const int tidx_ = otid(), bidx_ = obid(); (void)tidx_; (void)bidx_;
    unsigned char* ws = ows(P.ws);
    {
        const bf16_t* ch = (const bf16_t*)(ws + W_CH); const bf16_t* bg = (const bf16_t*)(ws + W_BG); bf16_t* ya = (bf16_t*)(ws + W_YA);
        const float* cw = P.in[I_CAW] + (size_t)l * 3 * 1024; const float* hist = P.in[I_SCA] + (size_t)l * 128 * 2 * 1024;
        for (int i = bidx_ * 512 + tidx_; i < (MT / 4) * 128; i += gridDim.x * 512) {
            const int q = i >> 7, c8 = (i & 127) * 8, r0 = 4 * q;
            const bool smp = r0 >= MP; const int t0 = smp ? 0 : (r0 & 2047), sb = (r0 - MP) >> 2;
            float x[6][8];
#pragma unroll
            for (int d = 0; d < 2; ++d) {
                if (t0 > 0) unpack8(*(const u32x4*)(ch + (size_t)(r0 - 2 + d) * 1024 + c8), x[d]);
                else if (smp) { const float* h = hist + ((size_t)sb * 2 + d) * 1024 + c8; const f32x4 h0 = *(const f32x4*)h, h1 = *(const f32x4*)(h + 4);
#pragma unroll
                    for (int j = 0; j < 4; ++j) { x[d][j] = h0[j]; x[d][4 + j] = h1[j]; } }
                else {
#pragma unroll
                    for (int j = 0; j < 8; ++j) x[d][j] = 0.f; }
            }
#pragma unroll
            for (int d = 0; d < 4; ++d) unpack8(*(const u32x4*)(ch + (size_t)(r0 + d) * 1024 + c8), x[2 + d]);
            float w[3][8];
#pragma unroll
            for (int d = 0; d < 3; ++d) { const f32x4 w0 = *(const f32x4*)(cw + d * 1024 + c8), w1 = *(const f32x4*)(cw + d * 1024 + c8 + 4);
#pragma unroll
                for (int j = 0; j < 4; ++j) { w[d][j] = w0[j]; w[d][4 + j] = w1[j]; } }
#pragma unroll
            for (int d = 0; d < 4; ++d) {
                float g[8], a[8]; unpack8(*(const u32x4*)(bg + (size_t)(r0 + d) * 1024 + c8), g);
#pragma unroll
                for (int j = 0; j < 8; ++j) a[j] = g[j] * (w[0][j] * x[d][j] + w[1][j] * x[d + 1][j] + w[2][j] * x[d + 2][j]);
                *(u32x4*)(ya + (size_t)(r0 + d) * 1024 + c8) = pack8(a);
            }
        }
    }
    const int lane = tidx_ & 63, gw = bidx_ * 8 + (tidx_ >> 6), ngw = gridDim.x * 8;
    {
        const bf16_t* qkv = (const bf16_t*)(ws + W_QKV); bf16_t* qn = (bf16_t*)(ws + W_QKVN); float* qns = (float*)(ws + W_QKVNS);
        const float* cw = P.in[I_CBW] + (size_t)l * 4 * 3072; const float* hist = P.in[I_SCQ] + (size_t)l * 128 * 3 * 3072;
        for (int it = gw; it < (MT / 4) * 6; it += ngw) {
            const int q = it / 6, s4 = it % 6, c = s4 * 512 + lane * 8, r0 = 4 * q;
            const bool smp = r0 >= MP; const int t0 = smp ? 0 : (r0 & 2047), sb = (r0 - MP) >> 2;
            float x[7][8];
#pragma unroll
            for (int d = 0; d < 3; ++d) {
                if (t0 > 0) unpack8(*(const u32x4*)(qkv + (size_t)(r0 - 3 + d) * 3072 + c), x[d]);
                else if (smp) { const float* hp = hist + ((size_t)sb * 3 + d) * 3072 + c; const f32x4 h0 = *(const f32x4*)hp, h1 = *(const f32x4*)(hp + 4);
#pragma unroll
                    for (int j = 0; j < 4; ++j) { x[d][j] = h0[j]; x[d][4 + j] = h1[j]; } }
                else {
#pragma unroll
                    for (int j = 0; j < 8; ++j) x[d][j] = 0.f; }
            }
#pragma unroll
            for (int d = 0; d < 4; ++d) unpack8(*(const u32x4*)(qkv + (size_t)(r0 + d) * 3072 + c), x[3 + d]);
            float w[4][8];
#pragma unroll
            for (int d = 0; d < 4; ++d) { const f32x4 w0 = *(const f32x4*)(cw + d * 3072 + c), w1 = *(const f32x4*)(cw + d * 3072 + c + 4);
#pragma unroll
                for (int j = 0; j < 4; ++j) { w[d][j] = w0[j]; w[d][4 + j] = w1[j]; } }
#pragma unroll
            for (int d = 0; d < 4; ++d) {
                float a[8]; float ss = 0.f;
#pragma unroll
                for (int j = 0; j < 8; ++j) { a[j] = silu_(w[0][j] * x[d][j] + w[1][j] * x[d + 1][j] + w[2][j] * x[d + 2][j] + w[3][j] * x[d + 3][j]); ss += a[j] * a[j]; }
                if (s4 < 4) {
                    ss += __shfl_xor(ss, 1); ss += __shfl_xor(ss, 2); ss += __shfl_xor(ss, 4); ss += __shfl_xor(ss, 8);
                    const float sc = rsqrtf(ss + RMS_EPS) * (s4 < 2 ? 0.08838834764831845f : 1.f);
#pragma unroll
                    for (int j = 0; j < 8; ++j) a[j] *= sc;
                }
                *(u32x4*)(qn + (size_t)(r0 + d) * 3072 + c) = pack8(a);
                if (smp) st8f(qns + (size_t)(r0 + d - MP) * 3072 + c, (f32x4){a[0], a[1], a[2], a[3]}, (f32x4){a[4], a[5], a[6], a[7]});
            }
        }
    }
    {
        const bf16_t* gv = (const bf16_t*)(ws + W_GV); bf16_t* vcn = (bf16_t*)(ws + W_VCN);
        const float* lg = P.in[I_LCG] + (size_t)l * 1024; const float* lb = P.in[I_LCB] + (size_t)l * 1024;
        for (int r = gw; r < MT; r += ngw) {
            float x[2][8]; float s = 0.f;
#pragma unroll
            for (int j = 0; j < 2; ++j) { unpack8(*(const u32x4*)(gv + (size_t)r * 1024 + j * 512 + lane * 8), x[j]);
#pragma unroll
                for (int e = 0; e < 8; ++e) s += x[j][e]; }
            const float mean = wave_sum(s) * (1.f / 1024.f); float s2 = 0.f;
#pragma unroll
            for (int j = 0; j < 2; ++j)
#pragma unroll
                for (int e = 0; e < 8; ++e) { x[j][e] -= mean; s2 += x[j][e] * x[j][e]; }
            const float rstd = rsqrtf(wave_sum(s2) * (1.f / 1024.f) + LN_EPS);
#pragma unroll
            for (int j = 0; j < 2; ++j) {
                const int c = j * 512 + lane * 8;
#pragma unroll
                for (int e = 0; e < 8; ++e) x[j][e] = x[j][e] * rstd * lg[c + e] + lb[c + e];
                *(u32x4*)(vcn + (size_t)r * 1024 + c) = pack8(x[j]);
                if (r >= MP) { float* d = P.out + OUT_VS + ((size_t)l * MS + (r - MP)) * 1024 + c;
                    st8f(d, (f32x4){x[j][0], x[j][1], x[j][2], x[j][3]}, (f32x4){x[j][4], x[j][5], x[j][6], x[j][7]}); }
            }
        }
    }
}

__device__ __forceinline__ void beta_gate(const KP& P, const int l) {
    const int tidx_ = otid(), bidx_ = obid(); (void)tidx_; (void)bidx_;
    unsigned char* ws = ows(P.ws);
    const int lane = tidx_ & 63, lr = lane & 15, lq = lane >> 4, gw = bidx_ * 8 + (tidx_ >> 6), ngw = gridDim.x * 8;
    const bf16_t* xb = (const bf16_t*)(ws + W_XB); const bf16_t* wt = (const bf16_t*)(ws + W_WIN) + (size_t)15360 * 2048;
    float* betab = (float*)(ws + W_BETA); float* ggb = (float*)(ws + W_GG);
    for (int it = gw; it < MT / 16; it += ngw) {
        const bf16_t* ap = xb + (size_t)(16 * it + lr) * 2048 + lq * 8; const bf16_t* bp = wt + (size_t)lr * 2048 + lq * 8;
        f32x4 acc0 = {0.f, 0.f, 0.f, 0.f}, acc1 = {0.f, 0.f, 0.f, 0.f};
#pragma unroll 8
        for (int ks = 0; ks < 64; ks += 2) {
            acc0 = __builtin_amdgcn_mfma_f32_16x16x32_bf16(*(const bf16x8*)(ap + ks * 32), *(const bf16x8*)(bp + ks * 32), acc0, 0, 0, 0);
            acc1 = __builtin_amdgcn_mfma_f32_16x16x32_bf16(*(const bf16x8*)(ap + ks * 32 + 32), *(const bf16x8*)(bp + ks * 32 + 32), acc1, 0, 0, 0);
        }
        const int h = lr & 7; const float al = -__expf(P.in[I_ALOG][l * 8 + h]), dtb = P.in[I_DTB][l * 8 + h];
#pragma unroll
        for (int j = 0; j < 4; ++j) {
            const float v = acc0[j] + acc1[j]; const int row = 16 * it + 4 * lq + j;
            if (lr < 8) betab[row * 8 + h] = sigmoid_(v); else ggb[row * 8 + h] = al * softplus_(v + dtb);
        }
    }
}
__device__ __forceinline__ void d1_prep(const KP& P, const int l, float* shm) {
    const int tidx_ = otid(), bidx_ = obid(); (void)tidx_; (void)bidx_;
    unsigned char* ws = ows(P.ws);
    const int tid = tidx_, w = tid >> 6, lane = tid & 63, lr = lane & 15, lq = lane >> 4;
    float* Am = shm;
    float* gc = Am + 64 * 68;
    float* bt = gc + 64;
    float* X = shm + 8192;
    const bf16_t* qn = (const bf16_t*)(ws + W_QKVN);
    const float* betab = (const float*)(ws + W_BETA); const float* ggb = (const float*)(ws + W_GG);
    float* DU = (float*)(ws + W_DU); bf16_t* DNW = (bf16_t*)(ws + W_DNW); bf16_t* DQD = (bf16_t*)(ws + W_DQD); bf16_t* DKDT = (bf16_t*)(ws + W_DKDT);
    bf16_t* DQK = (bf16_t*)(ws + W_DQK); float* DGL = (float*)(ws + W_DGL);
    for (int T = bidx_; T < 1024; T += gridDim.x) {
        const int chain = T >> 5, n = T & 31, b = chain >> 3, h = chain & 7, r0 = b * 2048 + n * 64;
        const bf16_t* qp = qn + (size_t)r0 * 3072 + h * 128; const bf16_t* kp = qp + 1024; const bf16_t* vp = qp + 2048;
        bf16x8 ak[4], aq[4];
        { const int rt_ = w & 3;
#pragma unroll
            for (int ks = 0; ks < 4; ++ks) { ak[ks] = *(const bf16x8*)(kp + (size_t)(16 * rt_ + lr) * 3072 + ks * 32 + lq * 8); aq[ks] = *(const bf16x8*)(qp + (size_t)(16 * rt_ + lr) * 3072 + ks * 32 + lq * 8); } }
        asm volatile("" ::: "memory");
        if (w == 0) {
            float v = ggb[(size_t)(r0 + lane) * 8 + h];
#pragma unroll
            for (int o = 1; o < 64; o <<= 1) { const float t = __shfl_up(v, o); if (lane >= o) v += t; }
            gc[lane] = v; bt[lane] = betab[(size_t)(r0 + lane) * 8 + h];
        }
        __syncthreads();
        {
            const int rt = w & 3;
#pragma unroll
            for (int c2 = 0; c2 < 2; ++c2) {
                const int nt = 2 * (w >> 2) + c2;
                f32x4 ckk = {0.f, 0.f, 0.f, 0.f}, cqk = {0.f, 0.f, 0.f, 0.f};
#pragma unroll
                for (int ks = 0; ks < 4; ++ks) {
                    const bf16x8 bb = *(const bf16x8*)(kp + (size_t)(16 * nt + lr) * 3072 + ks * 32 + lq * 8);
                    ckk = __builtin_amdgcn_mfma_f32_16x16x32_bf16(ak[ks], bb, ckk, 0, 0, 0);
                    cqk = __builtin_amdgcn_mfma_f32_16x16x32_bf16(aq[ks], bb, cqk, 0, 0, 0);
                }
                const int jj = 16 * nt + lr; const float gj = gc[jj];
#pragma unroll
                for (int j = 0; j < 4; ++j) {
                    const int i = 16 * rt + 4 * lq + j; const float dec = __expf(fminf(gc[i] - gj, 0.f));
                    Am[i * 68 + jj] = (i > jj) ? bt[i] * ckk[j] * dec : 0.f;
                    DQK[(size_t)T * 4096 + i * 64 + jj] = f2bf((i >= jj) ? cqk[j] * dec : 0.f);
                }
            }
        }
        __syncthreads();
        {
            const int c = tid & 255, hf = tid >> 8; const bool isv = c < 128; const bf16_t* colp = isv ? vp + c : kp + (c - 128);
#pragma unroll 16
            for (int i2 = 0; i2 < 32; ++i2) { const int i = hf * 32 + i2; float rhs = bf2f(colp[(size_t)i * 3072]) * bt[i]; if (!isv) rhs *= __expf(gc[i]); X[i * 256 + c] = rhs; }
            const float glast = gc[63];
#pragma unroll 8
            for (int e = tid; e < 8192; e += 512) { const int i = e >> 7, d = e & 127; DQD[(size_t)T * 8192 + e] = f2bf(bf2f(qp[(size_t)i * 3072 + d]) * __expf(gc[i])); }
#pragma unroll 8
            for (int e = tid; e < 8192; e += 512) { const int d = e >> 6, i = e & 63; DKDT[(size_t)T * 8192 + e] = f2bf(bf2f(kp[(size_t)i * 3072 + d]) * __expf(glast - gc[i])); }
            if (tid == 0) DGL[T] = __expf(glast);
        }
        __syncthreads();
#pragma unroll
        for (int I = 0; I < 4; ++I) {
            if (I > 0) {
#pragma unroll
                for (int c2 = 0; c2 < 2; ++c2) {
                    const int ct = 2 * w + c2;
                    f32x4 acc = {0.f, 0.f, 0.f, 0.f};
#pragma unroll
                    for (int kk = 0; kk < 4 * I; ++kk)
                        acc = __builtin_amdgcn_mfma_f32_16x16x4f32(Am[(16 * I + lr) * 68 + 4 * kk + lq], X[(4 * kk + lq) * 256 + 16 * ct + lr], acc, 0, 0, 0);
#pragma unroll
                    for (int j = 0; j < 4; ++j) X[(16 * I + 4 * lq + j) * 256 + 16 * ct + lr] -= acc[j];
                }
                __syncthreads();
            }
            if (tid < 256) {
                float x[16];
#pragma unroll
                for (int r = 0; r < 16; ++r) x[r] = X[(16 * I + r) * 256 + tid];
#pragma unroll
                for (int r = 1; r < 16; ++r) {
                    float sacc = 0.f;
#pragma unroll
                    for (int j = 0; j < r; ++j) sacc += Am[(16 * I + r) * 68 + 16 * I + j] * x[j];
                    x[r] -= sacc;
                }
#pragma unroll
                for (int r = 1; r < 16; ++r) X[(16 * I + r) * 256 + tid] = x[r];
            }
            __syncthreads();
        }
        {
            const int c = tid & 255, hf = tid >> 8;
            if (c < 128) {
#pragma unroll 8
                for (int i2 = 0; i2 < 32; ++i2) { const int i = hf * 32 + i2; DU[(size_t)T * 8192 + i * 128 + c] = X[i * 256 + c]; }
            } else {
#pragma unroll 8
                for (int i2 = 0; i2 < 32; ++i2) { const int i = hf * 32 + i2; DNW[(size_t)T * 8192 + i * 128 + (c - 128)] = f2bf(-X[i * 256 + c]); }
            }
        }
        __syncthreads();
    }
}
__device__ __forceinline__ void d1_mix(const KP& P, const int l) {
    const int tidx_ = otid(), bidx_ = obid(); (void)tidx_; (void)bidx_;
    unsigned char* ws = ows(P.ws);
    const int tid = tidx_, w = tid >> 6, lane = tid & 63, lr = lane & 15, lq = lane >> 4;
    const bf16_t* vcn = (const bf16_t*)(ws + W_VCN); const bf16_t* gu = (const bf16_t*)(ws + W_GU); bf16_t* yc = (bf16_t*)(ws + W_YC);
    for (int it = bidx_ - 128; it < 512; it += gridDim.x - 128) {
        const int g = it & 7, cn = (it >> 3) & 15, b = it >> 7, r0 = b * 2048 + cn * 128;
        const float* wsg = P.in[I_WS] + ((size_t)l * 8 + g) * 128 * 128; const float* bsg = P.in[I_BS] + ((size_t)l * 8 + g) * 128;
        bf16x8 xv[4];
#pragma unroll
        for (int ks = 0; ks < 4; ++ks)
#pragma unroll
            for (int e = 0; e < 8; ++e) xv[ks][e] = (short)vcn[(size_t)(r0 + 32 * ks + 8 * lq + e) * 1024 + g * 128 + 16 * w + lr];
        float biasv[8]; u32x2 gq[8];
#pragma unroll
        for (int mt = 0; mt < 8; ++mt) { biasv[mt] = bsg[16 * mt + lr]; gq[mt] = *(const u32x2*)(gu + (size_t)(r0 + 16 * mt + lr) * 1024 + g * 128 + 16 * w + 4 * lq); }
        asm volatile("" ::: "memory");
#pragma unroll
        for (int mt = 0; mt < 8; ++mt) {
            const int t = 16 * mt + lr;
            f32x4 acc = {0.f, 0.f, 0.f, 0.f};
#pragma unroll
            for (int ks = 0; ks < 4; ++ks) {
                if (32 * ks <= 16 * mt + 15) {
                    const float* wp = wsg + (size_t)t * 128 + 32 * ks + 8 * lq; const f32x4 w0 = *(const f32x4*)wp, w1 = *(const f32x4*)(wp + 4);
                    float wv[8] = {w0[0], w0[1], w0[2], w0[3], w1[0], w1[1], w1[2], w1[3]};
                    bf16x8 yw;
#pragma unroll
                    for (int e = 0; e < 8; ++e) yw[e] = (short)f2bf((32 * ks + 8 * lq + e <= t) ? wv[e] : 0.f);
                    acc = __builtin_amdgcn_mfma_f32_16x16x32_bf16(xv[ks], yw, acc, 0, 0, 0);
                }
            }
            const float bias = biasv[mt]; const size_t o = (size_t)(r0 + t) * 1024 + g * 128 + 16 * w + 4 * lq;
            const u32x2 gw2 = gq[mt];
            u32x2 r; r.x = pk2(lo16(gw2.x) * (acc[0] + bias), hi16(gw2.x) * (acc[1] + bias)); r.y = pk2(lo16(gw2.y) * (acc[2] + bias), hi16(gw2.y) * (acc[3] + bias));
            *(u32x2*)(yc + o) = r;
        }
    }
    for (int i = (bidx_ - 128) * 512 + tidx_; i < MS * 128; i += (gridDim.x - 128) * 512) {
        const int rs = i >> 7, c8 = (i & 127) * 8, t = rs & 3, g = c8 >> 7, r = MP + rs;
        const float* wsg = P.in[I_WS] + (((size_t)l * 8 + g) * 128 + t) * 128; const float bias = P.in[I_BS][((size_t)l * 8 + g) * 128 + t];
        float a[8];
#pragma unroll
        for (int e = 0; e < 8; ++e) a[e] = bias;
#pragma unroll
        for (int s = 0; s < 4; ++s) if (s <= t) { float x[8]; unpack8(*(const u32x4*)(vcn + (size_t)(r - t + s) * 1024 + c8), x); const float wv = wsg[s];
#pragma unroll
            for (int e = 0; e < 8; ++e) a[e] += wv * x[e]; }
        float gq[8]; unpack8(*(const u32x4*)(gu + (size_t)r * 1024 + c8), gq);
#pragma unroll
        for (int e = 0; e < 8; ++e) a[e] *= gq[e];
        *(u32x4*)(yc + (size_t)r * 1024 + c8) = pack8(a);
    }
}
__device__ __forceinline__ void d1_sample_delta(const KP& P, const int l, float* shm) {
    const int tidx_ = otid(), bidx_ = obid(); (void)tidx_; (void)bidx_;
    unsigned char* ws = ows(P.ws);
    const int tid = tidx_, dvq = tid & 31, dkg = tid >> 5, lane = tid & 63;
    float* part = shm;
    float* part2 = shm + 2048;
    float* qs = shm + 4096;
    float* ks = qs + 512; float* vs = ks + 512; float* ab = vs + 512; float* zs = ab + 8;
    const float* qns = (const float*)(ws + W_QKVNS); const float* betab = (const float*)(ws + W_BETA); const float* ggb = (const float*)(ws + W_GG);
    const bf16_t* zb = (const bf16_t*)(ws + W_Z); bf16_t* yb = (bf16_t*)(ws + W_YB);
    float pq[3], pz = 0.f, pa = 0.f, pb = 0.f; const float ngd = P.in[I_NBG][(size_t)l * 128 + (tid & 127)];
#define SD_ISSUE(it_) do { const int b_ = (it_) >> 3, h_ = (it_) & 7; \
        _Pragma("unroll") for (int j_ = 0; j_ < 3; ++j_) { const int e_ = tid + 512 * j_, t_ = (e_ >> 7) & 3, d_ = e_ & 127, wh_ = e_ >> 9; pq[j_] = qns[(size_t)(b_ * 4 + t_) * 3072 + wh_ * 1024 + h_ * 128 + d_]; } \
        pz = bf2f(zb[(size_t)(MP + b_ * 4 + (tid >> 7)) * 1024 + h_ * 128 + (tid & 127)]); \
        if (tid < 4) { pa = ggb[(size_t)(MP + b_ * 4 + tid) * 8 + h_]; pb = betab[(size_t)(MP + b_ * 4 + tid) * 8 + h_]; } } while (0)
    if (bidx_ - 128 < 1024) SD_ISSUE(bidx_ - 128);
    for (int it = bidx_ - 128; it < 1024; it += gridDim.x - 128) {
        const int b = it >> 3, h = it & 7;
        const size_t so = ((size_t)(l * 128 + b) * 8 + h) * 16384;
        const float* s0 = P.in[I_SD] + so; float* sout = P.out + OUT_DS + so;
        f32x4 S[8];
#pragma unroll
        for (int i = 0; i < 8; ++i) S[i] = __builtin_nontemporal_load((const f32x4*)(s0 + (size_t)(8 * dkg + i) * 128 + 4 * dvq));
        __syncthreads();
#pragma unroll
        for (int j = 0; j < 3; ++j) qs[tid + 512 * j] = pq[j];
        zs[tid] = silu_(pz) * ngd;
        if (tid < 4) { ab[tid] = __expf(pa); ab[4 + tid] = pb; }
        { const int itn = it + (int)gridDim.x - 128; if (itn < 1024) SD_ISSUE(itn); }
        asm volatile("" ::: "memory");
        __syncthreads();
#pragma unroll 1
        for (int t = 0; t < 4; ++t) {
            const int row = MP + b * 4 + t;
            const float a = ab[t], be = ab[4 + t];
            f32x4 p = {0.f, 0.f, 0.f, 0.f};
#pragma unroll
            for (int i = 0; i < 8; ++i) p += ks[t * 128 + 8 * dkg + i] * S[i];
            *(f32x4*)(part + dkg * 128 + 4 * dvq) = p;
            __syncthreads();
            f32x4 kS = {0.f, 0.f, 0.f, 0.f};
#pragma unroll
            for (int j = 0; j < 16; ++j) kS += *(const f32x4*)(part + j * 128 + 4 * dvq);
            const f32x4 vv = *(const f32x4*)(vs + t * 128 + 4 * dvq);
            const f32x4 vn = be * (vv - a * kS);
            f32x4 po = {0.f, 0.f, 0.f, 0.f};
#pragma unroll
            for (int i = 0; i < 8; ++i) { S[i] = a * S[i] + ks[t * 128 + 8 * dkg + i] * vn; po += qs[t * 128 + 8 * dkg + i] * S[i]; }
            *(f32x4*)(part2 + dkg * 128 + 4 * dvq) = po;
            __syncthreads();
            if (tid < 64) {
                float o0 = 0.f, o1 = 0.f;
#pragma unroll
                for (int j = 0; j < 16; ++j) { o0 += part2[j * 128 + lane]; o1 += part2[j * 128 + 64 + lane]; }
                const float rstd = rsqrtf(wave_sum(o0 * o0 + o1 * o1) * (1.f / 128.f) + RMS_EPS);
                const size_t o = (size_t)row * 1024 + h * 128;
                yb[o + lane] = f2bf(o0 * rstd * zs[t * 128 + lane]);
                yb[o + 64 + lane] = f2bf(o1 * rstd * zs[t * 128 + 64 + lane]);
            }
        }
#pragma unroll
        for (int i = 0; i < 8; ++i) __builtin_nontemporal_store(S[i], (f32x4*)(sout + (size_t)(8 * dkg + i) * 128 + 4 * dvq));
    }
}

#undef SD_ISSUE
struct D2Frags { bf16x8 nwh[4], qd[4], qk[2], kd[2][2]; float u[4]; float gl; };
__device__ __forceinline__ void d2_load(D2Frags& f, const unsigned char* ws, const int T, const int rg, const int lr, const int lq, const int dvc) {
    const bf16_t* DNW = (const bf16_t*)(ws + W_DNW); const bf16_t* DQD = (const bf16_t*)(ws + W_DQD);
    const bf16_t* DKDT = (const bf16_t*)(ws + W_DKDT); const bf16_t* DQK = (const bf16_t*)(ws + W_DQK);
    const unsigned o8 = (unsigned)T * 8192u + (unsigned)(16 * rg + lr) * 128u + lq * 8;
#pragma unroll
    for (int ks = 0; ks < 4; ++ks) { f.nwh[ks] = *(const bf16x8*)(DNW + o8 + ks * 32); f.qd[ks] = *(const bf16x8*)(DQD + o8 + ks * 32); }
#pragma unroll
    for (int k2 = 0; k2 < 2; ++k2) {
        f.qk[k2] = *(const bf16x8*)(DQK + (unsigned)T * 4096u + (unsigned)(16 * rg + lr) * 64u + k2 * 32 + lq * 8);
#pragma unroll
        for (int t2 = 0; t2 < 2; ++t2) f.kd[t2][k2] = *(const bf16x8*)(DKDT + (unsigned)T * 8192u + (unsigned)(32 * rg + 16 * t2 + lr) * 64u + k2 * 32 + lq * 8);
    }
#pragma unroll
    for (int j = 0; j < 4; ++j) f.u[j] = ((const float*)(ws + W_DU))[(unsigned)T * 8192u + (unsigned)(16 * rg + 4 * lq + j) * 128u + dvc];
    f.gl = ((const float*)(ws + W_DGL))[T];
}
#define MF(a_, b_, c_) c_ = __builtin_amdgcn_mfma_f32_16x16x32_bf16(a_, b_, c_, 0, 0, 0)
__device__ __forceinline__ void d2_step(const D2Frags& cur, D2Frags& nxt, const unsigned char* ws, const int Tn, const int r0, const int h, const int rg, const int lr, const int lq, const int dvc,
                                        bf16_t* StH, bf16_t* StL, bf16_t* vnT, float* ob, f32x4 (&S)[2]) {
    d2_load(nxt, ws, Tn, rg, lr, lq, dvc);
    asm volatile("" ::: "memory");
    bf16x8 bSh[4], bSl[4];
#pragma unroll
    for (int ks = 0; ks < 4; ++ks) { bSh[ks] = *(const bf16x8*)(StH + lr * 136 + ks * 32 + lq * 8); bSl[ks] = *(const bf16x8*)(StL + lr * 136 + ks * 32 + lq * 8); }
    f32x4 av = {cur.u[0], cur.u[1], cur.u[2], cur.u[3]};
#pragma unroll
    for (int ks = 0; ks < 4; ++ks) { MF(cur.nwh[ks], bSh[ks], av); MF(cur.nwh[ks], bSl[ks], av); }
    { u32x2 q; q.x = pk2(av[0], av[1]); q.y = pk2(av[2], av[3]); *(u32x2*)(vnT + lr * 72 + 16 * rg + 4 * lq) = q; }
    f32x4 ao = {0.f, 0.f, 0.f, 0.f};
#pragma unroll
    for (int ks = 0; ks < 4; ++ks) MF(cur.qd[ks], bSh[ks], ao);
    __syncthreads();
    bf16x8 bV[2];
#pragma unroll
    for (int k2 = 0; k2 < 2; ++k2) bV[k2] = *(const bf16x8*)(vnT + lr * 72 + k2 * 32 + lq * 8);
#pragma unroll
    for (int k2 = 0; k2 < 2; ++k2) MF(cur.qk[k2], bV[k2], ao);
#pragma unroll
    for (int t2 = 0; t2 < 2; ++t2) {
        S[t2] *= cur.gl;
#pragma unroll
        for (int k2 = 0; k2 < 2; ++k2) MF(cur.kd[t2][k2], bV[k2], S[t2]);
        float hf[4], lf[4];
#pragma unroll
        for (int j = 0; j < 4; ++j) { hf[j] = bf2f(f2bf(S[t2][j])); lf[j] = S[t2][j] - hf[j]; }
        u32x2 q; q.x = pk2(hf[0], hf[1]); q.y = pk2(hf[2], hf[3]); *(u32x2*)(StH + lr * 136 + 32 * rg + 16 * t2 + 4 * lq) = q;
        q.x = pk2(lf[0], lf[1]); q.y = pk2(lf[2], lf[3]); *(u32x2*)(StL + lr * 136 + 32 * rg + 16 * t2 + 4 * lq) = q;
    }
#pragma unroll
    for (int j = 0; j < 4; ++j) ob[(unsigned)(r0 + 16 * rg + 4 * lq + j) * 1024u + h * 128 + dvc] = ao[j];
    __syncthreads();
}
__device__ __forceinline__ void d2_scan(const KP& P, const int l, unsigned char* shmb) {
    const int tidx_ = otid(), bidx_ = obid(); (void)tidx_; (void)bidx_;
    unsigned char* ws = ows(P.ws);
    const int tid = tidx_, w = tid >> 6, lane = tid & 63, lr = lane & 15, lq = lane >> 4, sl = w >> 2, rg = w & 3;
    bf16_t* StH = (bf16_t*)(shmb + sl * 11008); bf16_t* StL = StH + 16 * 136; bf16_t* vnT = StL + 16 * 136;
    float* ob = (float*)(ws + W_OB);
    for (int item = bidx_; item < 128; item += gridDim.x) {
        const int chain = item >> 2, dq = item & 3, b = chain >> 3, h = chain & 7, dv0 = 32 * dq + 16 * sl, dvc = dv0 + lr;
        f32x4 S[2];
        S[0] = (f32x4){0.f, 0.f, 0.f, 0.f}; S[1] = (f32x4){0.f, 0.f, 0.f, 0.f};
        __syncthreads();
        for (int e = tid; e < 2 * 11008 / 4; e += 512) ((unsigned*)shmb)[e] = 0u;
        __syncthreads();
        D2Frags fa, fb; d2_load(fa, ws, chain * 32, rg, lr, lq, dvc);
#pragma unroll 1
        for (int n = 0; n < 32; n += 2) {
            const int T = chain * 32 + n, r0 = b * 2048 + n * 64;
            d2_step(fa, fb, ws, T + 1, r0, h, rg, lr, lq, dvc, StH, StL, vnT, ob, S);
            d2_step(fb, fa, ws, (n < 30) ? T + 2 : T + 1, r0 + 64, h, rg, lr, lq, dvc, StH, StL, vnT, ob, S);
        }
        float* sout = P.out + OUT_DP + ((size_t)(l * 4 + b) * 8 + h) * 16384;
#pragma unroll
        for (int t2 = 0; t2 < 2; ++t2)
#pragma unroll
            for (int j = 0; j < 4; ++j) sout[(unsigned)(32 * rg + 16 * t2 + 4 * lq + j) * 128u + dvc] = S[t2][j];
    }
}
#undef MF
__device__ __forceinline__ void onorm(const KP& P, const int l) {
    const int tidx_ = otid(), bidx_ = obid(); (void)tidx_; (void)bidx_;
    unsigned char* ws = ows(P.ws);
    const int lane = tidx_ & 63, gw = bidx_ * 8 + (tidx_ >> 6), ngw = gridDim.x * 8;
    const float* ob = (const float*)(ws + W_OB); const bf16_t* zb = (const bf16_t*)(ws + W_Z); bf16_t* yb = (bf16_t*)(ws + W_YB);
    const float* ng = P.in[I_NBG] + (size_t)l * 128 + (lane & 7) * 16;
    for (int r = gw; r < MP; r += ngw) {
        const unsigned o = (unsigned)r * 1024u + lane * 16;
        float x[16]; float ss = 0.f;
#pragma unroll
        for (int q = 0; q < 4; ++q) { const f32x4 v = *(const f32x4*)(ob + o + 4 * q); x[4 * q] = v[0]; x[4 * q + 1] = v[1]; x[4 * q + 2] = v[2]; x[4 * q + 3] = v[3]; ss += (v[0] * v[0] + v[1] * v[1]) + (v[2] * v[2] + v[3] * v[3]); }
        ss += __shfl_xor(ss, 1); ss += __shfl_xor(ss, 2); ss += __shfl_xor(ss, 4);
        const float rstd = rsqrtf(ss * (1.f / 128.f) + RMS_EPS);
        float z0[8], z1[8]; unpack8(*(const u32x4*)(zb + o), z0); unpack8(*(const u32x4*)(zb + o + 8), z1);
        float y0[8], y1[8];
#pragma unroll
        for (int e = 0; e < 8; ++e) { y0[e] = x[e] * rstd * ng[e] * silu_(z0[e]); y1[e] = x[8 + e] * rstd * ng[8 + e] * silu_(z1[e]); }
        *(u32x4*)(yb + o) = pack8(y0); *(u32x4*)(yb + o + 8) = pack8(y1);
    }
}

__device__ __forceinline__ void phase_f(const KP& P, const int l) {
    const int tidx_ = otid(), bidx_ = obid(); (void)tidx_; (void)bidx_;
    unsigned char* ws = ows(P.ws);
    const bf16_t* hg = (const bf16_t*)(ws + W_HG); const bf16_t* hu = (const bf16_t*)(ws + W_HU); bf16_t* hh = (bf16_t*)(ws + W_H);
    const float* cw = P.in[I_CFW] + (size_t)l * 3 * DFF; const float* hist = P.in[I_SCF] + (size_t)l * 128 * 2 * DFF;
    constexpr int C8 = DFF / 8;
    for (int i = bidx_ * 512 + tidx_; i < (MT / 4) * C8; i += gridDim.x * 512) {
        const int q = i / C8, c8 = (i % C8) * 8, r0 = 4 * q;
        const bool smp = r0 >= MP; const int t0 = smp ? 0 : (r0 & 2047), sb = (r0 - MP) >> 2;
        float x[6][8];
#pragma unroll
        for (int d = 0; d < 2; ++d) {
            if (t0 > 0) unpack8(*(const u32x4*)(hg + (size_t)(r0 - 2 + d) * DFF + c8), x[d]);
            else if (smp) { const float* hp = hist + ((size_t)sb * 2 + d) * DFF + c8; const f32x4 h0 = *(const f32x4*)hp, h1 = *(const f32x4*)(hp + 4);
#pragma unroll
                for (int j = 0; j < 4; ++j) { x[d][j] = h0[j]; x[d][4 + j] = h1[j]; } }
            else {
#pragma unroll
                for (int j = 0; j < 8; ++j) x[d][j] = 0.f; }
        }
#pragma unroll
        for (int d = 0; d < 4; ++d) unpack8(*(const u32x4*)(hg + (size_t)(r0 + d) * DFF + c8), x[2 + d]);
        float w[3][8];
#pragma unroll
        for (int d = 0; d < 3; ++d) { const f32x4 w0 = *(const f32x4*)(cw + d * DFF + c8), w1 = *(const f32x4*)(cw + d * DFF + c8 + 4);
#pragma unroll
            for (int j = 0; j < 4; ++j) { w[d][j] = w0[j]; w[d][4 + j] = w1[j]; } }
#pragma unroll
        for (int d = 0; d < 4; ++d) {
            float u[8], a[8]; unpack8(*(const u32x4*)(hu + (size_t)(r0 + d) * DFF + c8), u);
#pragma unroll
            for (int j = 0; j < 8; ++j) a[j] = silu_(w[0][j] * x[d][j] + w[1][j] * x[d + 1][j] + w[2][j] * x[d + 2][j]) * u[j];
            *(u32x4*)(hh + (size_t)(r0 + d) * DFF + c8) = pack8(a);
        }
    }
}

#define XB_TMO      128
#define XB_XCNT(j)  (256  + 64 * (j))
#define XB_XSUB(j)  (1280 + 64 * (j))
#define XB_XGEN(j)  (2304 + 64 * (j))
#define XB_TOP      3328
#define XB_TOPGEN   3392
#define XCD_BAR_WORDS 3456
#define XB_SPIN_CAP (1u << 18)

__device__ __forceinline__ unsigned xb_ld(unsigned* p)              { return __hip_atomic_load(p, __ATOMIC_RELAXED, __HIP_MEMORY_SCOPE_AGENT); }
__device__ __forceinline__ unsigned xb_add(unsigned* p, unsigned v) { return __hip_atomic_fetch_add(p, v, __ATOMIC_RELAXED, __HIP_MEMORY_SCOPE_AGENT); }
__device__ __forceinline__ unsigned xb_xcc_id() { return (unsigned)__builtin_amdgcn_s_getreg((3 << 11) | 20) & 0xFu; }
#define XB_SPIN(cond, bar) do { unsigned _sp = 0; while (cond) { __builtin_amdgcn_s_sleep(1); \
    if ((++_sp & 255u) == 0u) { if (xb_ld(&(bar)[XB_TMO])) break; if (_sp > XB_SPIN_CAP) { atomicAdd(&(bar)[XB_TMO], 1u); break; } } } } while (0)

struct XcdBarrier {
    unsigned* bar; unsigned x;
    volatile LAS unsigned* st;
};

__device__ __forceinline__ XcdBarrier xcd_barrier_post(unsigned* bar, volatile LAS unsigned* st) {
    XcdBarrier b; b.bar = bar; b.x = xb_xcc_id(); b.st = st;
    if (threadIdx.x == 0) (void)xb_add(&bar[XB_XCNT(b.x)], 1u);
    return b;
}
__device__ __forceinline__ void xcd_barrier_complete(unsigned* bar, unsigned x, unsigned& nloc, unsigned& nx) {
    const unsigned G = gridDim.x * gridDim.y * gridDim.z;
    unsigned sum, cnt, mine, sp = 0u;
    for (;;) {
        sum = 0u; cnt = 0u; mine = 0u;
#pragma unroll
        for (unsigned j = 0; j < 16; ++j) { const unsigned c = xb_ld(&bar[XB_XCNT(j)]); sum += c; cnt += (c > 0u) ? 1u : 0u; mine = (j == x) ? c : mine; }
        if (sum == G) break;
        __builtin_amdgcn_s_sleep(1);
        if ((++sp & 255u) == 0u) { if (xb_ld(&bar[XB_TMO])) break; if (sp > XB_SPIN_CAP) { atomicAdd(&bar[XB_TMO], 1u); break; } }
    }
    nloc = mine > 0u ? mine : 1u; nx = cnt > 0u ? cnt : 1u;
}

__device__ __forceinline__ void xcd_barrier(const XcdBarrier& b) {
    asm volatile("s_waitcnt vmcnt(0)" ::: "memory");
    __syncthreads();
    if (threadIdx.x == 0) {
        unsigned* bar = b.bar;
        __builtin_amdgcn_s_waitcnt(0);
        unsigned nloc = b.st[0], nx = b.st[1];
        if (nloc == 0u) { xcd_barrier_complete(bar, b.x, nloc, nx); b.st[0] = nloc; b.st[1] = nx; }
        const unsigned old = xb_add(&bar[XB_XSUB(b.x)], 1u);
        const unsigned gen = old / nloc;
        if (old + 1u == (gen + 1u) * nloc) {
            __builtin_amdgcn_fence(__ATOMIC_RELEASE, "agent");
            asm volatile("s_waitcnt vmcnt(0)" ::: "memory");
            const unsigned og = xb_add(&bar[XB_TOP], 1u);
            const unsigned tg = og / nx;
            if (og + 1u == (tg + 1u) * nx) xb_add(&bar[XB_TOPGEN], 1u);
            else XB_SPIN(xb_ld(&bar[XB_TOPGEN]) == tg, bar);
            __builtin_amdgcn_fence(__ATOMIC_ACQUIRE, "agent");
            xb_add(&bar[XB_XGEN(b.x)], 1u);
            asm volatile("s_waitcnt vmcnt(0)" ::: "memory");
        } else {
            XB_SPIN(xb_ld(&bar[XB_XGEN(b.x)]) == gen, bar);
            __builtin_amdgcn_fence(__ATOMIC_ACQUIRE, "agent");
            asm volatile("s_waitcnt vmcnt(0)" ::: "memory");
        }
    }
    __syncthreads();
}

enum { K_G1 = 0, K_E, K_D1, K_D2, K_G2A, K_G2B, K_G3, K_LN1, K_G4, K_F, K_G5, K_LN2, K_PER_LAYER };
constexpr int N_PHASES = 1 + 2 * K_PER_LAYER;

__global__ void __launch_bounds__(512, 2) mega(const KP P, const int ph_lo, const int ph_hi) {
    extern __shared__ __attribute__((aligned(16))) unsigned char shm[];
    cg::grid_group grid = cg::this_grid();
    unsigned char* const ws = P.ws;
    volatile LAS unsigned* xst = (volatile LAS unsigned*)((LAS unsigned char*)shm + STAGE_BYTES);
    if (threadIdx.x == 0) { xst[0] = 0u; xst[1] = 0u; xst[2] = 0u; xst[3] = 0u; }
    __syncthreads();
    (void)xcd_barrier_post((unsigned*)(ws + W_BAR), xst);
    int again = 0;
#pragma unroll 1
    for (int ph = ph_lo; ph < ph_hi;) {
        if (ph == 0) {
#if !defined(PHSEL) || PHSEL == 0
            ln_rows(P, 0, P.in[I_LNG], P.in[I_LNB], false);
#endif
#if !defined(PHSEL) || PHSEL == 1
#endif
        } else {
            const int l = (ph - 1) / K_PER_LAYER, k = (ph - 1) % K_PER_LAYER;
            Gemm g; g.A = nullptr; g.Bt = nullptr; g.M = MT; g.N = 0; g.K = 0; int mode = -1;
            switch (k) {
                case K_G1: g.A = (const bf16_t*)(ws + W_XB); g.Bt = (const bf16_t*)(ws + W_WIN); g.N = NV1 - 256; g.K = 2048; mode = M_G1; break;
                case K_G2A: g.A = (const bf16_t*)(ws + W_YA); g.Bt = (const bf16_t*)(ws + W_WA); g.N = 2048; g.K = 1024; mode = M_G2A; break;
                case K_G2B: g.A = (const bf16_t*)(ws + W_YB); g.Bt = (const bf16_t*)(ws + W_WB); g.N = 2048; g.K = 1024; mode = M_G2B; break;
                case K_G3: g.A = (const bf16_t*)(ws + W_MGB); g.Bt = (const bf16_t*)(ws + W_WO); g.N = 2048; g.K = 2048; mode = M_G3; break;
                case K_G4: g.A = (const bf16_t*)(ws + W_XB); g.Bt = (const bf16_t*)(ws + W_WUP); g.N = NV4; g.K = 2048; mode = M_G4; break;
                case K_G5: g.A = (const bf16_t*)(ws + W_H); g.Bt = (const bf16_t*)(ws + W_WDN); g.N = 2048; g.K = DFF; mode = M_G5; break;
                default: break;
            }
            if (mode >= 0) {
#if !defined(PHSEL) || PHSEL == 2
                const int npass = (k == K_G2A) ? 3 : 1;
#pragma unroll 1
                for (int pass = 0; pass < npass; ++pass) {
                    int cblk = (int)blockIdx.x, G = (int)gridDim.x; bool skip = false;
                    if (pass == 1) {
                        g.A = (const bf16_t*)(ws + W_YC); g.Bt = (const bf16_t*)(ws + W_WC); mode = M_G2C; cblk = (cblk + G / 2) % G;
                    } else if (pass == 2) {
                        g.A = (const bf16_t*)(ws + W_PB); g.Bt = (const bf16_t*)(ws + W_WPE); g.K = 256; mode = M_PE;
                        skip = (cblk < 16) || (cblk >= 128 && cblk < 144); cblk -= (cblk < 128) ? 16 : 32; G -= 32;
                    }
                    if (!skip) {
                        const int split = ((mode == M_G3 || mode == M_G5) && gridDim.x == 256) ? 1 : 0;
                        StaticOrder S; S.init(split ? MP : g.M, g.N, g.K, G, cblk, split);
                        gemm_phase((LAS unsigned char*)shm, g, S, P, mode, l);
                    }
                }
#endif
                if (k == K_G2A) onorm(P, l);
            } else if (k == K_E) {
#if !defined(PHSEL) || PHSEL == 3
                beta_gate(P, l);
                phase_e(P, l);
#endif
            } else if (k == K_D1) {
#if !defined(PHSEL) || PHSEL == 4
                d1_prep(P, l, (float*)shm);
#endif

            } else if (k == K_D2) {
#if !defined(PHSEL) || PHSEL == 7
                if (blockIdx.x < 128) d2_scan(P, l, shm);
                else { d1_sample_delta(P, l, (float*)shm); d1_mix(P, l); }
#endif
            } else if (k == K_LN1) {
                ln_rows(P, 1, P.in[I_L1G] + (size_t)l * DM, P.in[I_L1B] + (size_t)l * DM, false);
            } else if (k == K_F) {
#if !defined(PHSEL) || PHSEL == 8
                phase_f(P, l);
#endif
            } else if (k == K_LN2) {
                ln_rows(P, 1, P.in[I_L2G] + (size_t)l * DM, P.in[I_L2B] + (size_t)l * DM, l == 1);
            }
        }
        {
            int cl = -1, cpart = 0, cb0 = 0, cnb = (int)gridDim.x;
            if (ph == 0) cl = 0;
            else { const int l2 = (ph - 1) / K_PER_LAYER, k2 = (ph - 1) % K_PER_LAYER;
                if (k2 == K_LN2 && l2 == 0) cl = 1;
                else if (k2 == K_G2B && blockIdx.x >= 16) { cl = l2; cpart = 1; cb0 = 16; cnb -= 16; } }
            if (cl >= 0) convert_weights(P, cl, (float*)shm, cpart, cb0, cnb);
        }
#ifdef REPMASK
        {
            const int k = ph == 0 ? -1 : (ph - 1) % K_PER_LAYER; int bit = -1;
            if (ph == 0 || k == K_LN2) bit = 0; else if (k == K_E || k == K_F) bit = 1; else if (k == K_D1) bit = 2; else if (k == K_D2) bit = 3;
            else if (k == K_G1 || k == K_G5) bit = 4; else if (k == K_G3) bit = 5; else if (k == K_LN1) bit = 6;
            if (!again && bit >= 0 && ((REPMASK >> bit) & 1)) again = 1; else { again = 0; ++ph; }
        }
#else
        ++ph; (void)again;
#endif
        if (ph < ph_hi) { if (ph_hi < 0) grid.sync();   { XcdBarrier xb; xb.bar = (unsigned*)(ows(P.ws) + W_BAR); xb.x = xb_xcc_id(); xb.st = (volatile LAS unsigned*)((LAS unsigned char*)shm + STAGE_BYTES); xcd_barrier(xb); } }
    }
}

extern "C" void kernel_launch(void* const* d_in, const int* in_sizes, int n_in, void* d_out, int out_size, void* d_ws, size_t ws_size, hipStream_t stream) {
    static int grid_blocks = 0;
    constexpr int LDS_BYTES = STAGE_BYTES + 256;
    if (grid_blocks == 0) {
        if (n_in != 33 || (size_t)out_size != OUT_END || ws_size < WS_TOTAL) {
            fprintf(stderr, "kernel_launch: unexpected problem (n_in %d, out %d vs %zu, ws %zu vs %zu)\n", n_in, out_size, (size_t)OUT_END, ws_size, (size_t)WS_TOTAL);
            grid_blocks = -1; return;
        }
        int dev = 0, cus = 0, per_cu = 0;
        hipGetDevice(&dev);
        hipDeviceGetAttribute(&cus, hipDeviceAttributeMultiprocessorCount, dev);
        hipFuncSetAttribute((const void*)mega, hipFuncAttributeMaxDynamicSharedMemorySize, LDS_BYTES);
        hipOccupancyMaxActiveBlocksPerMultiprocessor(&per_cu, (const void*)mega, 512, LDS_BYTES);
        if (per_cu < 1) per_cu = 1;
        grid_blocks = cus * 1;
        (void)hipGetLastError();
    }
    if (grid_blocks < 0) return;
    if (hipMemsetAsync((unsigned char*)d_ws + W_BAR, 0, XCD_BAR_WORDS * sizeof(unsigned), stream) != hipSuccess) { fprintf(stderr, "kernel_launch: memset of the barrier words failed\n"); return; }
    KP p{};
    for (int i = 0; i < 33; ++i) p.in[i] = (const float*)d_in[i];
    p.out = (float*)d_out; p.ws = (unsigned char*)d_ws;
    int lo = 0, hi = N_PHASES;
    void* args[] = {&p, &lo, &hi};
    hipError_t e = hipLaunchCooperativeKernel((const void*)mega, dim3(grid_blocks), dim3(512), args, LDS_BYTES, stream);
    if (e != hipSuccess) fprintf(stderr, "cooperative launch failed: %s (grid %d)\n", hipGetErrorString(e), grid_blocks);
}
```
